# Optimizing an MI355X kernel written in HIP

```python
import jax, jax.numpy as jnp
from jax import lax
import numpy as np

D_MODEL = 1024
BATCH = 2
SEQ = 8192
DEPTH = 4

GRID_W = 64
CTX_LEN = 256
EPS = 1e-6

MLA_HEADS = 8
MLA_NOPE = 64
MLA_ROPE = 32
MLA_QK = MLA_NOPE + MLA_ROPE
MLA_V = 64
Q_LORA = 256
KV_LORA = 128
ROPE_THETA = 10000.0
Q_BLOCK = 128

ML_HEADS = 4
ML_DH = 64
ML_W = ML_HEADS * ML_DH
ML_CONV = 5
ML_CHUNK = 64

GLA_HEADS = 4
GLA_DK = 32
GLA_DV = 64
GLA_LR = 16
GLA_TAU = 16.0
GLA_CHUNK = 64

N_GROUPS = 4
EXP_PER_GROUP = 8
N_EXPERTS = N_GROUPS * EXP_PER_GROUP
TOP_K = 2
D_EXPERT = 256
MOE_BLOCK = 128

IN_WIDTHS = (Q_LORA, KV_LORA, MLA_ROPE, ML_W, ML_W, ML_W, 4 * ML_HEADS,
             GLA_HEADS * GLA_DK, GLA_HEADS * GLA_DK, GLA_HEADS * GLA_DV, GLA_HEADS * GLA_DV, 2 * GLA_LR)
D_IN = sum(IN_WIDTHS)
D_MIX = MLA_HEADS * MLA_V + ML_W + GLA_HEADS * GLA_DV

kernel_name = 'hybrid_mla_mlstm_gla_hmoe_dit'


def _split_cols(p):
    offs = np.cumsum(IN_WIDTHS)[:-1].tolist()
    return jnp.split(p, offs, axis=-1)


def _rms_norm(x, w):
    xf = x.astype(jnp.float32)
    y = xf * lax.rsqrt(jnp.mean(xf * xf, axis=-1, keepdims=True) + EPS)
    return (y * w.astype(jnp.float32)).astype(x.dtype)


def _modulate(x, w, shift, scale):
    return _rms_norm(x, w) * (1 + scale) + shift


def _axial_rope(n_tokens, dtype):
    rows = n_tokens // GRID_W
    row = jnp.broadcast_to(jnp.arange(rows, dtype=jnp.float32)[:, None], (rows, GRID_W)).reshape(-1)
    col = jnp.broadcast_to(jnp.arange(GRID_W, dtype=jnp.float32)[None, :], (rows, GRID_W)).reshape(-1)
    n_freq = MLA_ROPE // 4
    inv = ROPE_THETA ** (-jnp.arange(n_freq, dtype=jnp.float32) / n_freq)
    ang = jnp.concatenate([row[:, None] * inv, col[:, None] * inv], axis=-1)
    return jnp.cos(ang).astype(dtype), jnp.sin(ang).astype(dtype)


def _apply_rope(x, cos, sin):
    half = MLA_ROPE // 2
    x1, x2 = x[..., :half], x[..., half:]
    return jnp.concatenate([x1 * cos - x2 * sin, x1 * sin + x2 * cos], axis=-1)


def _mla_qkv(cq, ckv, kr, q_a_norm, w_uq, kv_a_norm, w_ukv, q_norm_w, k_norm_w, rope):
    b, t, _ = cq.shape
    q = (_rms_norm(cq, q_a_norm) @ w_uq).reshape(b, t, MLA_HEADS, MLA_QK)
    kv = (_rms_norm(ckv, kv_a_norm) @ w_ukv).reshape(b, t, MLA_HEADS, MLA_NOPE + MLA_V)
    k = jnp.concatenate([kv[..., :MLA_NOPE],
                         jnp.broadcast_to(kr[:, :, None, :], (b, t, MLA_HEADS, MLA_ROPE))], axis=-1)
    v = kv[..., MLA_NOPE:]
    q = _rms_norm(q, q_norm_w)
    k = _rms_norm(k, k_norm_w)
    if rope is not None:
        cos, sin = rope[0][:, None, :], rope[1][:, None, :]
        q = jnp.concatenate([q[..., :MLA_NOPE], _apply_rope(q[..., MLA_NOPE:], cos, sin)], axis=-1)
        k = jnp.concatenate([k[..., :MLA_NOPE], _apply_rope(k[..., MLA_NOPE:], cos, sin)], axis=-1)
    return q, k, v


def _attend(q, k, v):
    s = jnp.einsum('bqhd,bkhd->bhqk', q, k, preferred_element_type=jnp.float32) * (MLA_QK ** -0.5)
    p = jax.nn.softmax(s, axis=-1).astype(v.dtype)
    return jnp.einsum('bhqk,bkhd->bqhd', p, v)


def _latent_attention(q, k_lat, v_lat, k_ctx, v_ctx):
    b, s, h, _ = q.shape
    k_all = jnp.concatenate([k_lat, k_ctx], axis=1)
    v_all = jnp.concatenate([v_lat, v_ctx], axis=1)
    qb = q.reshape(b, s // Q_BLOCK, Q_BLOCK, h, MLA_QK).transpose(1, 0, 2, 3, 4)
    o = lax.map(lambda qi: _attend(qi, k_all, v_all), qb)
    return o.transpose(1, 0, 2, 3, 4).reshape(b, s, h * MLA_V)


def _dwconv(x, w, b):
    k, ch = w.shape
    y = lax.conv_general_dilated(x, w[:, None, :].astype(x.dtype), window_strides=(1,),
                                 padding=[(k // 2, k // 2)],
                                 dimension_numbers=('NWC', 'WIO', 'NWC'),
                                 feature_group_count=ch)
    return y + b


def _mlstm_prep(xm, v, gates, conv_w, conv_b, wq, wk, gate_b):
    b, t, _ = xm.shape
    xconv = jax.nn.silu(_dwconv(xm, conv_w, conv_b))
    xh = xconv.reshape(b, t, ML_HEADS, ML_DH)
    q = jnp.einsum('bthd,hde->bhte', xh, wq).astype(jnp.float32) * (ML_DH ** -0.5)
    k = jnp.einsum('bthd,hde->bhte', xh, wk).astype(jnp.float32)
    v = v.reshape(b, t, ML_HEADS, ML_DH).transpose(0, 2, 1, 3).astype(jnp.float32)
    g = (gates.astype(jnp.float32) + gate_b.astype(jnp.float32)).reshape(b, t, 2, 2, ML_HEADS)
    g = g.transpose(2, 3, 0, 4, 1)
    logi = g[:, 0]
    logf = jax.nn.log_sigmoid(g[:, 1])
    return xconv, (q, k, v, logi[0], logf[0]), (q, k, v, logi[1], logf[1])


def _mlstm_scan(q, k, v, logi, logf, state):
    n_chunk = q.shape[2] // ML_CHUNK
    tri = jnp.tril(jnp.ones((ML_CHUNK, ML_CHUNK), dtype=bool))

    def chunks(a):
        return jnp.moveaxis(a.reshape(a.shape[:2] + (n_chunk, ML_CHUNK) + a.shape[3:]), 2, 0)

    def step(carry, xs):
        c_st, n_st, m_st = carry
        qc, kc, vc, ic, fc = xs
        bcum = jnp.cumsum(fc, axis=-1)
        d = jnp.where(tri, bcum[..., :, None] - bcum[..., None, :] + ic[..., None, :], -jnp.inf)
        inter = bcum + m_st[..., None]
        m_t = jnp.maximum(inter, jnp.max(d, axis=-1))
        s = jnp.einsum('bhtd,bhjd->bhtj', qc, kc) * jnp.exp(d - m_t[..., None])
        w_inter = jnp.exp(inter - m_t)
        num = (jnp.einsum('bhtj,bhjv->bhtv', s, vc)
               + w_inter[..., None] * jnp.einsum('bhtd,bhdv->bhtv', qc, c_st))
        den = jnp.sum(s, axis=-1) + w_inter * jnp.einsum('bhtd,bhd->bht', qc, n_st)
        h = num / jnp.maximum(jnp.abs(den), jnp.exp(-m_t))[..., None]
        b_end = bcum[..., -1]
        g = b_end[..., None] - bcum + ic
        m_new = jnp.maximum(b_end + m_st, jnp.max(g, axis=-1))
        w_j = jnp.exp(g - m_new[..., None])
        decay = jnp.exp(b_end + m_st - m_new)
        c_new = decay[..., None, None] * c_st + jnp.einsum('bhj,bhjd,bhjv->bhdv', w_j, kc, vc)
        n_new = decay[..., None] * n_st + jnp.einsum('bhj,bhjd->bhd', w_j, kc)
        return (c_new, n_new, m_new), h

    state, hs = lax.scan(step, state, tuple(chunks(a) for a in (q, k, v, logi, logf)))
    h = jnp.moveaxis(hs, 0, 2)
    return h.reshape(h.shape[:2] + (-1, h.shape[-1])), state


def _mlstm_out(h, xconv, o, norm_w, skip):
    b, nh, t, dv = h.shape
    hn = _rms_norm(h.transpose(0, 2, 1, 3), norm_w.reshape(nh, dv)).reshape(b, t, nh * dv)
    return jax.nn.sigmoid(o) * (hn.astype(xconv.dtype) + skip * xconv)


def _gla_prep(q, k, v, a_lr, wa, ba):
    b, t, _ = q.shape

    def heads(a, d):
        return a.reshape(b, t, GLA_HEADS, d).transpose(0, 2, 1, 3).astype(jnp.float32)

    q = heads(q, GLA_DK) * (GLA_DK ** -0.5)
    k = heads(k, GLA_DK)
    v = heads(v, GLA_DV)
    a = a_lr.reshape(b, t, 2, GLA_LR)
    pre = jnp.einsum('btur,urk->ubtk', a, wa).astype(jnp.float32) + ba[:, None, None, :].astype(jnp.float32)
    loga = jax.nn.log_sigmoid(pre) / GLA_TAU
    loga = loga.reshape(2, b, t, GLA_HEADS, GLA_DK).transpose(0, 1, 3, 2, 4)
    return (q, k, v, loga[0]), (q, k, v, loga[1])


def _gla_scan(q, k, v, loga, state):
    n_chunk = q.shape[2] // GLA_CHUNK
    tri = jnp.tril(jnp.ones((GLA_CHUNK, GLA_CHUNK), dtype=bool))[:, :, None]

    def chunks(a):
        return jnp.moveaxis(a.reshape(a.shape[:2] + (n_chunk, GLA_CHUNK) + a.shape[3:]), 2, 0)

    def step(s_st, xs):
        qc, kc, vc, ac = xs
        bcum = jnp.cumsum(ac, axis=2)
        diff = jnp.where(tri, bcum[:, :, :, None, :] - bcum[:, :, None, :, :], -jnp.inf)
        att = jnp.einsum('bhtd,bhjd,bhtjd->bhtj', qc, kc, jnp.exp(diff))
        o = jnp.einsum('bhtj,bhjv->bhtv', att, vc) + jnp.einsum('bhtd,bhdv->bhtv', qc * jnp.exp(bcum), s_st)
        b_end = bcum[:, :, -1]
        s_new = (jnp.exp(b_end)[..., None] * s_st
                 + jnp.einsum('bhjd,bhjv->bhdv', kc * jnp.exp(b_end[:, :, None, :] - bcum), vc))
        return s_new, o

    state, os_ = lax.scan(step, state, tuple(chunks(a) for a in (q, k, v, loga)))
    o = jnp.moveaxis(os_, 0, 2)
    return o.reshape(o.shape[:2] + (-1, o.shape[-1])), state


def _gla_out(o, r, norm_w):
    b, nh, t, dv = o.shape
    on = _rms_norm(o.transpose(0, 2, 1, 3), norm_w.reshape(nh, dv)).reshape(b, t, nh * dv)
    return on.astype(r.dtype) * jax.nn.silu(r)


def _bidirectional(scan_fn, init, ctx_fwd, ctx_bwd, lat_fwd, lat_bwd):
    def flip(args):
        return tuple(jnp.flip(a, axis=2) for a in args)

    h_cf, st_f = scan_fn(*ctx_fwd, init)
    h_lf, _ = scan_fn(*lat_fwd, st_f)
    h_cb, st_b = scan_fn(*flip(ctx_bwd), init)
    h_lb, _ = scan_fn(*flip(lat_bwd), st_b)
    return h_cf + jnp.flip(h_cb, axis=2), h_lf + jnp.flip(h_lb, axis=2)


def _moe(h, w_grp, b_grp, w_erouter, b_erouter, w_gate, w_up, w_down):
    n, d = h.shape
    hb = h.reshape(n // MOE_BLOCK, MOE_BLOCK, d)

    def blk(t):
        g_prob = jax.nn.softmax((t @ w_grp + b_grp).astype(jnp.float32), axis=-1)
        g_w, g_i = lax.top_k(g_prob, 1)
        e_logit = (t @ w_erouter + b_erouter).astype(jnp.float32).reshape(-1, N_GROUPS, EXP_PER_GROUP)
        e_sel = e_logit[jnp.arange(t.shape[0]), g_i[:, 0]]
        e_w, e_i = lax.top_k(jax.nn.softmax(e_sel, axis=-1), TOP_K)
        e_w = e_w / jnp.sum(e_w, axis=-1, keepdims=True)
        wts = g_w * e_w
        ids = g_i * EXP_PER_GROUP + e_i
        gate = jnp.sum(jax.nn.one_hot(ids, N_EXPERTS, dtype=jnp.float32) * wts[..., None], axis=1)
        a = jax.nn.silu(jnp.einsum('nd,edf->nef', t, w_gate)) * jnp.einsum('nd,edf->nef', t, w_up)
        a = a * gate[..., None].astype(a.dtype)
        return jnp.einsum('nef,efd->nd', a, w_down)

    return lax.map(blk, hb).reshape(n, d)


def _layer(x, xc, c, c_ctx, w_mod, b_mod, norm1_w, w_in, q_a_norm, w_uq, kv_a_norm, w_ukv,
           q_norm_w, k_norm_w, ml_conv_w, ml_conv_b, ml_wq, ml_wk, ml_gate_b, ml_norm_w, ml_skip,
           gla_wa, gla_ba, gla_norm_w, w_out, norm2_w, w_grp, b_grp, w_erouter, b_erouter,
           w_gate, w_up, w_down, rope, need_ctx):
    b, s, d = x.shape
    mod_l = jnp.split((jax.nn.silu(c) @ w_mod + b_mod)[:, None, :], 6, axis=-1)
    mod_c = jnp.split((jax.nn.silu(c_ctx) @ w_mod + b_mod)[None, None, :], 6, axis=-1)

    (cq_l, ckv_l, kr_l, mx_l, mv_l, mo_l, mg_l, gq_l, gk_l, gv_l, gr_l, ga_l) = _split_cols(
        _modulate(x, norm1_w, mod_l[0], mod_l[1]) @ w_in)
    (cq_c, ckv_c, kr_c, mx_c, mv_c, mo_c, mg_c, gq_c, gk_c, gv_c, gr_c, ga_c) = _split_cols(
        _modulate(xc, norm1_w, mod_c[0], mod_c[1]) @ w_in)

    q_l, k_l, v_l = _mla_qkv(cq_l, ckv_l, kr_l, q_a_norm, w_uq, kv_a_norm, w_ukv, q_norm_w, k_norm_w, rope)
    q_c, k_c, v_c = _mla_qkv(cq_c, ckv_c, kr_c, q_a_norm, w_uq, kv_a_norm, w_ukv, q_norm_w, k_norm_w, None)
    a_l = _latent_attention(q_l, k_l, v_l, k_c, v_c)

    xconv_l, mf_l, mb_l = _mlstm_prep(mx_l, mv_l, mg_l, ml_conv_w, ml_conv_b, ml_wq, ml_wk, ml_gate_b)
    xconv_c, mf_c, mb_c = _mlstm_prep(mx_c, mv_c, mg_c, ml_conv_w, ml_conv_b, ml_wq, ml_wk, ml_gate_b)
    ml_init = (jnp.zeros((b, ML_HEADS, ML_DH, ML_DH), jnp.float32),
               jnp.zeros((b, ML_HEADS, ML_DH), jnp.float32),
               jnp.zeros((b, ML_HEADS), jnp.float32))
    mh_c, mh_l = _bidirectional(_mlstm_scan, ml_init, mf_c, mb_c, mf_l, mb_l)
    m_l = _mlstm_out(mh_l, xconv_l, mo_l, ml_norm_w, ml_skip)

    gf_l, gb_l = _gla_prep(gq_l, gk_l, gv_l, ga_l, gla_wa, gla_ba)
    gf_c, gb_c = _gla_prep(gq_c, gk_c, gv_c, ga_c, gla_wa, gla_ba)
    gla_init = jnp.zeros((b, GLA_HEADS, GLA_DK, GLA_DV), jnp.float32)
    go_c, go_l = _bidirectional(_gla_scan, gla_init, gf_c, gb_c, gf_l, gb_l)
    g_l = _gla_out(go_l, gr_l, gla_norm_w)

    x = x + mod_l[2] * (jnp.concatenate([a_l, m_l, g_l], axis=-1) @ w_out)
    h2 = _modulate(x, norm2_w, mod_l[3], mod_l[4])
    x = x + mod_l[5] * _moe(h2.reshape(b * s, d), w_grp, b_grp, w_erouter, b_erouter,
                           w_gate, w_up, w_down).reshape(b, s, d)

    if need_ctx:
        n_ctx = xc.shape[1]
        a_c = _attend(q_c, k_c, v_c).reshape(b, n_ctx, MLA_HEADS * MLA_V)
        m_c = _mlstm_out(mh_c, xconv_c, mo_c, ml_norm_w, ml_skip)
        g_c = _gla_out(go_c, gr_c, gla_norm_w)
        xc = xc + mod_c[2] * (jnp.concatenate([a_c, m_c, g_c], axis=-1) @ w_out)
        h2c = _modulate(xc, norm2_w, mod_c[3], mod_c[4])
        xc = xc + mod_c[5] * _moe(h2c.reshape(b * n_ctx, d), w_grp, b_grp, w_erouter, b_erouter,
                                 w_gate, w_up, w_down).reshape(b, n_ctx, d)
    return x, xc


def setup_inputs(seed: int = 0) -> dict:
    key = jax.random.key(seed)
    ks = iter(jax.random.split(key, 48))

    def nrm(shape, scale):
        return scale * jax.random.normal(next(ks), shape, dtype=jnp.float32)

    def gain(shape):
        return 1.0 + nrm(shape, 0.02)

    L, D = DEPTH, D_MODEL
    ib = nrm((L, 2, 1, ML_HEADS), 0.1)
    fb = jnp.linspace(3.0, 6.0, ML_HEADS, dtype=jnp.float32) + nrm((L, 2, 1, ML_HEADS), 0.1)
    ml_gate_b = jnp.concatenate([ib, fb], axis=2).reshape(L, 4 * ML_HEADS)
    return {
        'x': nrm((BATCH, SEQ, D), 1.0),
        'c': nrm((BATCH, D), 1.0),
        'ctx': nrm((BATCH, CTX_LEN, D), 1.0),
        'c_ctx': nrm((D,), 1.0),
        'w_mod': nrm((L, D, 6 * D), 0.5 * D ** -0.5),
        'b_mod': nrm((L, 6 * D), 0.01),
        'norm1_w': gain((L, D)),
        'w_in': nrm((L, D, D_IN), D ** -0.5),
        'q_a_norm': gain((L, Q_LORA)),
        'w_uq': nrm((L, Q_LORA, MLA_HEADS * MLA_QK), Q_LORA ** -0.5),
        'kv_a_norm': gain((L, KV_LORA)),
        'w_ukv': nrm((L, KV_LORA, MLA_HEADS * (MLA_NOPE + MLA_V)), KV_LORA ** -0.5),
        'q_norm_w': gain((L, MLA_QK)),
        'k_norm_w': gain((L, MLA_QK)),
        'ml_conv_w': nrm((L, ML_CONV, ML_W), ML_CONV ** -0.5),
        'ml_conv_b': nrm((L, ML_W), 0.01),
        'ml_wq': nrm((L, ML_HEADS, ML_DH, ML_DH), ML_DH ** -0.5),
        'ml_wk': nrm((L, ML_HEADS, ML_DH, ML_DH), ML_DH ** -0.5),
        'ml_gate_b': ml_gate_b,
        'ml_norm_w': gain((L, ML_W)),
        'ml_skip': gain((L, ML_W)),
        'gla_wa': nrm((L, 2, GLA_LR, GLA_HEADS * GLA_DK), GLA_LR ** -0.5),
        'gla_ba': nrm((L, 2, GLA_HEADS * GLA_DK), 0.1),
        'gla_norm_w': gain((L, GLA_HEADS * GLA_DV)),
        'w_out': nrm((L, D_MIX, D), D_MIX ** -0.5),
        'norm2_w': gain((L, D)),
        'w_grp': nrm((L, D, N_GROUPS), D ** -0.5),
        'b_grp': nrm((L, N_GROUPS), 0.01),
        'w_erouter': nrm((L, D, N_EXPERTS), D ** -0.5),
        'b_erouter': nrm((L, N_EXPERTS), 0.01),
        'w_gate': nrm((L, N_EXPERTS, D, D_EXPERT), D ** -0.5),
        'w_up': nrm((L, N_EXPERTS, D, D_EXPERT), D ** -0.5),
        'w_down': nrm((L, N_EXPERTS, D_EXPERT, D), D_EXPERT ** -0.5),
    }


def reference(x, c, ctx, c_ctx, w_mod, b_mod, norm1_w, w_in, q_a_norm, w_uq, kv_a_norm, w_ukv,
              q_norm_w, k_norm_w, ml_conv_w, ml_conv_b, ml_wq, ml_wk, ml_gate_b, ml_norm_w, ml_skip,
              gla_wa, gla_ba, gla_norm_w, w_out, norm2_w, w_grp, b_grp, w_erouter, b_erouter,
              w_gate, w_up, w_down):
    rope = _axial_rope(x.shape[1], x.dtype)
    xc = ctx
    for l in range(DEPTH):
        x, xc = _layer(x, xc, c, c_ctx, w_mod[l], b_mod[l], norm1_w[l], w_in[l], q_a_norm[l], w_uq[l],
                       kv_a_norm[l], w_ukv[l], q_norm_w[l], k_norm_w[l], ml_conv_w[l], ml_conv_b[l],
                       ml_wq[l], ml_wk[l], ml_gate_b[l], ml_norm_w[l], ml_skip[l], gla_wa[l], gla_ba[l],
                       gla_norm_w[l], w_out[l], norm2_w[l], w_grp[l], b_grp[l], w_erouter[l], b_erouter[l],
                       w_gate[l], w_up[l], w_down[l], rope=rope, need_ctx=(l < DEPTH - 1))
    return x
```

```cpp
#include <hip/hip_runtime.h>
#include <cstdio>
#include <cstdint>

#ifndef N_LAUNCH_MODE
#define N_LAUNCH_MODE 0
#endif

#define LAS __attribute__((address_space(3)))
#define GAS __attribute__((address_space(1)))
typedef unsigned short bf16_t;
typedef short bf16x8 __attribute__((ext_vector_type(8)));
typedef short s16x4 __attribute__((ext_vector_type(4)));
typedef float f32x2 __attribute__((ext_vector_type(2)));
typedef float f32x4 __attribute__((ext_vector_type(4)));
typedef float f32x16 __attribute__((ext_vector_type(16)));
typedef unsigned u32x2 __attribute__((ext_vector_type(2)));
typedef unsigned u32x4 __attribute__((ext_vector_type(4)));
#define DI __device__ __forceinline__

constexpr int D = 1024, NB = 2, SEQ = 8192, DEPTH = 4, CTX = 256;
constexpr int ML = NB * SEQ, MC = NB * CTX, MA = ML + MC;
constexpr int DINP = 2048;
constexpr int C_CQ = 0, C_CKV = 256, C_KR = 384, C_MX = 416, C_MV = 672, C_MO = 928, C_MG = 1184, C_GQ = 1200, C_GK = 1328, C_GV = 1456, C_GR = 1712, C_GA = 1968;
constexpr int NH = 8, QK = 96, NKEY = SEQ + CTX, NTILE = NKEY / 64;
constexpr int NCH = 132;
constexpr int NEXP = 32, DE = 256, PAIRCAP = MA;
constexpr float EPS = 1e-6f;
constexpr float QSCALE = 0.10206207261596577f * 1.4426950408889634f;
constexpr int NPL = 11;
constexpr int NPHASE = 1 + DEPTH * NPL + 1;

constexpr size_t MiB = 1u << 20;
constexpr size_t WS_CTL = 0, CTL_BYTES = 1 * MiB;
constexpr size_t WS_MODS = 1 * MiB;
constexpr size_t WS_ROPE = WS_MODS + MiB / 2;
constexpr size_t WS_XC = WS_ROPE + 1 * MiB + MiB / 2;
constexpr size_t WS_WL = 5 * MiB;
constexpr size_t WL_STRIDE = 8 * MiB, WL_IN = 0, WL_UP = 4 * MiB, WL_MQK = 4 * MiB + 1536 * 1024, WL_OUT = 6 * MiB;
constexpr size_t WS_WGU = 37 * MiB;
constexpr size_t WS_WDN = 69 * MiB;
constexpr size_t WS_A = 85 * MiB;
constexpr size_t WS_B = 151 * MiB;
constexpr size_t WS_ACT = WS_B + 34 * MiB;
constexpr size_t WS_H = 209 * MiB;
constexpr size_t WS_CQ = 242 * MiB;
constexpr size_t WS_XCONV = 255 * MiB;
constexpr size_t WS_MQK = 264 * MiB;
constexpr size_t WS_Q = 281 * MiB;
constexpr size_t WS_K = 306 * MiB;
constexpr size_t WS_V = 331 * MiB;
constexpr size_t WS_GATES = 348 * MiB;
constexpr size_t WS_LOGA = 350 * MiB;
constexpr size_t WS_MU = 367 * MiB;
constexpr size_t WS_MN = 400 * MiB;
constexpr size_t WS_MS = 401 * MiB;
constexpr size_t WS_GU = 402 * MiB;
constexpr size_t WS_GD = 419 * MiB;
constexpr size_t WS_PAIR = 420 * MiB;
constexpr size_t WS_PW = 423 * MiB;
constexpr size_t WS_END = 426 * MiB;
static_assert(WS_A + (size_t)MA * DINP * 2 <= WS_B && WS_B + (size_t)MA * 1792 * 2 <= WS_H && WS_ACT + (size_t)42240 * 256 * 2 <= WS_H && WS_B + (size_t)MA * 1024 * 2 <= WS_ACT, "ws map");
static_assert(WS_H + (size_t)MA * D * 2 <= WS_CQ && WS_CQ + (size_t)MA * 384 * 2 <= WS_XCONV && WS_XCONV + (size_t)MA * 256 * 2 <= WS_MQK && WS_MQK + (size_t)MA * 512 * 2 <= WS_Q, "ws map 2");
static_assert(WS_Q + (size_t)16 * 8448 * 96 * 2 <= WS_K && WS_K + (size_t)16 * 132 * 12288 <= WS_V && WS_V + (size_t)16 * 132 * 8192 <= WS_GATES && WS_GATES + (size_t)MA * 64 <= WS_LOGA, "ws map 3");
static_assert(WS_LOGA + (size_t)2 * MA * 512 <= WS_MU && WS_MU + (size_t)16 * 132 * 16384 <= WS_MN && WS_MN + (size_t)16 * 132 * 256 <= WS_MS && WS_GU + (size_t)16 * 132 * 8192 <= WS_GD && WS_GD + (size_t)16 * 132 * 128 <= WS_PAIR, "ws map 4");
static_assert(WS_PAIR + (size_t)32 * PAIRCAP * 4 <= WS_PW && WS_PW + (size_t)32 * PAIRCAP * 4 <= WS_END, "ws map 5");
constexpr int CW_BAR = 4096;
constexpr int CW_CNT = 16384;

constexpr int LDS_BYTES = 163840 - 1024;
constexpr int MISC_OFF = LDS_BYTES - 1024;
constexpr int WSCR = 19200;

struct Args { const float* in[33]; float* out; unsigned char* ws; int ph_lo, ph_hi; };
typedef const __attribute__((address_space(4))) Args* KArgs;

DI float bf2f(unsigned v) { return __uint_as_float(v << 16); }
DI unsigned f2bf(float f) { unsigned u = __float_as_uint(f); return (u + 0x7fffu + ((u >> 16) & 1u)) >> 16; }
DI unsigned pk2(float lo, float hi) { return f2bf(lo) | (f2bf(hi) << 16); }
typedef __bf16 bf16x2_t __attribute__((ext_vector_type(2)));
DI unsigned cvtpk(float lo, float hi) { f32x2 v = {lo, hi}; bf16x2_t b = __builtin_convertvector(v, bf16x2_t); return __builtin_bit_cast(unsigned, b); }
DI float sh_idx(float v, int src) { return __int_as_float(__builtin_amdgcn_ds_bpermute(src << 2, __float_as_int(v))); }
DI float sh_xor(float v, int m, int lane) { return sh_idx(v, lane ^ m); }
DI float wave_sum(float v, int lane) {
#pragma unroll
    for (int o = 1; o < 64; o <<= 1) v += sh_xor(v, o, lane);
    return v;
}
DI float wave_max(float v, int lane) {
#pragma unroll
    for (int o = 1; o < 64; o <<= 1) v = fmaxf(v, sh_xor(v, o, lane));
    return v;
}
DI float siluf(float x) { return x / (1.f + __expf(-x)); }
DI float sigmoidf_(float x) { return 1.f / (1.f + __expf(-x)); }
DI float logsigmoidf_(float x) { return fminf(x, 0.f) - log1pf(__expf(-fabsf(x))); }
DI int crow(int r, int hi) { return (r & 3) + 8 * (r >> 2) + 4 * hi; }
#define LDS_WAIT() asm volatile("s_waitcnt lgkmcnt(0)" ::: "memory")
#define VM_WAIT() asm volatile("s_waitcnt vmcnt(0)" ::: "memory")
DI int tokrow(int b, int gc, int t) { return gc < 128 ? b * SEQ + gc * 64 + t : ML + b * CTX + (gc - 128) * 64 + t; }

#define XB_TMO      128
#define XB_XCNT(j)  (256  + 64 * (j))
#define XB_XSUB(j)  (1280 + 64 * (j))
#define XB_XGEN(j)  (2304 + 64 * (j))
#define XB_TOP      3328
#define XB_TOPGEN   3392
#define XCD_BAR_WORDS 3456
#define XB_SPIN_CAP (1u << 22)
DI unsigned xb_ld(unsigned* p)              { return __hip_atomic_load(p, __ATOMIC_RELAXED, __HIP_MEMORY_SCOPE_AGENT); }
DI unsigned xb_add(unsigned* p, unsigned v) { return __hip_atomic_fetch_add(p, v, __ATOMIC_RELAXED, __HIP_MEMORY_SCOPE_AGENT); }
DI unsigned xb_xcc_id() { return (unsigned)__builtin_amdgcn_s_getreg((3 << 11) | 20) & 0xFu; }
#define XB_SPIN(cond, bar) do { unsigned _sp = 0; while (cond) { __builtin_amdgcn_s_sleep(1); \
    if ((++_sp & 255u) == 0u) { if (xb_ld(&(bar)[XB_TMO])) break; if (_sp > XB_SPIN_CAP) { atomicAdd(&(bar)[XB_TMO], 1u); break; } } } } while (0)
struct XcdBarrier { unsigned* bar; unsigned x; volatile LAS unsigned* st; };
DI XcdBarrier xcd_barrier_post(unsigned* bar, volatile LAS unsigned* st) {
    XcdBarrier b; b.bar = bar; b.x = xb_xcc_id(); b.st = st;
    if (threadIdx.x == 0) (void)xb_add(&bar[XB_XCNT(b.x)], 1u);
    return b;
}
DI void xcd_barrier_complete(unsigned* bar, unsigned x, unsigned& nloc, unsigned& nx) {
    const unsigned G = gridDim.x * gridDim.y * gridDim.z;
    unsigned sum, cnt, mine, sp = 0u;
    for (;;) {
        sum = 0u; cnt = 0u; mine = 0u;
#pragma unroll
        for (unsigned j = 0; j < 16; ++j) { const unsigned c = xb_ld(&bar[XB_XCNT(j)]); sum += c; cnt += (c > 0u) ? 1u : 0u; mine = (j == x) ? c : mine; }
        if (sum == G) break;
        __builtin_amdgcn_s_sleep(1);
        if ((++sp & 255u) == 0u) { if (xb_ld(&bar[XB_TMO])) break; if (sp > XB_SPIN_CAP) { atomicAdd(&bar[XB_TMO], 1u); break; } }
    }
    nloc = mine > 0u ? mine : 1u; nx = cnt > 0u ? cnt : 1u;
}
DI void xcd_barrier(const XcdBarrier& b) {
    asm volatile("s_waitcnt vmcnt(0)" ::: "memory");
    __syncthreads();
    if (threadIdx.x == 0) {
        unsigned* bar = b.bar;
        __builtin_amdgcn_s_waitcnt(0);
        unsigned nloc = b.st[0], nx = b.st[1];
        if (nloc == 0u) { xcd_barrier_complete(bar, b.x, nloc, nx); b.st[0] = nloc; b.st[1] = nx; }
        const unsigned old = xb_add(&bar[XB_XSUB(b.x)], 1u);
        const unsigned gen = old / nloc;
        if (old + 1u == (gen + 1u) * nloc) {
            __builtin_amdgcn_fence(__ATOMIC_RELEASE, "agent");
            asm volatile("s_waitcnt vmcnt(0)" ::: "memory");
            const unsigned og = xb_add(&bar[XB_TOP], 1u);
            const unsigned tg = og / nx;
            if (og + 1u == (tg + 1u) * nx) xb_add(&bar[XB_TOPGEN], 1u);
            else XB_SPIN(xb_ld(&bar[XB_TOPGEN]) == tg, bar);
            __builtin_amdgcn_fence(__ATOMIC_ACQUIRE, "agent");
            xb_add(&bar[XB_XGEN(b.x)], 1u);
            asm volatile("s_waitcnt vmcnt(0)" ::: "memory");
        } else {
            XB_SPIN(xb_ld(&bar[XB_XGEN(b.x)]) == gen, bar);
            __builtin_amdgcn_fence(__ATOMIC_ACQUIRE, "agent");
            asm volatile("s_waitcnt vmcnt(0)" ::: "memory");
        }
    }
    __syncthreads();
}

namespace pg8 {
constexpr int BM = 256, BK = 64, HALF = 128, HTB = HALF * BK * 2, NXCD = 8, WGM = 8;
DI int lds_byte(int r, int c) { const int st = (r >> 4) * 2 + (c >> 5), rr = r & 15, cc = c & 31, ob = rr * 64 + cc * 2; return st * 1024 + (ob ^ (((ob >> 9) & 1) << 5)); }
DI void stage_rc(int b, int& R, int& C) { const int st = b / 1024, sb = b % 1024, swz = sb ^ (((sb >> 9) & 1) << 5); R = (st >> 1) * 16 + swz / 64; C = (st & 1) * 32 + (swz % 64) / 2; }
DI int perm32(int rho) { const int n = rho >> 4, i = rho & 15; return 8 * (i >> 2) + 4 * n + (i & 3); }
struct Unit { int pm, pn, e, t; };
DI unsigned cvt_pk_bf16(float lo, float hi) { unsigned r; asm volatile("v_cvt_pk_bf16_f32 %0, %1, %2" : "=v"(r) : "v"(lo), "v"(hi)); return r; }

struct DenseSched {
    static constexpr bool PER_UNIT_A = false;
    const bf16_t* A; const bf16_t* Bt; int lda, ldb; int nM, nN, nwg, G, c;
    DI void init(const bf16_t* A_, const bf16_t* Bt_, int lda_, int ldb_, int M, int N, int G_, int c_) { A = A_; Bt = Bt_; lda = lda_; ldb = ldb_; nM = M / BM; nN = N / BM; nwg = nM * nN; G = G_; c = c_; }
    DI bool next(int i, Unit& u) const {
        const long L = (long)i * G + c; if (L >= nwg) return false;
        int wgid = (int)L; { const int q = nwg / NXCD, r = nwg % NXCD, xcd = wgid % NXCD, off = wgid / NXCD; wgid = (xcd < r ? xcd * (q + 1) : r * (q + 1) + (xcd - r) * q) + off; }
        const int nig = WGM * nN, gid = wgid / nig, fm = gid * WGM, gsz = (nM - fm) < WGM ? (nM - fm) : WGM;
        u.pm = fm + ((wgid % nig) % gsz); u.pn = (wgid % nig) / gsz; u.e = 0; u.t = 0; return true;
    }
    DI const char* abase(const Unit& u) const { return (const char*)A + (size_t)u.pm * BM * lda * 2; }
    DI const char* bbase(const Unit& u) const { return (const char*)Bt + (size_t)u.pn * BM * ldb * 2; }
    DI void avoff(const Unit&, const int (&R)[2], const int (&C)[2], unsigned (&va)[2][2]) const {
#pragma unroll
        for (int h = 0; h < 2; ++h)
#pragma unroll
            for (int i = 0; i < 2; ++i) va[h][i] = (unsigned)((h * HALF + R[i]) * lda + C[i]) * 2u;
    }
};
template <bool GATHER> struct MoeSched {
    static constexpr bool PER_UNIT_A = GATHER;
    const bf16_t* A; const bf16_t* Bt; int lda, ldb; size_t bexp;
    const int* pair; const volatile LAS int* toff; const volatile LAS int* cnt; int NPN, G, c;
    DI bool next(int i, Unit& u) const {
        const int T = __builtin_amdgcn_readfirstlane(toff[NEXP]); const int L = i * G + c; if (L >= T * NPN) return false;
        const int ti = L / NPN; u.pn = L % NPN; int e = 0;
#pragma unroll 1
        for (int j = 1; j < NEXP; ++j) e = (__builtin_amdgcn_readfirstlane(toff[j]) <= ti) ? j : e;
        u.pm = ti; u.e = e; u.t = ti - __builtin_amdgcn_readfirstlane(toff[e]); return true;
    }
    DI const char* abase(const Unit& u) const { return GATHER ? (const char*)A : (const char*)A + (size_t)u.pm * BM * lda * 2; }
    DI const char* bbase(const Unit& u) const { return (const char*)Bt + ((size_t)u.e * bexp + (size_t)u.pn * BM * ldb) * 2; }
    DI void avoff(const Unit& u, const int (&R)[2], const int (&C)[2], unsigned (&va)[2][2]) const {
        const int n = __builtin_amdgcn_readfirstlane(cnt[u.e]);
#pragma unroll
        for (int h = 0; h < 2; ++h)
#pragma unroll
            for (int i = 0; i < 2; ++i) {
                if (GATHER) { const int slot = u.t * BM + h * HALF + R[i]; const int tok = (slot < n) ? (pair[(size_t)u.e * PAIRCAP + slot] >> 1) : 0; va[h][i] = (unsigned)(tok * lda + C[i]) * 2u; }
                else va[h][i] = (unsigned)((h * HALF + R[i]) * lda + C[i]) * 2u;
            }
    }
};

template <class Epi, class Sched>
DI void gemm_phase(LAS unsigned char* lds, const Sched& S, const Epi& E, const int K, const int ldb) {
    int tid_ = threadIdx.x; asm volatile("" : "+v"(tid_));
    const int tid = tid_, wid = __builtin_amdgcn_readfirstlane(tid >> 6), lane = tid & 63, wr = wid >> 2, wc = wid & 3, fr = lane & 15, fq = lane >> 4;
    int nt = K / BK; asm volatile("" : "+s"(nt));
    int Rr[2], Cc[2]; unsigned vb[2];
#pragma unroll
    for (int i = 0; i < 2; ++i) { stage_rc(tid * 16 + i * 8192, Rr[i], Cc[i]); const int Rb = (Rr[i] & ~31) + perm32(Rr[i] & 31); vb[i] = (unsigned)(Rb * ldb + Cc[i]) * 2u; }
    const size_t kstep = (size_t)(BK * 2);
    const size_t hstepB = (size_t)HALF * ldb * 2;
    const unsigned ldsw = (unsigned)wid * 1024u;
    const int aoff = lds_byte(wr * 64 + fr, fq * 8), boff = lds_byte(wc * 32 + fr, fq * 8);
#define PG8_SA(b, h) (((b) * 2 + (h)) * HTB)
#define PG8_SB(b, h) ((4 + (b) * 2 + (h)) * HTB)
#define PG8_STAGE_A(b, h, gbase, VA) do { _Pragma("unroll") for (int _i = 0; _i < 2; ++_i) \
        __builtin_amdgcn_global_load_lds((const unsigned*)((const char*)(gbase) + (VA)[h][_i]), (LAS unsigned*)(lds + PG8_SA(b, h) + ldsw + _i * 8192), 16, 0, 0); } while (0)
#define PG8_STAGE_B(b, h, gbase) do { _Pragma("unroll") for (int _i = 0; _i < 2; ++_i) \
        __builtin_amdgcn_global_load_lds((const unsigned*)((const char*)(gbase) + (h) * hstepB + vb[_i]), (LAS unsigned*)(lds + PG8_SB(b, h) + ldsw + _i * 8192), 16, 0, 0); } while (0)
#define PG8_LDA(dst, b, h) do { _Pragma("unroll") for (int m = 0; m < 4; ++m) _Pragma("unroll") for (int k = 0; k < 2; ++k) dst[m][k] = *(const LAS bf16x8*)(lds + PG8_SA(b, h) + aoff + m * 2048 + k * 1024); } while (0)
#define PG8_LDB(dst, b, h) do { _Pragma("unroll") for (int n = 0; n < 2; ++n) _Pragma("unroll") for (int k = 0; k < 2; ++k) dst[n][k] = *(const LAS bf16x8*)(lds + PG8_SB(b, h) + boff + n * 2048 + k * 1024); } while (0)
#define PG8_MMA(ai, bj, At, Bt) do { __builtin_amdgcn_s_setprio(1); _Pragma("unroll") for (int m = 0; m < 4; ++m) _Pragma("unroll") for (int n = 0; n < 2; ++n) _Pragma("unroll") for (int k = 0; k < 2; ++k) \
        acc[ai][bj][m][n] = __builtin_amdgcn_mfma_f32_16x16x32_bf16(Bt[n][k], At[m][k], acc[ai][bj][m][n], 0, 0, 0); __builtin_amdgcn_s_setprio(0); } while (0)
#define PG8_WAIT_V(n) asm volatile("s_waitcnt vmcnt(" #n ")" ::: "memory")
#define PG8_WAIT_L(n) asm volatile("s_waitcnt lgkmcnt(" #n ")" ::: "memory")
#define PG8_BAR __builtin_amdgcn_s_barrier()
#define PG8_SCHED __builtin_amdgcn_sched_barrier(0)
    Unit cur, nxt; int ui = 0;
    if (!S.next(0, cur)) return;
    f32x4 acc[2][2][4][2];
#pragma unroll
    for (int a = 0; a < 2; ++a)
#pragma unroll
        for (int b = 0; b < 2; ++b)
#pragma unroll
            for (int m = 0; m < 4; ++m)
#pragma unroll
                for (int n = 0; n < 2; ++n) acc[a][b][m][n] = (f32x4){0.f, 0.f, 0.f, 0.f};
    bf16x8 At[4][2], B0[2][2], B1[2][2];
    unsigned va[2][2];
    const char* cA = S.abase(cur); const char* cB = S.bbase(cur);
    S.avoff(cur, Rr, Cc, va);
    PG8_STAGE_B(0, 0, cB); PG8_STAGE_B(0, 1, cB); PG8_STAGE_A(0, 0, cA, va); PG8_STAGE_A(0, 1, cA, va);
    if (wr == 1) PG8_BAR;
    PG8_WAIT_V(2); PG8_BAR;
    PG8_STAGE_B(1, 0, cB + kstep); PG8_STAGE_A(1, 0, cA + kstep, va); PG8_STAGE_B(1, 1, cB + kstep);
    PG8_WAIT_V(6); PG8_BAR;
    for (;;) {
        const bool has_next = S.next(ui + 1, nxt);
        const char* nA = cA; const char* nB = cB;
        if (has_next) { nA = S.abase(nxt); nB = S.bbase(nxt); }
        for (int t = 0; t < nt; t += 2) {
            const bool last = (t == nt - 2);
            const char* a1 = cA + (size_t)(t + 1) * kstep;
            const char* a2 = last ? nA : cA + (size_t)(t + 2) * kstep; const char* b2 = last ? nB : cB + (size_t)(t + 2) * kstep;
            const char* a3 = a2 + kstep; const char* b3 = b2 + kstep;
            PG8_LDB(B0, 0, 0); PG8_LDB(B1, 0, 1); PG8_SCHED; PG8_LDA(At, 0, 0); PG8_STAGE_A(1, 1, a1, va);
            if (Sched::PER_UNIT_A && last && has_next) S.avoff(nxt, Rr, Cc, va);
            PG8_WAIT_V(8); PG8_WAIT_L(0); PG8_BAR; PG8_MMA(0, 0, At, B0); PG8_MMA(0, 1, At, B1); PG8_BAR; PG8_SCHED;
            PG8_LDA(At, 0, 1); PG8_STAGE_B(0, 0, b2); PG8_STAGE_B(0, 1, b2); PG8_STAGE_A(0, 0, a2, va);
            PG8_WAIT_V(8); PG8_WAIT_L(0); PG8_BAR; PG8_MMA(1, 0, At, B0); PG8_MMA(1, 1, At, B1); PG8_BAR; PG8_SCHED;
            PG8_LDB(B0, 1, 0); PG8_LDB(B1, 1, 1); PG8_SCHED; PG8_LDA(At, 1, 0); PG8_STAGE_A(0, 1, a2, va);
            PG8_WAIT_V(8); PG8_WAIT_L(0); PG8_BAR; PG8_MMA(0, 0, At, B0); PG8_MMA(0, 1, At, B1); PG8_BAR; PG8_SCHED;
            PG8_LDA(At, 1, 1); PG8_STAGE_B(1, 0, b3); PG8_STAGE_B(1, 1, b3); PG8_STAGE_A(1, 0, a3, va);
            PG8_WAIT_V(8); PG8_WAIT_L(0); PG8_BAR; PG8_MMA(1, 0, At, B0); PG8_MMA(1, 1, At, B1); PG8_BAR; PG8_SCHED;
        }
        E(acc, cur, wr, wc, fr, fq);
        if (!has_next) break;
#pragma unroll
        for (int a = 0; a < 2; ++a)
#pragma unroll
            for (int b = 0; b < 2; ++b)
#pragma unroll
                for (int m = 0; m < 4; ++m)
#pragma unroll
                    for (int n = 0; n < 2; ++n) acc[a][b][m][n] = (f32x4){0.f, 0.f, 0.f, 0.f};
        cur = nxt; cA = nA; cB = nB; ++ui;
    }
    PG8_WAIT_V(0);
    if (wr == 0) PG8_BAR;
    PG8_BAR;
#undef PG8_SA
#undef PG8_SB
#undef PG8_STAGE_A
#undef PG8_STAGE_B
#undef PG8_LDA
#undef PG8_LDB
#undef PG8_MMA
#undef PG8_WAIT_V
#undef PG8_WAIT_L
#undef PG8_BAR
#undef PG8_SCHED
}

struct EpiBf16 {
    bf16_t* O; int ldc;
    DI void operator()(const f32x4 (&acc)[2][2][4][2], const Unit& u, int wr, int wc, int fr, int fq) const {
        asm volatile("" : "+v"(fr), "+v"(fq));
        const int row0 = u.pm * BM + wr * 64 + fr, col0 = u.pn * BM + wc * 32 + 8 * fq;
#pragma unroll
        for (int ai = 0; ai < 2; ++ai)
#pragma unroll
            for (int m = 0; m < 4; ++m) { bf16_t* rowp = O + (size_t)(row0 + ai * HALF + m * 16) * ldc + col0;
#pragma unroll
                for (int bj = 0; bj < 2; ++bj) { const f32x4 v0 = acc[ai][bj][m][0], v1 = acc[ai][bj][m][1];
                    u32x4 w; w.x = cvt_pk_bf16(v0[0], v0[1]); w.y = cvt_pk_bf16(v0[2], v0[3]); w.z = cvt_pk_bf16(v1[0], v1[1]); w.w = cvt_pk_bf16(v1[2], v1[3]);
                    *(u32x4*)(rowp + bj * HALF) = w; } }
    }
};
struct EpiResid {
    float* xl; float* xc; const float* gate;
    DI void operator()(const f32x4 (&acc)[2][2][4][2], const Unit& u, int wr, int wc, int fr, int fq) const {
        asm volatile("" : "+v"(fr), "+v"(fq));
        const int rt = u.pm * BM; const int vec = rt < SEQ ? 0 : (rt < ML ? 1 : 2);
        float* xb = rt < ML ? xl + (size_t)rt * D : xc + (size_t)(rt - ML) * D;
        const int row0 = wr * 64 + fr, col0 = u.pn * BM + wc * 32 + 8 * fq;
        const float* g = gate + vec * 6144 + col0;
        f32x4 gv[2][2];
#pragma unroll
        for (int bj = 0; bj < 2; ++bj)
#pragma unroll
            for (int n = 0; n < 2; ++n) gv[bj][n] = *(const f32x4*)(g + bj * HALF + 4 * n);
#pragma unroll
        for (int ai = 0; ai < 2; ++ai)
#pragma unroll
            for (int m = 0; m < 4; ++m) { float* rowp = xb + (size_t)(row0 + ai * HALF + m * 16) * D + col0;
#pragma unroll
                for (int bj = 0; bj < 2; ++bj)
#pragma unroll
                    for (int n = 0; n < 2; ++n) { f32x4* p = (f32x4*)(rowp + bj * HALF + 4 * n); f32x4 xv = *p; xv = xv + gv[bj][n] * acc[ai][bj][m][n]; *p = xv; } }
    }
};
struct EpiMoeUp {
    bf16_t* ACT; const float* pw; const volatile LAS int* cnt;
    DI void operator()(const f32x4 (&acc)[2][2][4][2], const Unit& u, int wr, int wc, int fr, int fq) const {
        asm volatile("" : "+v"(fr), "+v"(fq));
        const int n_e = __builtin_amdgcn_readfirstlane(cnt[u.e]); const int col0 = u.pn * 128 + wc * 32 + 8 * fq;
#pragma unroll
        for (int ai = 0; ai < 2; ++ai)
#pragma unroll
            for (int m = 0; m < 4; ++m) { const int rt = wr * 64 + fr + ai * HALF + m * 16; const int slot = u.t * BM + rt;
                const float w = slot < n_e ? pw[(size_t)u.e * PAIRCAP + slot] : 0.f;
                float a[8];
#pragma unroll
                for (int n = 0; n < 2; ++n)
#pragma unroll
                    for (int j = 0; j < 4; ++j) { const float g = acc[ai][0][m][n][j], up = acc[ai][1][m][n][j]; a[n * 4 + j] = siluf(g) * up * w; }
                u32x4 o; o.x = cvt_pk_bf16(a[0], a[1]); o.y = cvt_pk_bf16(a[2], a[3]); o.z = cvt_pk_bf16(a[4], a[5]); o.w = cvt_pk_bf16(a[6], a[7]);
                *(u32x4*)(ACT + ((size_t)u.pm * BM + rt) * DE + col0) = o; }
    }
};
struct EpiMoeDown {
    bf16_t* Y; const int* pair; const volatile LAS int* cnt;
    DI void operator()(const f32x4 (&acc)[2][2][4][2], const Unit& u, int wr, int wc, int fr, int fq) const {
        asm volatile("" : "+v"(fr), "+v"(fq));
        const int n_e = __builtin_amdgcn_readfirstlane(cnt[u.e]); const int col0 = u.pn * BM + wc * 32 + 8 * fq;
#pragma unroll
        for (int ai = 0; ai < 2; ++ai)
#pragma unroll
            for (int m = 0; m < 4; ++m) { const int rt = wr * 64 + fr + ai * HALF + m * 16; const int slot = u.t * BM + rt;
                if (slot < n_e) { const int pr = pair[(size_t)u.e * PAIRCAP + slot]; bf16_t* rowp = Y + (size_t)pr * D + col0;
#pragma unroll
                    for (int bj = 0; bj < 2; ++bj) { const f32x4 v0 = acc[ai][bj][m][0], v1 = acc[ai][bj][m][1];
                        u32x4 w; w.x = cvt_pk_bf16(v0[0], v0[1]); w.y = cvt_pk_bf16(v0[2], v0[3]); w.z = cvt_pk_bf16(v1[0], v1[1]); w.w = cvt_pk_bf16(v1[2], v1[3]);
                        *(u32x4*)(rowp + bj * HALF) = w; } } }
    }
};
}

template <int KS> DI void wmma32(f32x16& acc, const LAS bf16_t* As, int lda, const LAS bf16_t* Bs, int ldb, int r32, int hi) {
#pragma unroll
    for (int ks = 0; ks < KS; ++ks) {
        const bf16x8 a = *(const LAS bf16x8*)(As + r32 * lda + ks * 16 + hi * 8);
        const bf16x8 b = *(const LAS bf16x8*)(Bs + r32 * ldb + ks * 16 + hi * 8);
        acc = __builtin_amdgcn_mfma_f32_32x32x16_bf16(a, b, acc, 0, 0, 0);
    }
}
DI float scan_incl(float x, int lane, bool suffix) {
#pragma unroll
    for (int off = 1; off < 64; off <<= 1) { const float v = sh_idx(x, suffix ? ((lane + off) & 63) : ((lane - off) & 63)); const bool ok = suffix ? (lane + off < 64) : (lane >= off); x += ok ? v : 0.f; }
    return x;
}
DI float scan_max(float x, int lane, bool suffix) {
#pragma unroll
    for (int off = 1; off < 64; off <<= 1) { const float v = sh_idx(x, suffix ? ((lane + off) & 63) : ((lane - off) & 63)); const bool ok = suffix ? (lane + off < 64) : (lane >= off); x = ok ? fmaxf(x, v) : x; }
    return x;
}
DI void unpack8(const u32x4 v, float (&f)[8]) {
    f[0] = bf2f(v.x & 0xffffu); f[1] = bf2f(v.x >> 16); f[2] = bf2f(v.y & 0xffffu); f[3] = bf2f(v.y >> 16);
    f[4] = bf2f(v.z & 0xffffu); f[5] = bf2f(v.z >> 16); f[6] = bf2f(v.w & 0xffffu); f[7] = bf2f(v.w >> 16);
}
DI u32x4 pack8(const float (&f)[8]) { u32x4 o; o.x = pk2(f[0], f[1]); o.y = pk2(f[2], f[3]); o.z = pk2(f[4], f[5]); o.w = pk2(f[6], f[7]); return o; }

struct WS {
    unsigned char* ws;
    DI unsigned* ctl() const { return (unsigned*)(ws + WS_CTL); }
    DI float* mods() const { return (float*)(ws + WS_MODS); }
    DI float* rope() const { return (float*)(ws + WS_ROPE); }
    DI float* xc() const { return (float*)(ws + WS_XC); }
    DI bf16_t* wl(int l, size_t off) const { return (bf16_t*)(ws + WS_WL + (size_t)l * WL_STRIDE + off); }
    DI bf16_t* wgu() const { return (bf16_t*)(ws + WS_WGU); }
    DI bf16_t* wdn() const { return (bf16_t*)(ws + WS_WDN); }
    DI bf16_t* proj() const { return (bf16_t*)(ws + WS_A); }
    DI bf16_t* y() const { return (bf16_t*)(ws + WS_A); }
    DI bf16_t* qkvraw() const { return (bf16_t*)(ws + WS_B); }
    DI bf16_t* mix() const { return (bf16_t*)(ws + WS_B); }
    DI bf16_t* act() const { return (bf16_t*)(ws + WS_ACT); }
    DI bf16_t* h() const { return (bf16_t*)(ws + WS_H); }
    DI bf16_t* cqn() const { return (bf16_t*)(ws + WS_CQ); }
    DI bf16_t* xconv() const { return (bf16_t*)(ws + WS_XCONV); }
    DI bf16_t* mqk() const { return (bf16_t*)(ws + WS_MQK); }
    DI bf16_t* q() const { return (bf16_t*)(ws + WS_Q); }
    DI bf16_t* k() const { return (bf16_t*)(ws + WS_K); }
    DI bf16_t* v() const { return (bf16_t*)(ws + WS_V); }
    DI float* gates() const { return (float*)(ws + WS_GATES); }
    DI float* loga() const { return (float*)(ws + WS_LOGA); }
    DI float* mu() const { return (float*)(ws + WS_MU); }
    DI float* mn() const { return (float*)(ws + WS_MN); }
    DI float* ms() const { return (float*)(ws + WS_MS); }
    DI float* gu() const { return (float*)(ws + WS_GU); }
    DI float* gd() const { return (float*)(ws + WS_GD); }
    DI int* pair() const { return (int*)(ws + WS_PAIR); }
    DI float* pw() const { return (float*)(ws + WS_PW); }
};
enum { I_X = 0, I_C, I_CTX, I_CCTX, I_WMOD, I_BMOD, I_N1W, I_WIN, I_QAN, I_WUQ, I_KVAN, I_WUKV, I_QNW, I_KNW, I_MCW, I_MCB, I_MWQ, I_MWK, I_MGB, I_MNW, I_MSK,
       I_GWA, I_GBA, I_GNW, I_WOUT, I_N2W, I_WGRP, I_BGRP, I_WER, I_BER, I_WG, I_WU, I_WD };

DI void tr_item(const float* W, int N, int nvalid, bf16_t* WT, int ldd, int k0, int n0, int drow0, int dcol0, LAS float* scr, int lane) {
#pragma unroll 8
    for (int i = 0; i < 32; ++i) { const int kk = 2 * i + (lane >> 5); const int n = n0 + (lane & 31); scr[kk * 33 + (lane & 31)] = (n < nvalid) ? W[(size_t)(k0 + kk) * N + n] : 0.f; }
    LDS_WAIT(); asm volatile("" ::: "memory");
    const int c = lane & 7;
#pragma unroll
    for (int j = 0; j < 4; ++j) { const int n = (lane >> 3) + 8 * j; const LAS float* s = scr + (8 * c) * 33 + n;
        u32x4 o; o.x = pk2(s[0 * 33], s[1 * 33]); o.y = pk2(s[2 * 33], s[3 * 33]); o.z = pk2(s[4 * 33], s[5 * 33]); o.w = pk2(s[6 * 33], s[7 * 33]);
        *(u32x4*)(WT + (size_t)(drow0 + n) * ldd + dcol0 + k0 + 8 * c) = o; }
    LDS_WAIT(); asm volatile("" ::: "memory");
}

DI void phase_prologue(KArgs a, const WS& W, LAS unsigned char* lds) {
    int tid_ = threadIdx.x; asm volatile("" : "+v"(tid_)); const int tid = tid_, lane = tid & 63, wid = __builtin_amdgcn_readfirstlane(tid >> 6);
    const int G = gridDim.x, gw = blockIdx.x * 8 + wid, NGW = G * 8, gt = blockIdx.x * 512 + tid, NGT = G * 512;
    LAS float* scr = (LAS float*)(lds + wid * WSCR);
    constexpr int IT_IN = 16 * 64, IT_UQ = 4 * 24, IT_UKV = 2 * 32, IT_OUT = 16 * 32, IT_L = IT_IN + IT_UQ + IT_UKV + IT_OUT;
    for (int it = gw; it < DEPTH * IT_L; it += NGW) {
        const int l = it / IT_L; int r = it % IT_L;
        if (r < IT_IN) { const int kb = r / 64, nb = r % 64; tr_item(a->in[I_WIN] + (size_t)l * D * 2000, 2000, 2000, W.wl(l, WL_IN), 1024, 64 * kb, 32 * nb, 32 * nb, 0, scr, lane); continue; } r -= IT_IN;
        if (r < IT_UQ) { const int kb = r / 24, nb = r % 24; tr_item(a->in[I_WUQ] + (size_t)l * 256 * 768, 768, 768, W.wl(l, WL_UP), 384, 64 * kb, 32 * nb, 32 * nb, 0, scr, lane); continue; } r -= IT_UQ;
        if (r < IT_UKV) { const int kb = r / 32, nb = r % 32; tr_item(a->in[I_WUKV] + (size_t)l * 128 * 1024, 1024, 1024, W.wl(l, WL_UP), 384, 64 * kb, 32 * nb, 768 + 32 * nb, 256, scr, lane); continue; } r -= IT_UKV;
        { const int kb = r / 32, nb = r % 32; tr_item(a->in[I_WOUT] + (size_t)l * D * D, 1024, 1024, W.wl(l, WL_OUT), 1024, 64 * kb, 32 * nb, 32 * nb, 0, scr, lane); }
    }
    for (int i = gt; i < DEPTH * (768 * 16 + 1024 * 32); i += NGT) {
        const int l = i / (768 * 16 + 1024 * 32); int r = i % (768 * 16 + 1024 * 32); bf16_t* wu = W.wl(l, WL_UP);
        if (r < 768 * 16) { const int row = r / 16, c = r % 16; *(u32x4*)(wu + (size_t)row * 384 + 256 + c * 8) = (u32x4){0u, 0u, 0u, 0u}; }
        else { r -= 768 * 16; const int row = 768 + r / 32, c = r % 32; *(u32x4*)(wu + (size_t)row * 384 + c * 8) = (u32x4){0u, 0u, 0u, 0u}; }
    }
    for (int i = gt; i < DEPTH * 512 * 256; i += NGT) {
        const int l = i / (512 * 256), r = i % (512 * 256), n = r / 256, kc = r % 256, hs = (n & 255) >> 6, e = n & 63;
        float v = 0.f;
        if ((kc >> 6) == hs) { const float* src = (n < 256 ? a->in[I_MWQ] : a->in[I_MWK]) + (size_t)l * 4 * 64 * 64; v = src[(hs * 64 + (kc & 63)) * 64 + e]; if (n < 256) v *= 0.125f; }
        W.wl(l, WL_MQK)[r] = (bf16_t)f2bf(v);
    }
    for (int i = gt; i < SEQ * 16; i += NGT) {
        const int t = i >> 4, p = i & 15; const float inv = powf(10000.f, -(float)(p & 7) / 8.f);
        const float ang = (float)(p < 8 ? (t >> 6) : (t & 63)) * inv;
        W.rope()[i] = cosf(ang); W.rope()[SEQ * 16 + i] = sinf(ang);
    }
    for (int i = gt; i < ML * D / 4; i += NGT) ((f32x4*)a->out)[i] = ((const f32x4*)a->in[I_X])[i];
    for (int i = gt; i < MC * D / 4; i += NGT) ((f32x4*)W.xc())[i] = ((const f32x4*)a->in[I_CTX])[i];
    {
        LAS float* sv = (LAS float*)lds;
        LAS float* red = (LAS float*)(lds + 12288);
        __syncthreads();
        for (int i = tid; i < 3 * 1024; i += 512) { const int vsel = i >> 10, k = i & 1023; const float c = vsel < 2 ? a->in[I_C][vsel * 1024 + k] : a->in[I_CCTX][k]; sv[i] = siluf(c); }
        __syncthreads();
        for (int it = blockIdx.x; it < DEPTH * 48; it += G) {
            const int l = it / 48, n0 = (it % 48) * 128, col = tid & 127, kg = tid >> 7;
            const float* wm = a->in[I_WMOD] + (size_t)l * D * 6144 + n0 + col;
            float s0 = 0.f, s1 = 0.f, s2 = 0.f;
#pragma unroll 8
            for (int k = kg * 256; k < kg * 256 + 256; ++k) { const float w = wm[(size_t)k * 6144]; s0 += sv[k] * w; s1 += sv[1024 + k] * w; s2 += sv[2048 + k] * w; }
            red[(kg * 3 + 0) * 128 + col] = s0; red[(kg * 3 + 1) * 128 + col] = s1; red[(kg * 3 + 2) * 128 + col] = s2;
            __syncthreads();
            if (tid < 384) { const int vsel = tid >> 7, c = tid & 127; const float s = red[(0 * 3 + vsel) * 128 + c] + red[(1 * 3 + vsel) * 128 + c] + red[(2 * 3 + vsel) * 128 + c] + red[(3 * 3 + vsel) * 128 + c];
                W.mods()[(size_t)(l * 3 + vsel) * 6144 + n0 + c] = s + a->in[I_BMOD][l * 6144 + n0 + c]; }
            __syncthreads();
        }
    }
}

DI void moe_weights(KArgs a, const WS& W, int l, LAS unsigned char* lds) {
    int tid_ = threadIdx.x; asm volatile("" : "+v"(tid_)); const int tid = tid_, lane = tid & 63, wid = __builtin_amdgcn_readfirstlane(tid >> 6);
    const int gw = blockIdx.x * 8 + wid, NGW = gridDim.x * 8;
    LAS float* scr = (LAS float*)(lds + wid * WSCR);
    constexpr int IT_G = 16 * 8, IT_D = 4 * 32;
    for (int it = gw; it < NEXP * (2 * IT_G + IT_D); it += NGW) {
        const int e = it / (2 * IT_G + IT_D); int r = it % (2 * IT_G + IT_D);
        if (r < 2 * IT_G) { const int up = r / IT_G; r %= IT_G; const int kb = r / 8, nb = r % 8, n0 = 32 * nb;
            const float* src = (up ? a->in[I_WU] : a->in[I_WG]) + (size_t)(l * NEXP + e) * D * DE;
            tr_item(src, DE, DE, W.wgu() + (size_t)e * 512 * D, D, 64 * kb, n0, 256 * (n0 >> 7) + (n0 & 127) + (up ? 128 : 0), 0, scr, lane); }
        else { r -= 2 * IT_G; const int kb = r / 32, nb = r % 32;
            tr_item(a->in[I_WD] + (size_t)(l * NEXP + e) * DE * D, D, D, W.wdn() + (size_t)e * D * DE, DE, 64 * kb, 32 * nb, 32 * nb, 0, scr, lane); }
    }
}

DI void phase_norm1(KArgs a, const WS& W, int l, int lc, bool combine, bool donorm, int nrows) {
    int tid_ = threadIdx.x; asm volatile("" : "+v"(tid_)); const int tid = tid_, lane = tid & 63, wid = __builtin_amdgcn_readfirstlane(tid >> 6);
    const int gw = blockIdx.x * 8 + wid, NGW = gridDim.x * 8;
    for (int row = gw; row < nrows; row += NGW) {
        float* xr = row < ML ? a->out + (size_t)row * D : W.xc() + (size_t)(row - ML) * D;
        const int vec = row < SEQ ? 0 : (row < ML ? 1 : 2);
        f32x4 v[4];
#pragma unroll
        for (int j = 0; j < 4; ++j) v[j] = *(const f32x4*)(xr + 4 * lane + 256 * j);
        if (combine) {
            const float* g2 = W.mods() + (size_t)(lc * 3 + vec) * 6144 + 5 * 1024;
            const bf16_t* y0 = W.y() + (size_t)(2 * row) * D; const bf16_t* y1 = y0 + D;
#pragma unroll
            for (int j = 0; j < 4; ++j) { const int c = 4 * lane + 256 * j; const f32x4 g = *(const f32x4*)(g2 + c); const u32x2 a0 = *(const u32x2*)(y0 + c), a1 = *(const u32x2*)(y1 + c);
                v[j][0] += g[0] * (bf2f(a0.x & 0xffffu) + bf2f(a1.x & 0xffffu)); v[j][1] += g[1] * (bf2f(a0.x >> 16) + bf2f(a1.x >> 16));
                v[j][2] += g[2] * (bf2f(a0.y & 0xffffu) + bf2f(a1.y & 0xffffu)); v[j][3] += g[3] * (bf2f(a0.y >> 16) + bf2f(a1.y >> 16));
                *(f32x4*)(xr + c) = v[j]; }
        }
        if (donorm) {
            float ss = 0.f;
#pragma unroll
            for (int j = 0; j < 4; ++j) ss += (v[j][0] * v[j][0] + v[j][1] * v[j][1]) + (v[j][2] * v[j][2] + v[j][3] * v[j][3]);
            const float r = rsqrtf(wave_sum(ss, lane) * (1.f / D) + EPS);
            const float* md = W.mods() + (size_t)(l * 3 + vec) * 6144; const float* nw = a->in[I_N1W] + l * D;
            bf16_t* hr = W.h() + (size_t)row * D;
#pragma unroll
            for (int j = 0; j < 4; ++j) { const int c = 4 * lane + 256 * j; const f32x4 w = *(const f32x4*)(nw + c), sh = *(const f32x4*)(md + c), sc = *(const f32x4*)(md + 1024 + c);
                float o[4];
#pragma unroll
                for (int i = 0; i < 4; ++i) o[i] = v[j][i] * r * w[i] * (1.f + sc[i]) + sh[i];
                u32x2 p; p.x = pk2(o[0], o[1]); p.y = pk2(o[2], o[3]); *(u32x2*)(hr + c) = p; }
        }
    }
}

DI void phase_prep(KArgs a, const WS& W, int l, LAS unsigned char* lds) {
    int tid_ = threadIdx.x; asm volatile("" : "+v"(tid_)); const int tid = tid_, lane = tid & 63, wid = __builtin_amdgcn_readfirstlane(tid >> 6);
    const int gw = blockIdx.x * 8 + wid, NGW = gridDim.x * 8;
    LAS float* wa = (LAS float*)lds;
    LAS float* cw = (LAS float*)(lds + 16384);
    __syncthreads();
    for (int i = tid; i < 4096; i += 512) wa[i] = a->in[I_GWA][l * 4096 + i];
    for (int i = tid; i < 1280; i += 512) cw[i] = a->in[I_MCW][l * 1280 + i];
    for (int i = tid; i < 256; i += 512) cw[1280 + i] = a->in[I_MCB][l * 256 + i];
    __syncthreads();
    const bf16_t* proj = W.proj();
    for (int row = gw; row < MA; row += NGW) {
        const bf16_t* pr = proj + (size_t)row * DINP;
        { const u32x2 c = *(const u32x2*)(pr + C_CQ + 4 * lane); float f[4] = {bf2f(c.x & 0xffffu), bf2f(c.x >> 16), bf2f(c.y & 0xffffu), bf2f(c.y >> 16)};
          const float r = rsqrtf(wave_sum((f[0] * f[0] + f[1] * f[1]) + (f[2] * f[2] + f[3] * f[3]), lane) * (1.f / 256.f) + EPS);
          const f32x4 g = *(const f32x4*)(a->in[I_QAN] + l * 256 + 4 * lane);
          u32x2 o; o.x = pk2(f[0] * r * g[0], f[1] * r * g[1]); o.y = pk2(f[2] * r * g[2], f[3] * r * g[3]); *(u32x2*)(W.cqn() + (size_t)row * 384 + 4 * lane) = o; }
        { const unsigned c = *(const unsigned*)(pr + C_CKV + 2 * lane); const float f0 = bf2f(c & 0xffffu), f1 = bf2f(c >> 16);
          const float r = rsqrtf(wave_sum(f0 * f0 + f1 * f1, lane) * (1.f / 128.f) + EPS);
          const f32x2 g = *(const f32x2*)(a->in[I_KVAN] + l * 128 + 2 * lane);
          *(unsigned*)(W.cqn() + (size_t)row * 384 + 256 + 2 * lane) = pk2(f0 * r * g[0], f1 * r * g[1]); }
        { const int s0 = row < ML ? (row / SEQ) * SEQ : ML + ((row - ML) / CTX) * CTX; const int Ls = row < ML ? SEQ : CTX; const int t = row - s0;
          float acc[4];
#pragma unroll
          for (int i = 0; i < 4; ++i) acc[i] = cw[1280 + 4 * lane + i];
#pragma unroll
          for (int k = 0; k < 5; ++k) { const int tt = t + k - 2;
              if (tt >= 0 && tt < Ls) { const u32x2 m = *(const u32x2*)(proj + (size_t)(s0 + tt) * DINP + C_MX + 4 * lane);
                  acc[0] += cw[k * 256 + 4 * lane + 0] * bf2f(m.x & 0xffffu); acc[1] += cw[k * 256 + 4 * lane + 1] * bf2f(m.x >> 16);
                  acc[2] += cw[k * 256 + 4 * lane + 2] * bf2f(m.y & 0xffffu); acc[3] += cw[k * 256 + 4 * lane + 3] * bf2f(m.y >> 16); } }
          u32x2 o; o.x = pk2(siluf(acc[0]), siluf(acc[1])); o.y = pk2(siluf(acc[2]), siluf(acc[3])); *(u32x2*)(W.xconv() + (size_t)row * 256 + 4 * lane) = o; }
        if (lane < 16) { const float g = bf2f(pr[C_MG + lane]) + a->in[I_MGB][l * 16 + lane]; W.gates()[(size_t)row * 16 + lane] = ((lane >> 2) & 1) ? logsigmoidf_(g) : g; }
        { const float av = lane < 32 ? bf2f(pr[C_GA + lane]) : 0.f;
#pragma unroll
          for (int u = 0; u < 2; ++u) { float s0 = a->in[I_GBA][(l * 2 + u) * 128 + lane], s1 = a->in[I_GBA][(l * 2 + u) * 128 + 64 + lane];
#pragma unroll
              for (int r = 0; r < 16; ++r) { const float ar = sh_idx(av, u * 16 + r); s0 += ar * wa[(u * 16 + r) * 128 + lane]; s1 += ar * wa[(u * 16 + r) * 128 + 64 + lane]; }
              float* lo = W.loga() + ((size_t)u * MA + row) * 128; lo[lane] = logsigmoidf_(s0) * (1.f / 16.f); lo[64 + lane] = logsigmoidf_(s1) * (1.f / 16.f); } }
    }
    __syncthreads();
    moe_weights(a, W, l, lds);
}

DI void phase_post(KArgs a, const WS& W, int l, LAS unsigned char* lds) {
    int tid_ = threadIdx.x; asm volatile("" : "+v"(tid_)); const int tid = tid_, lane = tid & 63, wid = __builtin_amdgcn_readfirstlane(tid >> 6);
    const int gw = blockIdx.x * 8 + wid, NGW = gridDim.x * 8;
    const int head = lane >> 3, sub = lane & 7, r32 = lane & 31, hi = lane >> 5;
    const bf16_t* proj = W.proj(); const bf16_t* raw = W.qkvraw();
    for (int row = gw; row < MA; row += NGW) {
        const bool lat = row < ML; const int b = lat ? row / SEQ : (row - ML) / CTX; const int t = lat ? row % SEQ : (row - ML) % CTX; const int kidx = lat ? t : SEQ + t;
        float cs[2], sn[2];
        if (lat) { cs[0] = W.rope()[t * 16 + sub * 2]; cs[1] = W.rope()[t * 16 + sub * 2 + 1]; sn[0] = W.rope()[SEQ * 16 + t * 16 + sub * 2]; sn[1] = W.rope()[SEQ * 16 + t * 16 + sub * 2 + 1]; }
        else { cs[0] = cs[1] = 1.f; sn[0] = sn[1] = 0.f; }
        { const bf16_t* qr = raw + (size_t)row * 1792 + head * 96; float f[8]; unpack8(*(const u32x4*)(qr + sub * 8), f);
          const unsigned u1 = *(const unsigned*)(qr + 64 + sub * 2), u2 = *(const unsigned*)(qr + 80 + sub * 2);
          float x1[2] = {bf2f(u1 & 0xffffu), bf2f(u1 >> 16)}, x2[2] = {bf2f(u2 & 0xffffu), bf2f(u2 >> 16)};
          float ss = x1[0] * x1[0] + x1[1] * x1[1] + x2[0] * x2[0] + x2[1] * x2[1];
#pragma unroll
          for (int i = 0; i < 8; ++i) ss += f[i] * f[i];
          ss += sh_xor(ss, 1, lane); ss += sh_xor(ss, 2, lane); ss += sh_xor(ss, 4, lane);
          const float r = rsqrtf(ss * (1.f / 96.f) + EPS) ; const float* nw = a->in[I_QNW] + l * 96;
#pragma unroll
          for (int i = 0; i < 8; ++i) f[i] = f[i] * r * nw[sub * 8 + i] * QSCALE;
          float o1[2], o2[2];
#pragma unroll
          for (int i = 0; i < 2; ++i) { const float a1 = x1[i] * r * nw[64 + sub * 2 + i], a2 = x2[i] * r * nw[80 + sub * 2 + i]; o1[i] = (a1 * cs[i] - a2 * sn[i]) * QSCALE; o2[i] = (a1 * sn[i] + a2 * cs[i]) * QSCALE; }
          bf16_t* qo = W.q() + ((size_t)(b * NH + head) * NKEY + kidx) * QK;
          *(u32x4*)(qo + sub * 8) = pack8(f); *(unsigned*)(qo + 64 + sub * 2) = pk2(o1[0], o1[1]); *(unsigned*)(qo + 80 + sub * 2) = pk2(o2[0], o2[1]); }
        { const bf16_t* kvr = raw + (size_t)row * 1792 + 768 + head * 128; float f[8]; unpack8(*(const u32x4*)(kvr + sub * 8), f);
          const bf16_t* pr = proj + (size_t)row * DINP + C_KR;
          const unsigned u1 = *(const unsigned*)(pr + sub * 2), u2 = *(const unsigned*)(pr + 16 + sub * 2);
          float x1[2] = {bf2f(u1 & 0xffffu), bf2f(u1 >> 16)}, x2[2] = {bf2f(u2 & 0xffffu), bf2f(u2 >> 16)};
          float ss = x1[0] * x1[0] + x1[1] * x1[1] + x2[0] * x2[0] + x2[1] * x2[1];
#pragma unroll
          for (int i = 0; i < 8; ++i) ss += f[i] * f[i];
          ss += sh_xor(ss, 1, lane); ss += sh_xor(ss, 2, lane); ss += sh_xor(ss, 4, lane);
          const float r = rsqrtf(ss * (1.f / 96.f) + EPS); const float* nw = a->in[I_KNW] + l * 96;
#pragma unroll
          for (int i = 0; i < 8; ++i) f[i] = f[i] * r * nw[sub * 8 + i];
          float o1[2], o2[2];
#pragma unroll
          for (int i = 0; i < 2; ++i) { const float a1 = x1[i] * r * nw[64 + sub * 2 + i], a2 = x2[i] * r * nw[80 + sub * 2 + i]; o1[i] = a1 * cs[i] - a2 * sn[i]; o2[i] = a1 * sn[i] + a2 * cs[i]; }
          const int tile = kidx >> 6, key = kidx & 63;
          bf16_t* kb = W.k() + ((size_t)(b * NH + head) * NTILE + tile) * 6144;
          *(u32x4*)(kb + (sub * 64 + key) * 8) = pack8(f);
          *(unsigned*)(kb + ((8 + (sub >> 2)) * 64 + key) * 8 + (sub & 3) * 2) = pk2(o1[0], o1[1]);
          *(unsigned*)(kb + ((10 + (sub >> 2)) * 64 + key) * 8 + (sub & 3) * 2) = pk2(o2[0], o2[1]);
          bf16_t* vb = W.v() + ((size_t)(b * NH + head) * NTILE + tile) * 4096;
          *(u32x4*)(vb + ((sub >> 2) * 4 + (key >> 4)) * 512 + (key & 15) * 32 + (sub & 3) * 8) = *(const u32x4*)(kvr + 64 + sub * 8); }
    }
    LAS bf16_t* As = (LAS bf16_t*)(lds + wid * WSCR);
    LAS bf16_t* Bs = As + 64 * 72;
    for (int u = gw; u < 2 * 16 * NCH; u += NGW) {
        const int kind = u / (16 * NCH), s = (u % (16 * NCH)) / NCH, gc = u % NCH, b = s >> 3, h = (s >> 1) & 3, dir = s & 1;
        const int row = tokrow(b, gc, lane);
        LDS_WAIT(); asm volatile("" ::: "memory");
        if (kind == 0) {
            const float logi = W.gates()[(size_t)row * 16 + dir * 8 + h], logf = W.gates()[(size_t)row * 16 + dir * 8 + 4 + h];
            const float bc = scan_incl(logf, lane, dir), bend = sh_idx(bc, dir ? 0 : 63), g = bend - bc + logi, gmax = wave_max(g, lane), wj = __expf(g - gmax);
#pragma unroll
            for (int i = 0; i < 8; ++i) { const int p = i * 8 + (lane >> 3), c8 = lane & 7; const int rp = tokrow(b, gc, p);
                float fv[8], fk[8]; unpack8(*(const u32x4*)(proj + (size_t)rp * DINP + C_MV + h * 64 + c8 * 8), fv); unpack8(*(const u32x4*)(W.mqk() + (size_t)rp * 512 + 256 + h * 64 + c8 * 8), fk);
                const float wp = sh_idx(wj, p);
#pragma unroll
                for (int e = 0; e < 8; ++e) { As[(c8 * 8 + e) * 72 + p] = (bf16_t)f2bf(fv[e]); Bs[(c8 * 8 + e) * 72 + p] = (bf16_t)f2bf(fk[e] * wp); } }
            LDS_WAIT(); asm volatile("" ::: "memory");
            float* ut = W.mu() + (size_t)(s * NCH + gc) * 4096;
#pragma unroll
            for (int mt = 0; mt < 2; ++mt)
#pragma unroll
                for (int nt = 0; nt < 2; ++nt) { f32x16 acc = {}; wmma32<4>(acc, As + mt * 32 * 72, 72, Bs + nt * 32 * 72, 72, r32, hi);
#pragma unroll
                    for (int r = 0; r < 16; ++r) ut[(32 * mt + crow(r, hi)) * 64 + 32 * nt + r32] = acc[r]; }
            float nsum = 0.f;
#pragma unroll 8
            for (int j = 0; j < 64; ++j) nsum += bf2f(Bs[lane * 72 + j]);
            W.mn()[(size_t)(s * NCH + gc) * 64 + lane] = nsum;
            if (lane == 0) { W.ms()[(size_t)(s * NCH + gc) * 4 + 0] = gmax; W.ms()[(size_t)(s * NCH + gc) * 4 + 1] = bend; }
        } else {
            float bc[32];
            { const float* lp = W.loga() + ((size_t)dir * MA + row) * 128 + h * 32;
#pragma unroll
              for (int q4 = 0; q4 < 8; ++q4) { const f32x4 v = *(const f32x4*)(lp + 4 * q4); bc[4 * q4] = v[0]; bc[4 * q4 + 1] = v[1]; bc[4 * q4 + 2] = v[2]; bc[4 * q4 + 3] = v[3]; } }
#pragma unroll
            for (int d = 0; d < 32; ++d) bc[d] = scan_incl(bc[d], lane, dir);
            float kk[32];
#pragma unroll
            for (int q8 = 0; q8 < 4; ++q8) { float f[8]; unpack8(*(const u32x4*)(proj + (size_t)row * DINP + C_GK + h * 32 + q8 * 8), f);
#pragma unroll
                for (int e = 0; e < 8; ++e) kk[q8 * 8 + e] = f[e]; }
            float* gdp = W.gd() + (size_t)(s * NCH + gc) * 32;
#pragma unroll
            for (int d = 0; d < 32; ++d) { const float bend = sh_idx(bc[d], dir ? 0 : 63); Bs[d * 72 + lane] = (bf16_t)f2bf(kk[d] * __expf(bend - bc[d])); if (lane == d) gdp[d] = __expf(bend); }
#pragma unroll
            for (int i = 0; i < 8; ++i) { const int p = i * 8 + (lane >> 3), c8 = lane & 7; const int rp = tokrow(b, gc, p);
                float fv[8]; unpack8(*(const u32x4*)(proj + (size_t)rp * DINP + C_GV + h * 64 + c8 * 8), fv);
#pragma unroll
                for (int e = 0; e < 8; ++e) As[(c8 * 8 + e) * 72 + p] = (bf16_t)f2bf(fv[e]); }
            LDS_WAIT(); asm volatile("" ::: "memory");
            float* ut = W.gu() + (size_t)(s * NCH + gc) * 2048;
#pragma unroll
            for (int mt = 0; mt < 2; ++mt) { f32x16 acc = {}; wmma32<4>(acc, As + mt * 32 * 72, 72, Bs, 72, r32, hi);
#pragma unroll
                for (int r = 0; r < 16; ++r) ut[(32 * mt + crow(r, hi)) * 32 + r32] = acc[r]; }
        }
    }
}

DI int scan_gc(int dir, int sc) { return dir ? (NCH - 1 - sc) : (sc < 4 ? 128 + sc : sc - 4); }
DI void phase_scan(const WS& W, LAS unsigned char* lds) {
    int tid_ = threadIdx.x; asm volatile("" : "+v"(tid_)); const int tid = tid_;
    LAS float* gm = (LAS float*)lds; LAS float* be = gm + NCH; LAS float* dec = be + NCH; LAS float* ff = dec + NCH; LAS float* mi = ff + NCH;
    for (int u = blockIdx.x; u < 192; u += gridDim.x) {
        __syncthreads();
        if (u < 128) {
            const int s = u >> 3, slice = u & 7, dir = s & 1;
            if (tid < NCH) { const int gc = scan_gc(dir, tid); gm[tid] = W.ms()[(size_t)(s * NCH + gc) * 4 + 0]; be[tid] = W.ms()[(size_t)(s * NCH + gc) * 4 + 1]; }
            __syncthreads();
            if (tid == 0) { float m = 0.f; for (int sc = 0; sc < NCH; ++sc) { mi[sc] = m; const float mn = fmaxf(be[sc] + m, gm[sc]); dec[sc] = __expf(be[sc] + m - mn); ff[sc] = __expf(gm[sc] - mn); m = mn; } }
            __syncthreads();
            const int e = slice * 512 + tid; float C = 0.f, nn = 0.f;
            const bool do_n = (slice == 0 && tid < 64);
            for (int sc = 0; sc < NCH; ++sc) { const int gc = scan_gc(dir, sc);
                float* p = W.mu() + (size_t)(s * NCH + gc) * 4096 + e; const float uu = *p; *p = C; C = dec[sc] * C + ff[sc] * uu;
                if (do_n) { float* q = W.mn() + (size_t)(s * NCH + gc) * 64 + tid; const float un = *q; *q = nn; nn = dec[sc] * nn + ff[sc] * un; }
                if (slice == 0 && tid == 64) W.ms()[(size_t)(s * NCH + gc) * 4 + 2] = mi[sc]; }
        } else {
            const int s = (u - 128) >> 2, slice = (u - 128) & 3, dir = s & 1; const int e = slice * 512 + tid, d = e & 31; float S = 0.f;
            for (int sc = 0; sc < NCH; ++sc) { const int gc = scan_gc(dir, sc);
                const float dcy = W.gd()[(size_t)(s * NCH + gc) * 32 + d]; float* p = W.gu() + (size_t)(s * NCH + gc) * 2048 + e; const float uu = *p; *p = S; S = dcy * S + uu; }
        }
    }
    __syncthreads();
}

constexpr int AT_SLOT = 20480, AT_WS = 3 * AT_SLOT, AT_OST = AT_WS + 2048;
DI void glds16(const void* gsrc, unsigned lds_dst) { unsigned keep;
    asm volatile("s_mov_b32 %0, m0\n\ts_mov_b32 m0, %2\n\ts_nop 0\n\tglobal_load_lds_dwordx4 %1, off\n\ts_mov_b32 m0, %0" : "=&s"(keep) : "v"(gsrc), "s"(lds_dst) : "memory"); }
DI s16x4 vtr(const LAS char* p) { typedef short v4i16_t __attribute__((ext_vector_type(4))); return __builtin_bit_cast(s16x4, __builtin_amdgcn_ds_read_tr16_b64_v4i16((LAS v4i16_t*)p)); }
DI void attn_unit(const WS& W, LAS unsigned char* lds, int b, int h, int tq0, int tile0, int nt, int orow0) {
    int tid_ = threadIdx.x; asm volatile("" : "+v"(tid_)); const int tid = tid_, lane = tid & 63, r32 = lane & 31, hi = lane >> 5; const int wid = __builtin_amdgcn_readfirstlane(tid >> 6);
    const unsigned lds0 = (unsigned)(uintptr_t)lds;
    const bf16_t* Qw = W.q() + ((size_t)(b * NH + h) * NKEY + tq0 + wid * 32 + r32) * QK;
    const char* Kt = (const char*)(W.k() + ((size_t)(b * NH + h) * NTILE + tile0) * 6144);
    const char* Vt = (const char*)(W.v() + ((size_t)(b * NH + h) * NTILE + tile0) * 4096);
    const int np = wid < 4 ? 3 : 2;
#define AT_ISSUE(t, slot) do { const char* kt_ = Kt + (size_t)(t) * 12288; const char* vt_ = Vt + (size_t)(t) * 8192; const unsigned d_ = lds0 + (slot) * AT_SLOT; \
        glds16(kt_ + wid * 1024 + lane * 16, (unsigned)__builtin_amdgcn_readfirstlane(d_ + wid * 1024)); \
        if (wid < 4) { glds16(kt_ + (wid + 8) * 1024 + lane * 16, (unsigned)__builtin_amdgcn_readfirstlane(d_ + (wid + 8) * 1024)); glds16(vt_ + (wid + 4) * 1024 + lane * 16, (unsigned)__builtin_amdgcn_readfirstlane(d_ + (wid + 16) * 1024)); } \
        else { glds16(vt_ + (wid - 4) * 1024 + lane * 16, (unsigned)__builtin_amdgcn_readfirstlane(d_ + (wid + 8) * 1024)); } } while (0)
    bf16x8 qr[6];
#pragma unroll
    for (int d0 = 0; d0 < 6; ++d0) qr[d0] = *(const bf16x8*)(Qw + d0 * 16 + hi * 8);
    VM_WAIT();
    AT_ISSUE(0, 0);
    if (nt > 1) AT_ISSUE(1, 1);
    f32x16 o[2]; o[0] = f32x16{}; o[1] = f32x16{}; float l_reg = 0.f;
    const int vb = ((lane >> 4) & 1) * 32 + (lane & 3) * 8 + (4 * hi + ((lane & 15) >> 2)) * 64;
    int slot = 0;
    for (int t = 0; t < nt; ++t) {
        if (t + 1 < nt) { if (np == 3) asm volatile("s_waitcnt vmcnt(3)\n\ts_waitcnt lgkmcnt(0)\n\ts_barrier" ::: "memory"); else asm volatile("s_waitcnt vmcnt(2)\n\ts_waitcnt lgkmcnt(0)\n\ts_barrier" ::: "memory"); }
        else asm volatile("s_waitcnt vmcnt(0)\n\ts_waitcnt lgkmcnt(0)\n\ts_barrier" ::: "memory");
        if (t + 2 < nt) { const int s2 = slot >= 1 ? slot - 1 : 2; AT_ISSUE(t + 2, s2); }
        const LAS char* Ks = (const LAS char*)lds + slot * AT_SLOT; const LAS char* Vs = Ks + 12288;
        f32x16 p0 = f32x16{}, p1 = f32x16{};
#pragma unroll
        for (int d0 = 0; d0 < 6; ++d0) {
            const bf16x8 k0 = *(const LAS bf16x8*)(Ks + (2 * d0 + hi) * 1024 + r32 * 16);
            const bf16x8 k1 = *(const LAS bf16x8*)(Ks + (2 * d0 + hi) * 1024 + (32 + r32) * 16);
            p0 = __builtin_amdgcn_mfma_f32_32x32x16_bf16(k0, qr[d0], p0, 0, 0, 0);
            p1 = __builtin_amdgcn_mfma_f32_32x32x16_bf16(k1, qr[d0], p1, 0, 0, 0);
        }
        float sacc = 0.f;
#pragma unroll
        for (int r = 0; r < 16; ++r) { p0[r] = __builtin_amdgcn_exp2f(p0[r]); p1[r] = __builtin_amdgcn_exp2f(p1[r]); sacc += p0[r] + p1[r]; }
        l_reg += sacc;
        u32x4 pw[4];
#pragma unroll
        for (int j = 0; j < 4; ++j) { pw[0][j] = cvtpk(p0[2 * j], p0[2 * j + 1]); pw[1][j] = cvtpk(p0[8 + 2 * j], p0[8 + 2 * j + 1]);
            pw[2][j] = cvtpk(p1[2 * j], p1[2 * j + 1]); pw[3][j] = cvtpk(p1[8 + 2 * j], p1[8 + 2 * j + 1]); }
#pragma unroll
        for (int d0 = 0; d0 < 2; ++d0)
#pragma unroll
            for (int ks = 0; ks < 4; ++ks) {
                const s16x4 lo = vtr(Vs + vb + d0 * 4096 + ks * 1024), hh = vtr(Vs + vb + d0 * 4096 + ks * 1024 + 512);
                const bf16x8 vf = (bf16x8){lo[0], lo[1], lo[2], lo[3], hh[0], hh[1], hh[2], hh[3]};
                o[d0] = __builtin_amdgcn_mfma_f32_32x32x16_bf16(__builtin_bit_cast(bf16x8, pw[ks]), vf, o[d0], 0, 0, 0);
            }
        slot = slot == 2 ? 0 : slot + 1;
    }
#undef AT_ISSUE
    { auto rr = __builtin_amdgcn_permlane32_swap(__float_as_uint(l_reg), __float_as_uint(l_reg), false, false); l_reg = __uint_as_float(rr[0]) + __uint_as_float(rr[1]); }
    LAS float* wsf = (LAS float*)(lds + AT_WS) + wid * 64;
    if (hi == 0) wsf[r32] = l_reg;
    LDS_WAIT();
    float rli[16];
#pragma unroll
    for (int r = 0; r < 16; ++r) rli[r] = 1.f / wsf[crow(r, hi)];
    LAS bf16_t* stg = (LAS bf16_t*)(lds + AT_OST) + wid * 2048;
#pragma unroll
    for (int r = 0; r < 16; ++r) { const int orow = crow(r, hi);
#pragma unroll
        for (int d0 = 0; d0 < 2; ++d0) stg[orow * 64 + d0 * 32 + r32] = (bf16_t)f2bf(o[d0][r] * rli[r]); }
    LDS_WAIT();
    bf16_t* Ow = W.mix() + (size_t)(orow0 + wid * 32) * D + h * 64;
#pragma unroll
    for (int i = 0; i < 4; ++i) { const int row = i * 8 + (lane >> 3), ch = lane & 7; u32x4 v = *(const LAS u32x4*)(stg + row * 64 + ch * 8);
#ifdef PROBE_NOATT
        v = (u32x4){0u, 0u, 0u, 0u};
#endif
        *(u32x4*)(Ow + (size_t)row * D + ch * 8) = v; }
    asm volatile("s_waitcnt lgkmcnt(0)\n\ts_barrier" ::: "memory");
}
DI void phase_attn(const WS& W, LAS unsigned char* lds, bool need_ctx) {
    const int G = gridDim.x, bx = blockIdx.x; const int vcu = (G % 8 == 0) ? (bx % 8) * (G / 8) + bx / 8 : bx;
    for (int L = vcu; L < 512; L += G) {
        int bh, qb; if (G == 256) { const int i = L >> 8, v = L & 255; bh = (v >> 5) * 2 + i; qb = v & 31; } else { bh = L >> 5; qb = L & 31; }
        attn_unit(W, lds, bh >> 3, bh & 7, qb * 256, 0, NTILE, (bh >> 3) * SEQ + qb * 256);
    }
    if (need_ctx) for (int L = vcu; L < 16; L += G) attn_unit(W, lds, L >> 3, L & 7, SEQ, 128, 4, ML + (L >> 3) * CTX);
}

DI void mlstm_out_unit(KArgs a, const WS& W, int l, int b, int h, int gc, LAS unsigned char* lds) {
    int tid_ = threadIdx.x; asm volatile("" : "+v"(tid_)); const int tid = tid_, lane = tid & 63, r32 = lane & 31, hi = lane >> 5; const int wid = __builtin_amdgcn_readfirstlane(tid >> 6);
    LAS bf16_t* qs = (LAS bf16_t*)lds; LAS bf16_t* ks = qs + 4608; LAS bf16_t* vT = ks + 4608; LAS bf16_t* CT = vT + 4608  ; LAS bf16_t* P = CT + 2 * 4608  ;
    LAS float* Hs = (LAS float*)(lds + 64512)  ; LAS float* sm = (LAS float*)(lds + 97280);
    const bf16_t* proj = W.proj();
    { const int p = tid >> 3, c8 = tid & 7; const int rp = tokrow(b, gc, p);
      *(LAS u32x4*)(qs + p * 72 + c8 * 8) = *(const u32x4*)(W.mqk() + (size_t)rp * 512 + h * 64 + c8 * 8);
      *(LAS u32x4*)(ks + p * 72 + c8 * 8) = *(const u32x4*)(W.mqk() + (size_t)rp * 512 + 256 + h * 64 + c8 * 8);
      float fv[8]; unpack8(*(const u32x4*)(proj + (size_t)rp * DINP + C_MV + h * 64 + c8 * 8), fv);
#pragma unroll
      for (int e = 0; e < 8; ++e) vT[(c8 * 8 + e) * 72 + p] = (bf16_t)f2bf(fv[e]);
#pragma unroll
      for (int dir = 0; dir < 2; ++dir) { const int s = (b * 4 + h) * 2 + dir; const float* cp = W.mu() + (size_t)(s * NCH + gc) * 4096 + p * 64 + c8 * 8;
          const f32x4 c0 = *(const f32x4*)cp, c1 = *(const f32x4*)(cp + 4); float f[8] = {c0[0], c0[1], c0[2], c0[3], c1[0], c1[1], c1[2], c1[3]};
          *(LAS u32x4*)(CT + dir * 4608 + p * 72 + c8 * 8) = pack8(f); }
      if (tid < 128) { const int dir = tid >> 6, d = tid & 63; const int s = (b * 4 + h) * 2 + dir; sm[dir * 384 + 4 * 64 + d] = W.mn()[(size_t)(s * NCH + gc) * 64 + d]; } }
    if ((wid & 3) == 0) { const int dir = wid >> 2; const int s = (b * 4 + h) * 2 + dir; const int row = tokrow(b, gc, lane);
        const float logi = W.gates()[(size_t)row * 16 + dir * 8 + h], logf = W.gates()[(size_t)row * 16 + dir * 8 + 4 + h];
        const float mst = W.ms()[(size_t)(s * NCH + gc) * 4 + 2];
        const float bc = scan_incl(logf, lane, dir), av = logi - bc, amax = scan_max(av, lane, dir), mt = bc + fmaxf(mst, amax);
        LAS float* sd = sm + dir * 384; sd[lane] = bc - mt; sd[64 + lane] = av; sd[128 + lane] = __expf(bc + mst - mt); sd[192 + lane] = __expf(-mt); }
    __syncthreads();
    const int dir = wid >> 2, mt_ = (wid >> 1) & 1, nt_ = wid & 1; LAS float* sd = sm + dir * 384; LAS bf16_t* Pd = P + dir * 4608;
    { f32x16 acc = {}; wmma32<4>(acc, qs + mt_ * 32 * 72, 72, ks + nt_ * 32 * 72, 72, r32, hi);
      const int j = 32 * nt_ + r32; const float bj = sd[64 + j];
#pragma unroll
      for (int r = 0; r < 16; ++r) { const int t = 32 * mt_ + crow(r, hi); const bool ok = dir ? (j >= t) : (j <= t); const float w = ok ? __expf(sd[t] + bj) : 0.f; Pd[t * 72 + j] = (bf16_t)f2bf(acc[r] * w); } }
    __syncthreads();
    f32x16 acc = {};
    wmma32<4>(acc, qs + mt_ * 32 * 72, 72, CT + dir * 4608 + nt_ * 32 * 72, 72, r32, hi);
#pragma unroll
    for (int r = 0; r < 16; ++r) acc[r] *= sd[128 + 32 * mt_ + crow(r, hi)];
    wmma32<4>(acc, Pd + mt_ * 32 * 72, 72, vT + nt_ * 32 * 72, 72, r32, hi);
    if (nt_ == 0 && lane < 32) { const int t = 32 * mt_ + lane; float rs = 0.f, qn = 0.f;
#pragma unroll 8
        for (int j = 0; j < 64; ++j) { rs += bf2f(Pd[t * 72 + j]); qn += bf2f(qs[t * 72 + j]) * sd[256 + j]; }
        const float den = rs + sd[128 + t] * qn; sd[320 + t] = 1.f / fmaxf(fabsf(den), sd[192 + t]); }
    __syncthreads();
#pragma unroll
    for (int r = 0; r < 16; ++r) { const int t = 32 * mt_ + crow(r, hi); Hs[dir * 4096 + t * 64 + 32 * nt_ + r32] = acc[r] * sd[320 + t]; }
    __syncthreads();
    { const int t = tid >> 3, v0 = (tid & 7) * 8; const int row = tokrow(b, gc, t); float hv[8]; float ss = 0.f;
#pragma unroll
      for (int e = 0; e < 8; ++e) { hv[e] = Hs[t * 64 + v0 + e] + Hs[4096 + t * 64 + v0 + e]; ss += hv[e] * hv[e]; }
      ss += sh_xor(ss, 1, lane); ss += sh_xor(ss, 2, lane); ss += sh_xor(ss, 4, lane);
      const float r = rsqrtf(ss * (1.f / 64.f) + EPS);
      float xcv[8], ov[8]; unpack8(*(const u32x4*)(W.xconv() + (size_t)row * 256 + h * 64 + v0), xcv); unpack8(*(const u32x4*)(proj + (size_t)row * DINP + C_MO + h * 64 + v0), ov);
      const float* nw = a->in[I_MNW] + l * 256 + h * 64 + v0; const float* sk = a->in[I_MSK] + l * 256 + h * 64 + v0; float o[8];
#pragma unroll
      for (int e = 0; e < 8; ++e) o[e] = sigmoidf_(ov[e]) * (hv[e] * r * nw[e] + sk[e] * xcv[e]);
      *(u32x4*)(W.mix() + (size_t)row * D + 512 + h * 64 + v0) = pack8(o); }
    __syncthreads();
}
DI void gla_out_unit(KArgs a, const WS& W, int l, int b, int h, int gc, LAS unsigned char* lds) {
    int tid_ = threadIdx.x; asm volatile("" : "+v"(tid_)); const int tid = tid_, lane = tid & 63, r32 = lane & 31, hi = lane >> 5; const int wid = __builtin_amdgcn_readfirstlane(tid >> 6);
    LAS bf16_t* qs = (LAS bf16_t*)lds  ; LAS bf16_t* ks = qs + 2 * 2560; LAS bf16_t* vT = ks + 2 * 2560  ; LAS bf16_t* ST = vT + 4608  ; LAS bf16_t* P = ST + 2 * 2560  ;
    LAS float* Hs = (LAS float*)(lds + 58368);
    const bf16_t* proj = W.proj();
    { const int p = tid >> 3, c8 = tid & 7; const int rp = tokrow(b, gc, p);
      float fv[8]; unpack8(*(const u32x4*)(proj + (size_t)rp * DINP + C_GV + h * 64 + c8 * 8), fv);
#pragma unroll
      for (int e = 0; e < 8; ++e) vT[(c8 * 8 + e) * 72 + p] = (bf16_t)f2bf(fv[e]);
      const int dir = tid >> 8, idx = tid & 255, v = idx >> 2, d0 = (idx & 3) * 8; const int s = (b * 4 + h) * 2 + dir;
      const float* sp = W.gu() + (size_t)(s * NCH + gc) * 2048 + v * 32 + d0; const f32x4 c0 = *(const f32x4*)sp, c1 = *(const f32x4*)(sp + 4);
      float f[8] = {c0[0], c0[1], c0[2], c0[3], c1[0], c1[1], c1[2], c1[3]}; *(LAS u32x4*)(ST + dir * 2560 + v * 40 + d0) = pack8(f); }
    if ((wid & 3) == 0) { const int dir = wid >> 2; const int row = tokrow(b, gc, lane);
        float bc[32];
        { const float* lp = W.loga() + ((size_t)dir * MA + row) * 128 + h * 32;
#pragma unroll
          for (int q4 = 0; q4 < 8; ++q4) { const f32x4 v = *(const f32x4*)(lp + 4 * q4); bc[4 * q4] = v[0]; bc[4 * q4 + 1] = v[1]; bc[4 * q4 + 2] = v[2]; bc[4 * q4 + 3] = v[3]; } }
#pragma unroll
        for (int d = 0; d < 32; ++d) bc[d] = scan_incl(bc[d], lane, dir);
#pragma unroll
        for (int q8 = 0; q8 < 4; ++q8) { float fq[8], fk[8]; unpack8(*(const u32x4*)(proj + (size_t)row * DINP + C_GQ + h * 32 + q8 * 8), fq); unpack8(*(const u32x4*)(proj + (size_t)row * DINP + C_GK + h * 32 + q8 * 8), fk);
#pragma unroll
            for (int e = 0; e < 8; ++e) { fq[e] = fq[e] * 0.17677669529663687f * __expf(bc[q8 * 8 + e]); fk[e] = fk[e] * __expf(-bc[q8 * 8 + e]); }
            *(LAS u32x4*)(qs + dir * 2560 + lane * 40 + q8 * 8) = pack8(fq); *(LAS u32x4*)(ks + dir * 2560 + lane * 40 + q8 * 8) = pack8(fk); } }
    __syncthreads();
    const int dir = wid >> 2, mt_ = (wid >> 1) & 1, nt_ = wid & 1; LAS bf16_t* Pd = P + dir * 4608;
    { f32x16 acc = {}; wmma32<2>(acc, qs + dir * 2560 + mt_ * 32 * 40, 40, ks + dir * 2560 + nt_ * 32 * 40, 40, r32, hi);
      const int j = 32 * nt_ + r32;
#pragma unroll
      for (int r = 0; r < 16; ++r) { const int t = 32 * mt_ + crow(r, hi); const bool ok = dir ? (j >= t) : (j <= t); Pd[t * 72 + j] = (bf16_t)f2bf(ok ? acc[r] : 0.f); } }
    __syncthreads();
    f32x16 acc = {};
    wmma32<2>(acc, qs + dir * 2560 + mt_ * 32 * 40, 40, ST + dir * 2560 + nt_ * 32 * 40, 40, r32, hi);
    wmma32<4>(acc, Pd + mt_ * 32 * 72, 72, vT + nt_ * 32 * 72, 72, r32, hi);
#pragma unroll
    for (int r = 0; r < 16; ++r) { const int t = 32 * mt_ + crow(r, hi); Hs[dir * 4096 + t * 64 + 32 * nt_ + r32] = acc[r]; }
    __syncthreads();
    { const int t = tid >> 3, v0 = (tid & 7) * 8; const int row = tokrow(b, gc, t); float hv[8]; float ss = 0.f;
#pragma unroll
      for (int e = 0; e < 8; ++e) { hv[e] = Hs[t * 64 + v0 + e] + Hs[4096 + t * 64 + v0 + e]; ss += hv[e] * hv[e]; }
      ss += sh_xor(ss, 1, lane); ss += sh_xor(ss, 2, lane); ss += sh_xor(ss, 4, lane);
      const float r = rsqrtf(ss * (1.f / 64.f) + EPS);
      float rv[8]; unpack8(*(const u32x4*)(proj + (size_t)row * DINP + C_GR + h * 64 + v0), rv);
      const float* nw = a->in[I_GNW] + l * 256 + h * 64 + v0; float o[8];
#pragma unroll
      for (int e = 0; e < 8; ++e) o[e] = hv[e] * r * nw[e] * siluf(rv[e]);
      *(u32x4*)(W.mix() + (size_t)row * D + 768 + h * 64 + v0) = pack8(o); }
    __syncthreads();
}
DI void phase_chunkout(KArgs a, const WS& W, int l, LAS unsigned char* lds) {
    const int nch = (l < DEPTH - 1) ? NCH : 128;
    for (int u = blockIdx.x; u < 2 * 8 * nch; u += gridDim.x) {
        const int kind = u / (8 * nch), rem = u % (8 * nch), bh = rem / nch, gc = rem % nch;
        if (kind == 0) mlstm_out_unit(a, W, l, bh >> 2, bh & 3, gc, lds); else gla_out_unit(a, W, l, bh >> 2, bh & 3, gc, lds);
    }
}

DI void phase_router(KArgs a, const WS& W, int l, int nrows, LAS unsigned char* lds) {
    int tid_ = threadIdx.x; asm volatile("" : "+v"(tid_)); const int tid = tid_, lane = tid & 63, wid = __builtin_amdgcn_readfirstlane(tid >> 6);
    const int gw = blockIdx.x * 8 + wid, NGW = gridDim.x * 8;
    LAS float* WT = (LAS float*)lds;
    __syncthreads();
    for (int i = tid; i < 36 * 1024; i += 512) { const int e = i >> 10, k = i & 1023; WT[i] = e < 4 ? a->in[I_WGRP][(size_t)l * D * 4 + k * 4 + e] : a->in[I_WER][(size_t)l * D * 32 + k * 32 + (e - 4)]; }
    __syncthreads();
    unsigned* cnt = W.ctl() + CW_CNT + l * NEXP;
    for (int row = gw; row < nrows; row += NGW) {
        const float* xr = row < ML ? a->out + (size_t)row * D : W.xc() + (size_t)(row - ML) * D;
        const int vec = row < SEQ ? 0 : (row < ML ? 1 : 2);
        f32x4 v[4]; float ss = 0.f;
#pragma unroll
        for (int j = 0; j < 4; ++j) { v[j] = *(const f32x4*)(xr + 4 * lane + 256 * j); ss += (v[j][0] * v[j][0] + v[j][1] * v[j][1]) + (v[j][2] * v[j][2] + v[j][3] * v[j][3]); }
        const float r = rsqrtf(wave_sum(ss, lane) * (1.f / D) + EPS);
        const float* md = W.mods() + (size_t)(l * 3 + vec) * 6144; const float* nw = a->in[I_N2W] + l * D; bf16_t* hr = W.h() + (size_t)row * D;
#pragma unroll
        for (int j = 0; j < 4; ++j) { const int c = 4 * lane + 256 * j; const f32x4 w = *(const f32x4*)(nw + c), sh = *(const f32x4*)(md + 3072 + c), sc = *(const f32x4*)(md + 4096 + c);
#pragma unroll
            for (int i = 0; i < 4; ++i) v[j][i] = v[j][i] * r * w[i] * (1.f + sc[i]) + sh[i];
            u32x2 p; p.x = pk2(v[j][0], v[j][1]); p.y = pk2(v[j][2], v[j][3]); *(u32x2*)(hr + c) = p; }
        LAS float* lg = (LAS float*)(lds + 147456) + wid * 64;
#pragma unroll 2
        for (int e = 0; e < 36; ++e) { float s = 0.f;
#pragma unroll
            for (int j = 0; j < 4; ++j) { const f32x4 w = *(const LAS f32x4*)(WT + e * 1024 + 4 * lane + 256 * j); s += (v[j][0] * w[0] + v[j][1] * w[1]) + (v[j][2] * w[2] + v[j][3] * w[3]); }
            s = wave_sum(s, lane); if (lane == 0) lg[e] = s; }
        LDS_WAIT(); asm volatile("" ::: "memory");
        int g = 0; float gmx = lg[0] + a->in[I_BGRP][l * 4];
        float gl[4];
#pragma unroll
        for (int i = 0; i < 4; ++i) gl[i] = lg[i] + a->in[I_BGRP][l * 4 + i];
#pragma unroll
        for (int i = 1; i < 4; ++i) if (gl[i] > gmx) { gmx = gl[i]; g = i; }
        float gz = 0.f;
#pragma unroll
        for (int i = 0; i < 4; ++i) gz += __expf(gl[i] - gmx);
        const float gwt = 1.f / gz;
        float el[8];
#pragma unroll
        for (int i = 0; i < 8; ++i) el[i] = lg[4 + g * 8 + i] + a->in[I_BER][l * 32 + g * 8 + i];
        int i1 = 0; float m1 = el[0];
#pragma unroll
        for (int i = 1; i < 8; ++i) if (el[i] > m1) { m1 = el[i]; i1 = i; }
        int i2 = -1; float m2 = -3.0e38f;
#pragma unroll
        for (int i = 0; i < 8; ++i) if (i != i1 && el[i] > m2) { m2 = el[i]; i2 = i; }
        const float ex = __expf(m2 - m1), w1 = gwt / (1.f + ex), w2 = gwt * ex / (1.f + ex);
        if (lane == 0) {
#ifdef FIXED_ROUTE
            const int e1 = (row * 7) & 31, e2 = (e1 + 13) & 31;
#else
            const int e1 = g * 8 + i1, e2 = g * 8 + i2;
#endif
            const unsigned s1 = atomicAdd(cnt + e1, 1u), s2 = atomicAdd(cnt + e2, 1u);
            W.pair()[(size_t)e1 * PAIRCAP + s1] = row * 2; W.pw()[(size_t)e1 * PAIRCAP + s1] = w1;
            W.pair()[(size_t)e2 * PAIRCAP + s2] = row * 2 + 1; W.pw()[(size_t)e2 * PAIRCAP + s2] = w2;
        }
    }
}
DI void moe_tables(const WS& W, int l, LAS unsigned char* lds) {
    volatile LAS int* toff = (volatile LAS int*)(lds + MISC_OFF + 64); volatile LAS int* cn = (volatile LAS int*)(lds + MISC_OFF + 256);
    __syncthreads();
    if (threadIdx.x == 0) { int acc = 0; for (int e = 0; e < NEXP; ++e) { const int c = (int)__hip_atomic_load(W.ctl() + CW_CNT + l * NEXP + e, __ATOMIC_RELAXED, __HIP_MEMORY_SCOPE_AGENT); cn[e] = c; toff[e] = acc; acc += (c + 255) >> 8; } toff[NEXP] = acc; }
    __syncthreads();
}

__global__ void __launch_bounds__(512, 2) fwd_kernel(Args a) {
    extern __shared__ __attribute__((aligned(16))) unsigned char lds_raw[];
    LAS unsigned char* lds = (LAS unsigned char*)lds_raw;
    const KArgs ka = (KArgs)__builtin_amdgcn_kernarg_segment_ptr();
#define AL() ({ KArgs al_ = ka; asm volatile("" : "+s"(al_)); al_; })
#define WL() (WS{AL()->ws})
#define LL() ({ int l_ = l; asm volatile("" : "+s"(l_)); l_; })
    const WS W{a.ws};
    const int tid = threadIdx.x, G = gridDim.x;
    volatile LAS unsigned* misc = (volatile LAS unsigned*)(lds + MISC_OFF);
    if (tid < 4) misc[tid] = 0u;
    __syncthreads();
    const bool fused = (a.ph_hi - a.ph_lo) > 1;
    XcdBarrier bar; bar.bar = W.ctl() + CW_BAR; bar.x = 0; bar.st = misc;
    if (fused) bar = xcd_barrier_post(W.ctl() + CW_BAR, misc);
    const int lo = a.ph_lo, hi = a.ph_hi;
#ifndef PHMASK
#define PHMASK 0xFFFFFFFFu
#endif
#ifndef NO_MOE
#define NO_MOE 0
#endif
#define RUN(k) (lo <= (k) && (k) < hi)
#define EN(j) ((PHMASK >> (j)) & 1u)
#define SEAM(k) do { if (lo <= (k) && (k) + 1 < hi) xcd_barrier(bar); } while (0)
    if (EN(11) && RUN(0)) { phase_prologue(AL(), WL(), lds); }
    SEAM(0);
    for (int l = 0; l < DEPTH; ++l) {
        const int p0 = 1 + l * NPL; const bool need_ctx = l < DEPTH - 1; const int mrows = need_ctx ? MA : ML;
        if (lo >= p0 + NPL || hi <= p0) continue;
        if (EN(0) && RUN(p0 + 0)) { phase_norm1(AL(), WL(), LL(), l - 1, (l > 0) && !NO_MOE, true, MA); }
        SEAM(p0 + 0);
        if (EN(1) && RUN(p0 + 1)) { const WS W = WL(); pg8::DenseSched S; S.init(W.h(), W.wl(LL(), WL_IN), D, D, MA, DINP, G, (int)blockIdx.x); pg8::EpiBf16 E{W.proj(), DINP}; pg8::gemm_phase(lds, S, E, D, D); }
        SEAM(p0 + 1);
        if (EN(2) && RUN(p0 + 2)) { phase_prep(AL(), WL(), LL(), lds); }
        SEAM(p0 + 2);
        if (EN(3) && RUN(p0 + 3)) { const WS W = WL();
            { pg8::DenseSched S; S.init(W.cqn(), W.wl(LL(), WL_UP), 384, 384, MA, 1792, G, (int)blockIdx.x); pg8::EpiBf16 E{W.qkvraw(), 1792}; pg8::gemm_phase(lds, S, E, 384, 384); }
            { pg8::DenseSched S; S.init(W.xconv(), W.wl(LL(), WL_MQK), 256, 256, MA, 512, G, (int)blockIdx.x); pg8::EpiBf16 E{W.mqk(), 512}; pg8::gemm_phase(lds, S, E, 256, 256); }
        }
        SEAM(p0 + 3);
        if (EN(4) && RUN(p0 + 4)) { phase_post(AL(), WL(), LL(), lds); }
        SEAM(p0 + 4);
        if (EN(5) && RUN(p0 + 5)) { { const WS W2 = WL(); phase_scan(W2, lds); phase_attn(W2, lds, need_ctx); } }
        SEAM(p0 + 5);
        if (EN(6) && RUN(p0 + 6)) { phase_chunkout(AL(), WL(), LL(), lds); }
        SEAM(p0 + 6);
        if (EN(7) && RUN(p0 + 7)) { const WS W = WL(); float* outp = AL()->out; pg8::DenseSched S; S.init(W.mix(), W.wl(LL(), WL_OUT), D, D, mrows, D, G, (int)blockIdx.x); pg8::EpiResid E{outp, W.xc(), W.mods() + (size_t)LL() * 3 * 6144 + 2048}; pg8::gemm_phase(lds, S, E, D, D); }
        SEAM(p0 + 7);
        if (!NO_MOE && EN(8) && RUN(p0 + 8)) { phase_router(AL(), WL(), LL(), mrows, lds); }
        SEAM(p0 + 8);
        if (!NO_MOE && EN(9) && RUN(p0 + 9)) { const WS W = WL(); moe_tables(W, LL(), lds);
            pg8::MoeSched<true> S{W.h(), W.wgu(), D, D, (size_t)512 * D, W.pair(), (const volatile LAS int*)(lds + MISC_OFF + 64), (const volatile LAS int*)(lds + MISC_OFF + 256), 2, G, (int)blockIdx.x};
            pg8::EpiMoeUp E{W.act(), W.pw(), (const volatile LAS int*)(lds + MISC_OFF + 256)}; pg8::gemm_phase(lds, S, E, D, D); }
        SEAM(p0 + 9);
        if (!NO_MOE && EN(10) && RUN(p0 + 10)) { const WS W = WL(); moe_tables(W, LL(), lds);
            pg8::MoeSched<false> S{W.act(), W.wdn(), DE, DE, (size_t)D * DE, W.pair(), (const volatile LAS int*)(lds + MISC_OFF + 64), (const volatile LAS int*)(lds + MISC_OFF + 256), 4, G, (int)blockIdx.x};
            pg8::EpiMoeDown E{W.y(), W.pair(), (const volatile LAS int*)(lds + MISC_OFF + 256)}; pg8::gemm_phase(lds, S, E, DE, DE); }
        SEAM(p0 + 10);
    }
    if (NO_MOE && RUN(NPHASE - 1)) { KArgs aa = AL(); for (int i = blockIdx.x * 512 + tid; i < ML * D; i += G * 512) { const float xi = aa->in[I_X][i]; aa->out[i] = xi + 64.f * (aa->out[i] - xi); } }
    if (!NO_MOE && EN(12) && RUN(NPHASE - 1)) { phase_norm1(AL(), WL(), 0, DEPTH - 1, true, false, ML); }
#undef RUN
#undef SEAM
}

extern "C" void kernel_launch(void* const* d_in, const int* in_sizes, int n_in, void* d_out, int out_size, void* d_ws, size_t ws_size, hipStream_t stream) {
    static int grid = 0;
    if (grid == 0) {
        if (n_in != 33 || out_size != ML * D || ws_size < WS_END) { fprintf(stderr, "kernel_launch: unexpected shapes (n_in %d out %d ws %zu need %zu)\n", n_in, out_size, ws_size, (size_t)WS_END); grid = -1; return; }
        int dev = 0, cus = 0, per_cu = 0;
        if (hipGetDevice(&dev) != hipSuccess || hipDeviceGetAttribute(&cus, hipDeviceAttributeMultiprocessorCount, dev) != hipSuccess) { grid = -1; return; }
        if (hipFuncSetAttribute((const void*)fwd_kernel, hipFuncAttributeMaxDynamicSharedMemorySize, LDS_BYTES) != hipSuccess) { fprintf(stderr, "kernel_launch: hipFuncSetAttribute failed\n"); grid = -1; return; }
        if (hipOccupancyMaxActiveBlocksPerMultiprocessor(&per_cu, (const void*)fwd_kernel, 512, LDS_BYTES) != hipSuccess || per_cu < 1) fprintf(stderr, "kernel_launch: occupancy query says %d\n", per_cu);
        (void)hipGetLastError();
        grid = cus < 256 ? cus : 256;
    }
    if (grid < 0) return;
    (void)hipMemsetAsync((char*)d_ws + WS_CTL, 0, CTL_BYTES, stream);
    Args a{};
    for (int i = 0; i < 33; ++i) a.in[i] = (const float*)d_in[i];
    a.out = (float*)d_out; a.ws = (unsigned char*)d_ws;
#if N_LAUNCH_MODE == 1
    a.ph_lo = 0; a.ph_hi = NPHASE;
    hipLaunchKernelGGL(fwd_kernel, dim3(grid), dim3(512), LDS_BYTES, stream, a);
#else
    for (int p = 0; p < NPHASE; ++p) { a.ph_lo = p; a.ph_hi = p + 1; hipLaunchKernelGGL(fwd_kernel, dim3(grid), dim3(512), LDS_BYTES, stream, a); }
#endif
}
```

```cpp
#include <hip/hip_runtime.h>
#include <cstdio>
#include <cstdint>

#ifndef N_LAUNCH_MODE
#define N_LAUNCH_MODE 1
#endif

#define LAS __attribute__((address_space(3)))
#define GAS __attribute__((address_space(1)))
typedef unsigned short bf16_t;
typedef short bf16x8 __attribute__((ext_vector_type(8)));
typedef short s16x4 __attribute__((ext_vector_type(4)));
typedef float f32x2 __attribute__((ext_vector_type(2)));
typedef float f32x4 __attribute__((ext_vector_type(4)));
typedef float f32x16 __attribute__((ext_vector_type(16)));
typedef unsigned u32x2 __attribute__((ext_vector_type(2)));
typedef unsigned u32x4 __attribute__((ext_vector_type(4)));
#define DI __device__ __forceinline__

constexpr int D = 1024, NB = 2, SEQ = 8192, DEPTH = 4, CTX = 256;
constexpr int ML = NB * SEQ, MC = NB * CTX, MA = ML + MC;
constexpr int DINP = 2048;
constexpr int C_CQ = 0, C_CKV = 256, C_KR = 384, C_MX = 416, C_MV = 672, C_MO = 928, C_MG = 1184, C_GQ = 1200, C_GK = 1328, C_GV = 1456, C_GR = 1712, C_GA = 1968;
constexpr int NH = 8, QK = 96, NKEY = SEQ + CTX, NTILE = NKEY / 64;
constexpr int NCH = 132;
constexpr int NEXP = 32, DE = 256, PAIRCAP = MA;
constexpr float EPS = 1e-6f;
constexpr float QSCALE = 0.10206207261596577f * 1.4426950408889634f;
constexpr int NPL = 11;
constexpr int NPHASE = 1 + DEPTH * NPL + 1;

constexpr size_t MiB = 1u << 20;
constexpr size_t WS_CTL = 0, CTL_BYTES = 1 * MiB;
constexpr size_t WS_MODS = 1 * MiB;
constexpr size_t WS_ROPE = WS_MODS + MiB / 2;
constexpr size_t WS_XC = WS_ROPE + 1 * MiB + MiB / 2;
constexpr size_t WS_WL = 5 * MiB;
constexpr size_t WL_STRIDE = 8 * MiB, WL_IN = 0, WL_UP = 4 * MiB, WL_MQK = 4 * MiB + 1536 * 1024, WL_OUT = 6 * MiB;
constexpr size_t WS_WGU = 37 * MiB;
constexpr size_t WS_WDN = 69 * MiB;
constexpr size_t WS_A = 85 * MiB;
constexpr size_t WS_B = 151 * MiB;
constexpr size_t WS_ACT = WS_B + 34 * MiB;
constexpr size_t WS_H = 209 * MiB;
constexpr size_t WS_CQ = 242 * MiB;
constexpr size_t WS_XCONV = 255 * MiB;
constexpr size_t WS_MQK = 264 * MiB;
constexpr size_t WS_Q = 281 * MiB;
constexpr size_t WS_K = 306 * MiB;
constexpr size_t WS_V = 331 * MiB;
constexpr size_t WS_GATES = 348 * MiB;
constexpr size_t WS_LOGA = 350 * MiB;
constexpr size_t WS_MU = 367 * MiB;
constexpr size_t WS_MN = 400 * MiB;
constexpr size_t WS_MS = 401 * MiB;
constexpr size_t WS_GU = 402 * MiB;
constexpr size_t WS_GD = 419 * MiB;
constexpr size_t WS_PAIR = 420 * MiB;
constexpr size_t WS_PW = 423 * MiB;
constexpr size_t WS_END = 426 * MiB;
static_assert(WS_A + (size_t)MA * DINP * 2 <= WS_B && WS_B + (size_t)MA * 1792 * 2 <= WS_H && WS_ACT + (size_t)42240 * 256 * 2 <= WS_H && WS_B + (size_t)MA * 1024 * 2 <= WS_ACT, "ws map");
static_assert(WS_H + (size_t)MA * D * 2 <= WS_CQ && WS_CQ + (size_t)MA * 384 * 2 <= WS_XCONV && WS_XCONV + (size_t)MA * 256 * 2 <= WS_MQK && WS_MQK + (size_t)MA * 512 * 2 <= WS_Q, "ws map 2");
static_assert(WS_Q + (size_t)16 * 8448 * 96 * 2 <= WS_K && WS_K + (size_t)16 * 132 * 12288 <= WS_V && WS_V + (size_t)16 * 132 * 8192 <= WS_GATES && WS_GATES + (size_t)MA * 64 <= WS_LOGA, "ws map 3");
static_assert(WS_LOGA + (size_t)2 * MA * 512 <= WS_MU && WS_MU + (size_t)16 * 132 * 16384 <= WS_MN && WS_MN + (size_t)16 * 132 * 256 <= WS_MS && WS_GU + (size_t)16 * 132 * 8192 <= WS_GD && WS_GD + (size_t)16 * 132 * 128 <= WS_PAIR, "ws map 4");
static_assert(WS_PAIR + (size_t)32 * PAIRCAP * 4 <= WS_PW && WS_PW + (size_t)32 * PAIRCAP * 4 <= WS_END, "ws map 5");
constexpr int CW_BAR = 4096;
constexpr int CW_CNT = 16384;

constexpr int LDS_BYTES = 163840 - 1024;
constexpr int MISC_OFF = LDS_BYTES - 1024;
constexpr int WSCR = 19200;

struct Args { const float* in[33]; float* out; unsigned char* ws; int ph_lo, ph_hi; };
typedef const __attribute__((address_space(4))) Args* KArgs;

DI float bf2f(unsigned v) { return __uint_as_float(v << 16); }
DI unsigned f2bf(float f) { unsigned u = __float_as_uint(f); return (u + 0x7fffu + ((u >> 16) & 1u)) >> 16; }
DI unsigned pk2(float lo, float hi) { return f2bf(lo) | (f2bf(hi) << 16); }
typedef __bf16 bf16x2_t __attribute__((ext_vector_type(2)));
DI unsigned cvtpk(float lo, float hi) { f32x2 v = {lo, hi}; bf16x2_t b = __builtin_convertvector(v, bf16x2_t); return __builtin_bit_cast(unsigned, b); }
DI float sh_idx(float v, int src) { return __int_as_float(__builtin_amdgcn_ds_bpermute(src << 2, __float_as_int(v))); }
DI float sh_xor(float v, int m, int lane) { return sh_idx(v, lane ^ m); }
DI float wave_sum(float v, int lane) {
#pragma unroll
    for (int o = 1; o < 64; o <<= 1) v += sh_xor(v, o, lane);
    return v;
}
DI float wave_max(float v, int lane) {
#pragma unroll
    for (int o = 1; o < 64; o <<= 1) v = fmaxf(v, sh_xor(v, o, lane));
    return v;
}
DI float siluf(float x) { return x / (1.f + __expf(-x)); }
DI float sigmoidf_(float x) { return 1.f / (1.f + __expf(-x)); }
DI float logsigmoidf_(float x) { return fminf(x, 0.f) - log1pf(__expf(-fabsf(x))); }
DI int crow(int r, int hi) { return (r & 3) + 8 * (r >> 2) + 4 * hi; }
#define LDS_WAIT() asm volatile("s_waitcnt lgkmcnt(0)" ::: "memory")
#define VM_WAIT() asm volatile("s_waitcnt vmcnt(0)" ::: "memory")
DI int tokrow(int b, int gc, int t) { return gc < 128 ? b * SEQ + gc * 64 + t : ML + b * CTX + (gc - 128) * 64 + t; }

#define XB_TMO      128
#define XB_XCNT(j)  (256  + 64 * (j))
#define XB_XSUB(j)  (1280 + 64 * (j))
#define XB_XGEN(j)  (2304 + 64 * (j))
#define XB_TOP      3328
#define XB_TOPGEN   3392
#define XCD_BAR_WORDS 3456
#define XB_SPIN_CAP (1u << 22)
DI unsigned xb_ld(unsigned* p)              { return __hip_atomic_load(p, __ATOMIC_RELAXED, __HIP_MEMORY_SCOPE_AGENT); }
DI unsigned xb_add(unsigned* p, unsigned v) { return __hip_atomic_fetch_add(p, v, __ATOMIC_RELAXED, __HIP_MEMORY_SCOPE_AGENT); }
DI unsigned xb_xcc_id() { return (unsigned)__builtin_amdgcn_s_getreg((3 << 11) | 20) & 0xFu; }
#define XB_SPIN(cond, bar) do { unsigned _sp = 0; while (cond) { __builtin_amdgcn_s_sleep(1); \
    if ((++_sp & 255u) == 0u) { if (xb_ld(&(bar)[XB_TMO])) break; if (_sp > XB_SPIN_CAP) { atomicAdd(&(bar)[XB_TMO], 1u); break; } } } } while (0)
struct XcdBarrier { unsigned* bar; unsigned x; volatile LAS unsigned* st; };
DI XcdBarrier xcd_barrier_post(unsigned* bar, volatile LAS unsigned* st) {
    XcdBarrier b; b.bar = bar; b.x = xb_xcc_id(); b.st = st;
    if (threadIdx.x == 0) (void)xb_add(&bar[XB_XCNT(b.x)], 1u);
    return b;
}
DI void xcd_barrier_complete(unsigned* bar, unsigned x, unsigned& nloc, unsigned& nx) {
    const unsigned G = gridDim.x * gridDim.y * gridDim.z;
    unsigned sum, cnt, mine, sp = 0u;
    for (;;) {
        sum = 0u; cnt = 0u; mine = 0u;
#pragma unroll
        for (unsigned j = 0; j < 16; ++j) { const unsigned c = xb_ld(&bar[XB_XCNT(j)]); sum += c; cnt += (c > 0u) ? 1u : 0u; mine = (j == x) ? c : mine; }
        if (sum == G) break;
        __builtin_amdgcn_s_sleep(1);
        if ((++sp & 255u) == 0u) { if (xb_ld(&bar[XB_TMO])) break; if (sp > XB_SPIN_CAP) { atomicAdd(&bar[XB_TMO], 1u); break; } }
    }
    nloc = mine > 0u ? mine : 1u; nx = cnt > 0u ? cnt : 1u;
}
DI void xcd_barrier(const XcdBarrier& b) {
    asm volatile("s_waitcnt vmcnt(0)" ::: "memory");
    __syncthreads();
    if (threadIdx.x == 0) {
        unsigned* bar = b.bar;
        __builtin_amdgcn_s_waitcnt(0);
        unsigned nloc = b.st[0], nx = b.st[1];
        if (nloc == 0u) { xcd_barrier_complete(bar, b.x, nloc, nx); b.st[0] = nloc; b.st[1] = nx; }
        const unsigned old = xb_add(&bar[XB_XSUB(b.x)], 1u);
        const unsigned gen = old / nloc;
        if (old + 1u == (gen + 1u) * nloc) {
            __builtin_amdgcn_fence(__ATOMIC_RELEASE, "agent");
            asm volatile("s_waitcnt vmcnt(0)" ::: "memory");
            const unsigned og = xb_add(&bar[XB_TOP], 1u);
            const unsigned tg = og / nx;
            if (og + 1u == (tg + 1u) * nx) xb_add(&bar[XB_TOPGEN], 1u);
            else XB_SPIN(xb_ld(&bar[XB_TOPGEN]) == tg, bar);
            __builtin_amdgcn_fence(__ATOMIC_ACQUIRE, "agent");
            xb_add(&bar[XB_XGEN(b.x)], 1u);
            asm volatile("s_waitcnt vmcnt(0)" ::: "memory");
        } else {
            XB_SPIN(xb_ld(&bar[XB_XGEN(b.x)]) == gen, bar);
            __builtin_amdgcn_fence(__ATOMIC_ACQUIRE, "agent");
            asm volatile("s_waitcnt vmcnt(0)" ::: "memory");
        }
    }
    __syncthreads();
}

namespace pg8 {
constexpr int BM = 256, BK = 64, HALF = 128, HTB = HALF * BK * 2, NXCD = 8, WGM = 8;
DI int lds_byte(int r, int c) { const int st = (r >> 4) * 2 + (c >> 5), rr = r & 15, cc = c & 31, ob = rr * 64 + cc * 2; return st * 1024 + (ob ^ (((ob >> 9) & 1) << 5)); }
DI void stage_rc(int b, int& R, int& C) { const int st = b / 1024, sb = b % 1024, swz = sb ^ (((sb >> 9) & 1) << 5); R = (st >> 1) * 16 + swz / 64; C = (st & 1) * 32 + (swz % 64) / 2; }
DI int perm32(int rho) { const int n = rho >> 4, i = rho & 15; return 8 * (i >> 2) + 4 * n + (i & 3); }
struct Unit { int pm, pn, e, t; };
DI unsigned cvt_pk_bf16(float lo, float hi) { unsigned r; asm volatile("v_cvt_pk_bf16_f32 %0, %1, %2" : "=v"(r) : "v"(lo), "v"(hi)); return r; }

struct DenseSched {
    static constexpr bool PER_UNIT_A = false;
    const bf16_t* A; const bf16_t* Bt; int lda, ldb; int nM, nN, nwg, G, c;
    DI void init(const bf16_t* A_, const bf16_t* Bt_, int lda_, int ldb_, int M, int N, int G_, int c_) { A = A_; Bt = Bt_; lda = lda_; ldb = ldb_; nM = M / BM; nN = N / BM; nwg = nM * nN; G = G_; c = c_; }
    DI bool next(int i, Unit& u) const {
        const long L = (long)i * G + c; if (L >= nwg) return false;
        int wgid = (int)L; { const int q = nwg / NXCD, r = nwg % NXCD, xcd = wgid % NXCD, off = wgid / NXCD; wgid = (xcd < r ? xcd * (q + 1) : r * (q + 1) + (xcd - r) * q) + off; }
        const int nig = WGM * nN, gid = wgid / nig, fm = gid * WGM, gsz = (nM - fm) < WGM ? (nM - fm) : WGM;
        u.pm = fm + ((wgid % nig) % gsz); u.pn = (wgid % nig) / gsz; u.e = 0; u.t = 0; return true;
    }
    DI const char* abase(const Unit& u) const { return (const char*)A + (size_t)u.pm * BM * lda * 2; }
    DI const char* bbase(const Unit& u) const { return (const char*)Bt + (size_t)u.pn * BM * ldb * 2; }
    DI void avoff(const Unit&, const int (&R)[2], const int (&C)[2], unsigned (&va)[2][2]) const {
#pragma unroll
        for (int h = 0; h < 2; ++h)
#pragma unroll
            for (int i = 0; i < 2; ++i) va[h][i] = (unsigned)((h * HALF + R[i]) * lda + C[i]) * 2u;
    }
};
template <bool GATHER> struct MoeSched {
    static constexpr bool PER_UNIT_A = GATHER;
    const bf16_t* A; const bf16_t* Bt; int lda, ldb; size_t bexp;
    const int* pair; const volatile LAS int* toff; const volatile LAS int* cnt; int NPN, G, c;
    DI bool next(int i, Unit& u) const {
        const int T = __builtin_amdgcn_readfirstlane(toff[NEXP]); const int L = i * G + c; if (L >= T * NPN) return false;
        const int ti = L / NPN; u.pn = L % NPN; int e = 0;
#pragma unroll 1
        for (int j = 1; j < NEXP; ++j) e = (__builtin_amdgcn_readfirstlane(toff[j]) <= ti) ? j : e;
        u.pm = ti; u.e = e; u.t = ti - __builtin_amdgcn_readfirstlane(toff[e]); return true;
    }
    DI const char* abase(const Unit& u) const { return GATHER ? (const char*)A : (const char*)A + (size_t)u.pm * BM * lda * 2; }
    DI const char* bbase(const Unit& u) const { return (const char*)Bt + ((size_t)u.e * bexp + (size_t)u.pn * BM * ldb) * 2; }
    DI void avoff(const Unit& u, const int (&R)[2], const int (&C)[2], unsigned (&va)[2][2]) const {
        const int n = __builtin_amdgcn_readfirstlane(cnt[u.e]);
#pragma unroll
        for (int h = 0; h < 2; ++h)
#pragma unroll
            for (int i = 0; i < 2; ++i) {
                if (GATHER) { const int slot = u.t * BM + h * HALF + R[i]; const int tok = (slot < n) ? (pair[(size_t)u.e * PAIRCAP + slot] >> 1) : 0; va[h][i] = (unsigned)(tok * lda + C[i]) * 2u; }
                else va[h][i] = (unsigned)((h * HALF + R[i]) * lda + C[i]) * 2u;
            }
    }
};

template <class Epi, class Sched>
DI void gemm_phase(LAS unsigned char* lds, const Sched& S, const Epi& E, const int K, const int ldb) {
    int tid_ = threadIdx.x; asm volatile("" : "+v"(tid_));
    const int tid = tid_, wid = __builtin_amdgcn_readfirstlane(tid >> 6), lane = tid & 63, wr = wid >> 2, wc = wid & 3, fr = lane & 15, fq = lane >> 4;
    int nt = K / BK; asm volatile("" : "+s"(nt));
    int Rr[2], Cc[2]; unsigned vb[2];
#pragma unroll
    for (int i = 0; i < 2; ++i) { stage_rc(tid * 16 + i * 8192, Rr[i], Cc[i]); const int Rb = (Rr[i] & ~31) + perm32(Rr[i] & 31); vb[i] = (unsigned)(Rb * ldb + Cc[i]) * 2u; }
    const size_t kstep = (size_t)(BK * 2);
    const size_t hstepB = (size_t)HALF * ldb * 2;
    const unsigned ldsw = (unsigned)wid * 1024u;
    const int aoff = lds_byte(wr * 64 + fr, fq * 8), boff = lds_byte(wc * 32 + fr, fq * 8);
#define PG8_SA(b, h) (((b) * 2 + (h)) * HTB)
#define PG8_SB(b, h) ((4 + (b) * 2 + (h)) * HTB)
#define PG8_STAGE_A(b, h, gbase, VA) do { _Pragma("unroll") for (int _i = 0; _i < 2; ++_i) \
        __builtin_amdgcn_global_load_lds((const unsigned*)((const char*)(gbase) + (VA)[h][_i]), (LAS unsigned*)(lds + PG8_SA(b, h) + ldsw + _i * 8192), 16, 0, 0); } while (0)
#define PG8_STAGE_B(b, h, gbase) do { _Pragma("unroll") for (int _i = 0; _i < 2; ++_i) \
        __builtin_amdgcn_global_load_lds((const unsigned*)((const char*)(gbase) + (h) * hstepB + vb[_i]), (LAS unsigned*)(lds + PG8_SB(b, h) + ldsw + _i * 8192), 16, 0, 0); } while (0)
#define PG8_LDA(dst, b, h) do { _Pragma("unroll") for (int m = 0; m < 4; ++m) _Pragma("unroll") for (int k = 0; k < 2; ++k) dst[m][k] = *(const LAS bf16x8*)(lds + PG8_SA(b, h) + aoff + m * 2048 + k * 1024); } while (0)
#define PG8_LDB(dst, b, h) do { _Pragma("unroll") for (int n = 0; n < 2; ++n) _Pragma("unroll") for (int k = 0; k < 2; ++k) dst[n][k] = *(const LAS bf16x8*)(lds + PG8_SB(b, h) + boff + n * 2048 + k * 1024); } while (0)
#define PG8_MMA(ai, bj, At, Bt) do { __builtin_amdgcn_s_setprio(1); _Pragma("unroll") for (int m = 0; m < 4; ++m) _Pragma("unroll") for (int n = 0; n < 2; ++n) _Pragma("unroll") for (int k = 0; k < 2; ++k) \
        acc[ai][bj][m][n] = __builtin_amdgcn_mfma_f32_16x16x32_bf16(Bt[n][k], At[m][k], acc[ai][bj][m][n], 0, 0, 0); __builtin_amdgcn_s_setprio(0); } while (0)
#define PG8_WAIT_V(n) asm volatile("s_waitcnt vmcnt(" #n ")" ::: "memory")
#define PG8_WAIT_L(n) asm volatile("s_waitcnt lgkmcnt(" #n ")" ::: "memory")
#define PG8_BAR __builtin_amdgcn_s_barrier()
#define PG8_SCHED __builtin_amdgcn_sched_barrier(0)
    Unit cur, nxt; int ui = 0;
    if (!S.next(0, cur)) return;
    f32x4 acc[2][2][4][2];
#pragma unroll
    for (int a = 0; a < 2; ++a)
#pragma unroll
        for (int b = 0; b < 2; ++b)
#pragma unroll
            for (int m = 0; m < 4; ++m)
#pragma unroll
                for (int n = 0; n < 2; ++n) acc[a][b][m][n] = (f32x4){0.f, 0.f, 0.f, 0.f};
    bf16x8 At[4][2], B0[2][2], B1[2][2];
    unsigned va[2][2];
    const char* cA = S.abase(cur); const char* cB = S.bbase(cur);
    S.avoff(cur, Rr, Cc, va);
    PG8_STAGE_B(0, 0, cB); PG8_STAGE_B(0, 1, cB); PG8_STAGE_A(0, 0, cA, va); PG8_STAGE_A(0, 1, cA, va);
    if (wr == 1) PG8_BAR;
    PG8_WAIT_V(2); PG8_BAR;
    PG8_STAGE_B(1, 0, cB + kstep); PG8_STAGE_A(1, 0, cA + kstep, va); PG8_STAGE_B(1, 1, cB + kstep);
    PG8_WAIT_V(6); PG8_BAR;
    for (;;) {
        const bool has_next = S.next(ui + 1, nxt);
        const char* nA = cA; const char* nB = cB;
        if (has_next) { nA = S.abase(nxt); nB = S.bbase(nxt); }
        for (int t = 0; t < nt; t += 2) {
            const bool last = (t == nt - 2);
            const char* a1 = cA + (size_t)(t + 1) * kstep;
            const char* a2 = last ? nA : cA + (size_t)(t + 2) * kstep; const char* b2 = last ? nB : cB + (size_t)(t + 2) * kstep;
            const char* a3 = a2 + kstep; const char* b3 = b2 + kstep;
            PG8_LDB(B0, 0, 0); PG8_LDB(B1, 0, 1); PG8_SCHED; PG8_LDA(At, 0, 0); PG8_STAGE_A(1, 1, a1, va);
            if (Sched::PER_UNIT_A && last && has_next) S.avoff(nxt, Rr, Cc, va);
            PG8_WAIT_V(8); PG8_WAIT_L(0); PG8_BAR; PG8_MMA(0, 0, At, B0); PG8_MMA(0, 1, At, B1); PG8_BAR; PG8_SCHED;
            PG8_LDA(At, 0, 1); PG8_STAGE_B(0, 0, b2); PG8_STAGE_B(0, 1, b2); PG8_STAGE_A(0, 0, a2, va);
            PG8_WAIT_V(8); PG8_WAIT_L(0); PG8_BAR; PG8_MMA(1, 0, At, B0); PG8_MMA(1, 1, At, B1); PG8_BAR; PG8_SCHED;
            PG8_LDB(B0, 1, 0); PG8_LDB(B1, 1, 1); PG8_SCHED; PG8_LDA(At, 1, 0); PG8_STAGE_A(0, 1, a2, va);
            PG8_WAIT_V(8); PG8_WAIT_L(0); PG8_BAR; PG8_MMA(0, 0, At, B0); PG8_MMA(0, 1, At, B1); PG8_BAR; PG8_SCHED;
            PG8_LDA(At, 1, 1); PG8_STAGE_B(1, 0, b3); PG8_STAGE_B(1, 1, b3); PG8_STAGE_A(1, 0, a3, va);
            PG8_WAIT_V(8); PG8_WAIT_L(0); PG8_BAR; PG8_MMA(1, 0, At, B0); PG8_MMA(1, 1, At, B1); PG8_BAR; PG8_SCHED;
        }
        E(acc, cur, wr, wc, fr, fq);
        if (!has_next) break;
#pragma unroll
        for (int a = 0; a < 2; ++a)
#pragma unroll
            for (int b = 0; b < 2; ++b)
#pragma unroll
                for (int m = 0; m < 4; ++m)
#pragma unroll
                    for (int n = 0; n < 2; ++n) acc[a][b][m][n] = (f32x4){0.f, 0.f, 0.f, 0.f};
        cur = nxt; cA = nA; cB = nB; ++ui;
    }
    PG8_WAIT_V(0);
    if (wr == 0) PG8_BAR;
    PG8_BAR;
#undef PG8_SA
#undef PG8_SB
#undef PG8_STAGE_A
#undef PG8_STAGE_B
#undef PG8_LDA
#undef PG8_LDB
#undef PG8_MMA
#undef PG8_WAIT_V
#undef PG8_WAIT_L
#undef PG8_BAR
#undef PG8_SCHED
}

struct EpiBf16 {
    bf16_t* O; int ldc;
    DI void operator()(const f32x4 (&acc)[2][2][4][2], const Unit& u, int wr, int wc, int fr, int fq) const {
        asm volatile("" : "+v"(fr), "+v"(fq));
        const int row0 = u.pm * BM + wr * 64 + fr, col0 = u.pn * BM + wc * 32 + 8 * fq;
#pragma unroll
        for (int ai = 0; ai < 2; ++ai)
#pragma unroll
            for (int m = 0; m < 4; ++m) { bf16_t* rowp = O + (size_t)(row0 + ai * HALF + m * 16) * ldc + col0;
#pragma unroll
                for (int bj = 0; bj < 2; ++bj) { const f32x4 v0 = acc[ai][bj][m][0], v1 = acc[ai][bj][m][1];
                    u32x4 w; w.x = cvt_pk_bf16(v0[0], v0[1]); w.y = cvt_pk_bf16(v0[2], v0[3]); w.z = cvt_pk_bf16(v1[0], v1[1]); w.w = cvt_pk_bf16(v1[2], v1[3]);
                    *(u32x4*)(rowp + bj * HALF) = w; } }
    }
};
struct EpiResid {
    float* xl; float* xc; const float* gate;
    DI void operator()(const f32x4 (&acc)[2][2][4][2], const Unit& u, int wr, int wc, int fr, int fq) const {
        asm volatile("" : "+v"(fr), "+v"(fq));
        const int rt = u.pm * BM; const int vec = rt < SEQ ? 0 : (rt < ML ? 1 : 2);
        float* xb = rt < ML ? xl + (size_t)rt * D : xc + (size_t)(rt - ML) * D;
        const int row0 = wr * 64 + fr, col0 = u.pn * BM + wc * 32 + 8 * fq;
        const float* g = gate + vec * 6144 + col0;
        f32x4 gv[2][2];
#pragma unroll
        for (int bj = 0; bj < 2; ++bj)
#pragma unroll
            for (int n = 0; n < 2; ++n) gv[bj][n] = *(const f32x4*)(g + bj * HALF + 4 * n);
#pragma unroll
        for (int ai = 0; ai < 2; ++ai)
#pragma unroll
            for (int m = 0; m < 4; ++m) { float* rowp = xb + (size_t)(row0 + ai * HALF + m * 16) * D + col0;
#pragma unroll
                for (int bj = 0; bj < 2; ++bj)
#pragma unroll
                    for (int n = 0; n < 2; ++n) { f32x4* p = (f32x4*)(rowp + bj * HALF + 4 * n); f32x4 xv = *p; xv = xv + gv[bj][n] * acc[ai][bj][m][n]; *p = xv; } }
    }
};
struct EpiMoeUp {
    bf16_t* ACT; const float* pw; const volatile LAS int* cnt;
    DI void operator()(const f32x4 (&acc)[2][2][4][2], const Unit& u, int wr, int wc, int fr, int fq) const {
        asm volatile("" : "+v"(fr), "+v"(fq));
        const int n_e = __builtin_amdgcn_readfirstlane(cnt[u.e]); const int col0 = u.pn * 128 + wc * 32 + 8 * fq;
#pragma unroll
        for (int ai = 0; ai < 2; ++ai)
#pragma unroll
            for (int m = 0; m < 4; ++m) { const int rt = wr * 64 + fr + ai * HALF + m * 16; const int slot = u.t * BM + rt;
                const float w = slot < n_e ? pw[(size_t)u.e * PAIRCAP + slot] : 0.f;
                float a[8];
#pragma unroll
                for (int n = 0; n < 2; ++n)
#pragma unroll
                    for (int j = 0; j < 4; ++j) { const float g = acc[ai][0][m][n][j], up = acc[ai][1][m][n][j]; a[n * 4 + j] = siluf(g) * up * w; }
                u32x4 o; o.x = cvt_pk_bf16(a[0], a[1]); o.y = cvt_pk_bf16(a[2], a[3]); o.z = cvt_pk_bf16(a[4], a[5]); o.w = cvt_pk_bf16(a[6], a[7]);
                *(u32x4*)(ACT + ((size_t)u.pm * BM + rt) * DE + col0) = o; }
    }
};
struct EpiMoeDown {
    bf16_t* Y; const int* pair; const volatile LAS int* cnt;
    DI void operator()(const f32x4 (&acc)[2][2][4][2], const Unit& u, int wr, int wc, int fr, int fq) const {
        asm volatile("" : "+v"(fr), "+v"(fq));
        const int n_e = __builtin_amdgcn_readfirstlane(cnt[u.e]); const int col0 = u.pn * BM + wc * 32 + 8 * fq;
#pragma unroll
        for (int ai = 0; ai < 2; ++ai)
#pragma unroll
            for (int m = 0; m < 4; ++m) { const int rt = wr * 64 + fr + ai * HALF + m * 16; const int slot = u.t * BM + rt;
                if (slot < n_e) { const int pr = pair[(size_t)u.e * PAIRCAP + slot]; bf16_t* rowp = Y + (size_t)pr * D + col0;
#pragma unroll
                    for (int bj = 0; bj < 2; ++bj) { const f32x4 v0 = acc[ai][bj][m][0], v1 = acc[ai][bj][m][1];
                        u32x4 w; w.x = cvt_pk_bf16(v0[0], v0[1]); w.y = cvt_pk_bf16(v0[2], v0[3]); w.z = cvt_pk_bf16(v1[0], v1[1]); w.w = cvt_pk_bf16(v1[2], v1[3]);
                        *(u32x4*)(rowp + bj * HALF) = w; } } }
    }
};
}

template <int KS> DI void wmma32(f32x16& acc, const LAS bf16_t* As, int lda, const LAS bf16_t* Bs, int ldb, int r32, int hi) {
#pragma unroll
    for (int ks = 0; ks < KS; ++ks) {
        const bf16x8 a = *(const LAS bf16x8*)(As + r32 * lda + ks * 16 + hi * 8);
        const bf16x8 b = *(const LAS bf16x8*)(Bs + r32 * ldb + ks * 16 + hi * 8);
        acc = __builtin_amdgcn_mfma_f32_32x32x16_bf16(a, b, acc, 0, 0, 0);
    }
}
DI float scan_incl(float x, int lane, bool suffix) {
#pragma unroll
    for (int off = 1; off < 64; off <<= 1) { const float v = sh_idx(x, suffix ? ((lane + off) & 63) : ((lane - off) & 63)); const bool ok = suffix ? (lane + off < 64) : (lane >= off); x += ok ? v : 0.f; }
    return x;
}
DI float scan_max(float x, int lane, bool suffix) {
#pragma unroll
    for (int off = 1; off < 64; off <<= 1) { const float v = sh_idx(x, suffix ? ((lane + off) & 63) : ((lane - off) & 63)); const bool ok = suffix ? (lane + off < 64) : (lane >= off); x = ok ? fmaxf(x, v) : x; }
    return x;
}
DI void unpack8(const u32x4 v, float (&f)[8]) {
    f[0] = bf2f(v.x & 0xffffu); f[1] = bf2f(v.x >> 16); f[2] = bf2f(v.y & 0xffffu); f[3] = bf2f(v.y >> 16);
    f[4] = bf2f(v.z & 0xffffu); f[5] = bf2f(v.z >> 16); f[6] = bf2f(v.w & 0xffffu); f[7] = bf2f(v.w >> 16);
}
DI u32x4 pack8(const float (&f)[8]) { u32x4 o; o.x = pk2(f[0], f[1]); o.y = pk2(f[2], f[3]); o.z = pk2(f[4], f[5]); o.w = pk2(f[6], f[7]); return o; }

struct WS {
    unsigned char* ws;
    DI unsigned* ctl() const { return (unsigned*)(ws + WS_CTL); }
    DI float* mods() const { return (float*)(ws + WS_MODS); }
    DI float* rope() const { return (float*)(ws + WS_ROPE); }
    DI float* xc() const { return (float*)(ws + WS_XC); }
    DI bf16_t* wl(int l, size_t off) const { return (bf16_t*)(ws + WS_WL + (size_t)l * WL_STRIDE + off); }
    DI bf16_t* wgu() const { return (bf16_t*)(ws + WS_WGU); }
    DI bf16_t* wdn() const { return (bf16_t*)(ws + WS_WDN); }
    DI bf16_t* proj() const { return (bf16_t*)(ws + WS_A); }
    DI bf16_t* y() const { return (bf16_t*)(ws + WS_A); }
    DI bf16_t* qkvraw() const { return (bf16_t*)(ws + WS_B); }
    DI bf16_t* mix() const { return (bf16_t*)(ws + WS_B); }
    DI bf16_t* act() const { return (bf16_t*)(ws + WS_ACT); }
    DI bf16_t* h() const { return (bf16_t*)(ws + WS_H); }
    DI bf16_t* cqn() const { return (bf16_t*)(ws + WS_CQ); }
    DI bf16_t* xconv() const { return (bf16_t*)(ws + WS_XCONV); }
    DI bf16_t* mqk() const { return (bf16_t*)(ws + WS_MQK); }
    DI bf16_t* q() const { return (bf16_t*)(ws + WS_Q); }
    DI bf16_t* k() const { return (bf16_t*)(ws + WS_K); }
    DI bf16_t* v() const { return (bf16_t*)(ws + WS_V); }
    DI float* gates() const { return (float*)(ws + WS_GATES); }
    DI float* loga() const { return (float*)(ws + WS_LOGA); }
    DI float* mu() const { return (float*)(ws + WS_MU); }
    DI float* mn() const { return (float*)(ws + WS_MN); }
    DI float* ms() const { return (float*)(ws + WS_MS); }
    DI float* gu() const { return (float*)(ws + WS_GU); }
    DI float* gd() const { return (float*)(ws + WS_GD); }
    DI int* pair() const { return (int*)(ws + WS_PAIR); }
    DI float* pw() const { return (float*)(ws + WS_PW); }
};
enum { I_X = 0, I_C, I_CTX, I_CCTX, I_WMOD, I_BMOD, I_N1W, I_WIN, I_QAN, I_WUQ, I_KVAN, I_WUKV, I_QNW, I_KNW, I_MCW, I_MCB, I_MWQ, I_MWK, I_MGB, I_MNW, I_MSK,
       I_GWA, I_GBA, I_GNW, I_WOUT, I_N2W, I_WGRP, I_BGRP, I_WER, I_BER, I_WG, I_WU, I_WD };

DI void tr_item(const float* W, int N, int nvalid, bf16_t* WT, int ldd, int k0, int n0, int drow0, int dcol0, LAS float* scr, int lane) {
#pragma unroll 8
    for (int i = 0; i < 32; ++i) { const int kk = 2 * i + (lane >> 5); const int n = n0 + (lane & 31); scr[kk * 33 + (lane & 31)] = (n < nvalid) ? W[(size_t)(k0 + kk) * N + n] : 0.f; }
    LDS_WAIT(); asm volatile("" ::: "memory");
    const int c = lane & 7;
#pragma unroll
    for (int j = 0; j < 4; ++j) { const int n = (lane >> 3) + 8 * j; const LAS float* s = scr + (8 * c) * 33 + n;
        u32x4 o; o.x = pk2(s[0 * 33], s[1 * 33]); o.y = pk2(s[2 * 33], s[3 * 33]); o.z = pk2(s[4 * 33], s[5 * 33]); o.w = pk2(s[6 * 33], s[7 * 33]);
        *(u32x4*)(WT + (size_t)(drow0 + n) * ldd + dcol0 + k0 + 8 * c) = o; }
    LDS_WAIT(); asm volatile("" ::: "memory");
}

DI void phase_prologue(KArgs a, const WS& W, LAS unsigned char* lds) {
    int tid_ = threadIdx.x; asm volatile("" : "+v"(tid_)); const int tid = tid_, lane = tid & 63, wid = __builtin_amdgcn_readfirstlane(tid >> 6);
    const int G = gridDim.x, gw = blockIdx.x * 8 + wid, NGW = G * 8, gt = blockIdx.x * 512 + tid, NGT = G * 512;
    LAS float* scr = (LAS float*)(lds + wid * WSCR);
    constexpr int IT_IN = 16 * 64, IT_UQ = 4 * 24, IT_UKV = 2 * 32, IT_OUT = 16 * 32, IT_L = IT_IN + IT_UQ + IT_UKV + IT_OUT;
    for (int it = gw; it < DEPTH * IT_L; it += NGW) {
        const int l = it / IT_L; int r = it % IT_L;
        if (r < IT_IN) { const int kb = r / 64, nb = r % 64; tr_item(a->in[I_WIN] + (size_t)l * D * 2000, 2000, 2000, W.wl(l, WL_IN), 1024, 64 * kb, 32 * nb, 32 * nb, 0, scr, lane); continue; } r -= IT_IN;
        if (r < IT_UQ) { const int kb = r / 24, nb = r % 24; tr_item(a->in[I_WUQ] + (size_t)l * 256 * 768, 768, 768, W.wl(l, WL_UP), 384, 64 * kb, 32 * nb, 32 * nb, 0, scr, lane); continue; } r -= IT_UQ;
        if (r < IT_UKV) { const int kb = r / 32, nb = r % 32; tr_item(a->in[I_WUKV] + (size_t)l * 128 * 1024, 1024, 1024, W.wl(l, WL_UP), 384, 64 * kb, 32 * nb, 768 + 32 * nb, 256, scr, lane); continue; } r -= IT_UKV;
        { const int kb = r / 32, nb = r % 32; tr_item(a->in[I_WOUT] + (size_t)l * D * D, 1024, 1024, W.wl(l, WL_OUT), 1024, 64 * kb, 32 * nb, 32 * nb, 0, scr, lane); }
    }
    for (int i = gt; i < DEPTH * (768 * 16 + 1024 * 32); i += NGT) {
        const int l = i / (768 * 16 + 1024 * 32); int r = i % (768 * 16 + 1024 * 32); bf16_t* wu = W.wl(l, WL_UP);
        if (r < 768 * 16) { const int row = r / 16, c = r % 16; *(u32x4*)(wu + (size_t)row * 384 + 256 + c * 8) = (u32x4){0u, 0u, 0u, 0u}; }
        else { r -= 768 * 16; const int row = 768 + r / 32, c = r % 32; *(u32x4*)(wu + (size_t)row * 384 + c * 8) = (u32x4){0u, 0u, 0u, 0u}; }
    }
    for (int i = gt; i < DEPTH * 512 * 256; i += NGT) {
        const int l = i / (512 * 256), r = i % (512 * 256), n = r / 256, kc = r % 256, hs = (n & 255) >> 6, e = n & 63;
        float v = 0.f;
        if ((kc >> 6) == hs) { const float* src = (n < 256 ? a->in[I_MWQ] : a->in[I_MWK]) + (size_t)l * 4 * 64 * 64; v = src[(hs * 64 + (kc & 63)) * 64 + e]; if (n < 256) v *= 0.125f; }
        W.wl(l, WL_MQK)[r] = (bf16_t)f2bf(v);
    }
    for (int i = gt; i < SEQ * 16; i += NGT) {
        const int t = i >> 4, p = i & 15; const float inv = powf(10000.f, -(float)(p & 7) / 8.f);
        const float ang = (float)(p < 8 ? (t >> 6) : (t & 63)) * inv;
        W.rope()[i] = cosf(ang); W.rope()[SEQ * 16 + i] = sinf(ang);
    }
    for (int i = gt; i < ML * D / 4; i += NGT) ((f32x4*)a->out)[i] = ((const f32x4*)a->in[I_X])[i];
    for (int i = gt; i < MC * D / 4; i += NGT) ((f32x4*)W.xc())[i] = ((const f32x4*)a->in[I_CTX])[i];
    {
        LAS float* sv = (LAS float*)lds;
        LAS float* red = (LAS float*)(lds + 12288);
        __syncthreads();
        for (int i = tid; i < 3 * 1024; i += 512) { const int vsel = i >> 10, k = i & 1023; const float c = vsel < 2 ? a->in[I_C][vsel * 1024 + k] : a->in[I_CCTX][k]; sv[i] = siluf(c); }
        __syncthreads();
        for (int it = blockIdx.x; it < DEPTH * 48; it += G) {
            const int l = it / 48, n0 = (it % 48) * 128, col = tid & 127, kg = tid >> 7;
            const float* wm = a->in[I_WMOD] + (size_t)l * D * 6144 + n0 + col;
            float s0 = 0.f, s1 = 0.f, s2 = 0.f;
#pragma unroll 8
            for (int k = kg * 256; k < kg * 256 + 256; ++k) { const float w = wm[(size_t)k * 6144]; s0 += sv[k] * w; s1 += sv[1024 + k] * w; s2 += sv[2048 + k] * w; }
            red[(kg * 3 + 0) * 128 + col] = s0; red[(kg * 3 + 1) * 128 + col] = s1; red[(kg * 3 + 2) * 128 + col] = s2;
            __syncthreads();
            if (tid < 384) { const int vsel = tid >> 7, c = tid & 127; const float s = red[(0 * 3 + vsel) * 128 + c] + red[(1 * 3 + vsel) * 128 + c] + red[(2 * 3 + vsel) * 128 + c] + red[(3 * 3 + vsel) * 128 + c];
                W.mods()[(size_t)(l * 3 + vsel) * 6144 + n0 + c] = s + a->in[I_BMOD][l * 6144 + n0 + c]; }
            __syncthreads();
        }
    }
}

DI void moe_weights(KArgs a, const WS& W, int l, LAS unsigned char* lds) {
    int tid_ = threadIdx.x; asm volatile("" : "+v"(tid_)); const int tid = tid_, lane = tid & 63, wid = __builtin_amdgcn_readfirstlane(tid >> 6);
    const int gw = blockIdx.x * 8 + wid, NGW = gridDim.x * 8;
    LAS float* scr = (LAS float*)(lds + wid * WSCR);
    constexpr int IT_G = 16 * 8, IT_D = 4 * 32;
    for (int it = gw; it < NEXP * (2 * IT_G + IT_D); it += NGW) {
        const int e = it / (2 * IT_G + IT_D); int r = it % (2 * IT_G + IT_D);
        if (r < 2 * IT_G) { const int up = r / IT_G; r %= IT_G; const int kb = r / 8, nb = r % 8, n0 = 32 * nb;
            const float* src = (up ? a->in[I_WU] : a->in[I_WG]) + (size_t)(l * NEXP + e) * D * DE;
            tr_item(src, DE, DE, W.wgu() + (size_t)e * 512 * D, D, 64 * kb, n0, 256 * (n0 >> 7) + (n0 & 127) + (up ? 128 : 0), 0, scr, lane); }
        else { r -= 2 * IT_G; const int kb = r / 32, nb = r % 32;
            tr_item(a->in[I_WD] + (size_t)(l * NEXP + e) * DE * D, D, D, W.wdn() + (size_t)e * D * DE, DE, 64 * kb, 32 * nb, 32 * nb, 0, scr, lane); }
    }
}

DI void phase_norm1(KArgs a, const WS& W, int l, int lc, bool combine, bool donorm, int nrows) {
    int tid_ = threadIdx.x; asm volatile("" : "+v"(tid_)); const int tid = tid_, lane = tid & 63, wid = __builtin_amdgcn_readfirstlane(tid >> 6);
    const int gw = blockIdx.x * 8 + wid, NGW = gridDim.x * 8;
    for (int row = gw; row < nrows; row += NGW) {
        float* xr = row < ML ? a->out + (size_t)row * D : W.xc() + (size_t)(row - ML) * D;
        const int vec = row < SEQ ? 0 : (row < ML ? 1 : 2);
        f32x4 v[4];
#pragma unroll
        for (int j = 0; j < 4; ++j) v[j] = *(const f32x4*)(xr + 4 * lane + 256 * j);
        if (combine) {
            const float* g2 = W.mods() + (size_t)(lc * 3 + vec) * 6144 + 5 * 1024;
            const bf16_t* y0 = W.y() + (size_t)(2 * row) * D; const bf16_t* y1 = y0 + D;
#pragma unroll
            for (int j = 0; j < 4; ++j) { const int c = 4 * lane + 256 * j; const f32x4 g = *(const f32x4*)(g2 + c); const u32x2 a0 = *(const u32x2*)(y0 + c), a1 = *(const u32x2*)(y1 + c);
                v[j][0] += g[0] * (bf2f(a0.x & 0xffffu) + bf2f(a1.x & 0xffffu)); v[j][1] += g[1] * (bf2f(a0.x >> 16) + bf2f(a1.x >> 16));
                v[j][2] += g[2] * (bf2f(a0.y & 0xffffu) + bf2f(a1.y & 0xffffu)); v[j][3] += g[3] * (bf2f(a0.y >> 16) + bf2f(a1.y >> 16));
                *(f32x4*)(xr + c) = v[j]; }
        }
        if (donorm) {
            float ss = 0.f;
#pragma unroll
            for (int j = 0; j < 4; ++j) ss += (v[j][0] * v[j][0] + v[j][1] * v[j][1]) + (v[j][2] * v[j][2] + v[j][3] * v[j][3]);
            const float r = rsqrtf(wave_sum(ss, lane) * (1.f / D) + EPS);
            const float* md = W.mods() + (size_t)(l * 3 + vec) * 6144; const float* nw = a->in[I_N1W] + l * D;
            bf16_t* hr = W.h() + (size_t)row * D;
#pragma unroll
            for (int j = 0; j < 4; ++j) { const int c = 4 * lane + 256 * j; const f32x4 w = *(const f32x4*)(nw + c), sh = *(const f32x4*)(md + c), sc = *(const f32x4*)(md + 1024 + c);
                float o[4];
#pragma unroll
                for (int i = 0; i < 4; ++i) o[i] = v[j][i] * r * w[i] * (1.f + sc[i]) + sh[i];
                u32x2 p; p.x = pk2(o[0], o[1]); p.y = pk2(o[2], o[3]); *(u32x2*)(hr + c) = p; }
        }
    }
}

DI void phase_prep(KArgs a, const WS& W, int l, LAS unsigned char* lds) {
    int tid_ = threadIdx.x; asm volatile("" : "+v"(tid_)); const int tid = tid_, lane = tid & 63, wid = __builtin_amdgcn_readfirstlane(tid >> 6);
    const int gw = blockIdx.x * 8 + wid, NGW = gridDim.x * 8;
    LAS float* wa = (LAS float*)lds;
    LAS float* cw = (LAS float*)(lds + 16384);
    __syncthreads();
    for (int i = tid; i < 4096; i += 512) wa[i] = a->in[I_GWA][l * 4096 + i];
    for (int i = tid; i < 1280; i += 512) cw[i] = a->in[I_MCW][l * 1280 + i];
    for (int i = tid; i < 256; i += 512) cw[1280 + i] = a->in[I_MCB][l * 256 + i];
    __syncthreads();
    const bf16_t* proj = W.proj();
    for (int row = gw; row < MA; row += NGW) {
        const bf16_t* pr = proj + (size_t)row * DINP;
        { const u32x2 c = *(const u32x2*)(pr + C_CQ + 4 * lane); float f[4] = {bf2f(c.x & 0xffffu), bf2f(c.x >> 16), bf2f(c.y & 0xffffu), bf2f(c.y >> 16)};
          const float r = rsqrtf(wave_sum((f[0] * f[0] + f[1] * f[1]) + (f[2] * f[2] + f[3] * f[3]), lane) * (1.f / 256.f) + EPS);
          const f32x4 g = *(const f32x4*)(a->in[I_QAN] + l * 256 + 4 * lane);
          u32x2 o; o.x = pk2(f[0] * r * g[0], f[1] * r * g[1]); o.y = pk2(f[2] * r * g[2], f[3] * r * g[3]); *(u32x2*)(W.cqn() + (size_t)row * 384 + 4 * lane) = o; }
        { const unsigned c = *(const unsigned*)(pr + C_CKV + 2 * lane); const float f0 = bf2f(c & 0xffffu), f1 = bf2f(c >> 16);
          const float r = rsqrtf(wave_sum(f0 * f0 + f1 * f1, lane) * (1.f / 128.f) + EPS);
          const f32x2 g = *(const f32x2*)(a->in[I_KVAN] + l * 128 + 2 * lane);
          *(unsigned*)(W.cqn() + (size_t)row * 384 + 256 + 2 * lane) = pk2(f0 * r * g[0], f1 * r * g[1]); }
        { const int s0 = row < ML ? (row / SEQ) * SEQ : ML + ((row - ML) / CTX) * CTX; const int Ls = row < ML ? SEQ : CTX; const int t = row - s0;
          float acc[4];
#pragma unroll
          for (int i = 0; i < 4; ++i) acc[i] = cw[1280 + 4 * lane + i];
#pragma unroll
          for (int k = 0; k < 5; ++k) { const int tt = t + k - 2;
              if (tt >= 0 && tt < Ls) { const u32x2 m = *(const u32x2*)(proj + (size_t)(s0 + tt) * DINP + C_MX + 4 * lane);
                  acc[0] += cw[k * 256 + 4 * lane + 0] * bf2f(m.x & 0xffffu); acc[1] += cw[k * 256 + 4 * lane + 1] * bf2f(m.x >> 16);
                  acc[2] += cw[k * 256 + 4 * lane + 2] * bf2f(m.y & 0xffffu); acc[3] += cw[k * 256 + 4 * lane + 3] * bf2f(m.y >> 16); } }
          u32x2 o; o.x = pk2(siluf(acc[0]), siluf(acc[1])); o.y = pk2(siluf(acc[2]), siluf(acc[3])); *(u32x2*)(W.xconv() + (size_t)row * 256 + 4 * lane) = o; }
        if (lane < 16) { const float g = bf2f(pr[C_MG + lane]) + a->in[I_MGB][l * 16 + lane]; W.gates()[(size_t)row * 16 + lane] = ((lane >> 2) & 1) ? logsigmoidf_(g) : g; }
        { const float av = lane < 32 ? bf2f(pr[C_GA + lane]) : 0.f;
#pragma unroll
          for (int u = 0; u < 2; ++u) { float s0 = a->in[I_GBA][(l * 2 + u) * 128 + lane], s1 = a->in[I_GBA][(l * 2 + u) * 128 + 64 + lane];
#pragma unroll
              for (int r = 0; r < 16; ++r) { const float ar = sh_idx(av, u * 16 + r); s0 += ar * wa[(u * 16 + r) * 128 + lane]; s1 += ar * wa[(u * 16 + r) * 128 + 64 + lane]; }
              float* lo = W.loga() + ((size_t)u * MA + row) * 128; lo[lane] = logsigmoidf_(s0) * (1.f / 16.f); lo[64 + lane] = logsigmoidf_(s1) * (1.f / 16.f); } }
    }
    __syncthreads();
    moe_weights(a, W, l, lds);
}

DI void phase_post(KArgs a, const WS& W, int l, LAS unsigned char* lds) {
    int tid_ = threadIdx.x; asm volatile("" : "+v"(tid_)); const int tid = tid_, lane = tid & 63, wid = __builtin_amdgcn_readfirstlane(tid >> 6);
    const int gw = blockIdx.x * 8 + wid, NGW = gridDim.x * 8;
    const int head = lane >> 3, sub = lane & 7, r32 = lane & 31, hi = lane >> 5;
    const bf16_t* proj = W.proj(); const bf16_t* raw = W.qkvraw();
    for (int row = gw; row < MA; row += NGW) {
        const bool lat = row < ML; const int b = lat ? row / SEQ : (row - ML) / CTX; const int t = lat ? row % SEQ : (row - ML) % CTX; const int kidx = lat ? t : SEQ + t;
        float cs[2], sn[2];
        if (lat) { cs[0] = W.rope()[t * 16 + sub * 2]; cs[1] = W.rope()[t * 16 + sub * 2 + 1]; sn[0] = W.rope()[SEQ * 16 + t * 16 + sub * 2]; sn[1] = W.rope()[SEQ * 16 + t * 16 + sub * 2 + 1]; }
        else { cs[0] = cs[1] = 1.f; sn[0] = sn[1] = 0.f; }
        { const bf16_t* qr = raw + (size_t)row * 1792 + head * 96; float f[8]; unpack8(*(const u32x4*)(qr + sub * 8), f);
          const unsigned u1 = *(const unsigned*)(qr + 64 + sub * 2), u2 = *(const unsigned*)(qr + 80 + sub * 2);
          float x1[2] = {bf2f(u1 & 0xffffu), bf2f(u1 >> 16)}, x2[2] = {bf2f(u2 & 0xffffu), bf2f(u2 >> 16)};
          float ss = x1[0] * x1[0] + x1[1] * x1[1] + x2[0] * x2[0] + x2[1] * x2[1];
#pragma unroll
          for (int i = 0; i < 8; ++i) ss += f[i] * f[i];
          ss += sh_xor(ss, 1, lane); ss += sh_xor(ss, 2, lane); ss += sh_xor(ss, 4, lane);
          const float r = rsqrtf(ss * (1.f / 96.f) + EPS) ; const float* nw = a->in[I_QNW] + l * 96;
#pragma unroll
          for (int i = 0; i < 8; ++i) f[i] = f[i] * r * nw[sub * 8 + i] * QSCALE;
          float o1[2], o2[2];
#pragma unroll
          for (int i = 0; i < 2; ++i) { const float a1 = x1[i] * r * nw[64 + sub * 2 + i], a2 = x2[i] * r * nw[80 + sub * 2 + i]; o1[i] = (a1 * cs[i] - a2 * sn[i]) * QSCALE; o2[i] = (a1 * sn[i] + a2 * cs[i]) * QSCALE; }
          bf16_t* qo = W.q() + ((size_t)(b * NH + head) * NKEY + kidx) * QK;
          *(u32x4*)(qo + sub * 8) = pack8(f); *(unsigned*)(qo + 64 + sub * 2) = pk2(o1[0], o1[1]); *(unsigned*)(qo + 80 + sub * 2) = pk2(o2[0], o2[1]); }
        { const bf16_t* kvr = raw + (size_t)row * 1792 + 768 + head * 128; float f[8]; unpack8(*(const u32x4*)(kvr + sub * 8), f);
          const bf16_t* pr = proj + (size_t)row * DINP + C_KR;
          const unsigned u1 = *(const unsigned*)(pr + sub * 2), u2 = *(const unsigned*)(pr + 16 + sub * 2);
          float x1[2] = {bf2f(u1 & 0xffffu), bf2f(u1 >> 16)}, x2[2] = {bf2f(u2 & 0xffffu), bf2f(u2 >> 16)};
          float ss = x1[0] * x1[0] + x1[1] * x1[1] + x2[0] * x2[0] + x2[1] * x2[1];
#pragma unroll
          for (int i = 0; i < 8; ++i) ss += f[i] * f[i];
          ss += sh_xor(ss, 1, lane); ss += sh_xor(ss, 2, lane); ss += sh_xor(ss, 4, lane);
          const float r = rsqrtf(ss * (1.f / 96.f) + EPS); const float* nw = a->in[I_KNW] + l * 96;
#pragma unroll
          for (int i = 0; i < 8; ++i) f[i] = f[i] * r * nw[sub * 8 + i];
          float o1[2], o2[2];
#pragma unroll
          for (int i = 0; i < 2; ++i) { const float a1 = x1[i] * r * nw[64 + sub * 2 + i], a2 = x2[i] * r * nw[80 + sub * 2 + i]; o1[i] = a1 * cs[i] - a2 * sn[i]; o2[i] = a1 * sn[i] + a2 * cs[i]; }
          const int tile = kidx >> 6, key = kidx & 63;
          bf16_t* kb = W.k() + ((size_t)(b * NH + head) * NTILE + tile) * 6144;
          *(u32x4*)(kb + (sub * 64 + key) * 8) = pack8(f);
          *(unsigned*)(kb + ((8 + (sub >> 2)) * 64 + key) * 8 + (sub & 3) * 2) = pk2(o1[0], o1[1]);
          *(unsigned*)(kb + ((10 + (sub >> 2)) * 64 + key) * 8 + (sub & 3) * 2) = pk2(o2[0], o2[1]);
          bf16_t* vb = W.v() + ((size_t)(b * NH + head) * NTILE + tile) * 4096;
          *(u32x4*)(vb + ((sub >> 2) * 4 + (key >> 4)) * 512 + (key & 15) * 32 + (sub & 3) * 8) = *(const u32x4*)(kvr + 64 + sub * 8); }
    }
    LAS bf16_t* As = (LAS bf16_t*)(lds + wid * WSCR);
    LAS bf16_t* Bs = As + 64 * 72;
    for (int u = gw; u < 2 * 16 * NCH; u += NGW) {
        const int kind = u / (16 * NCH), s = (u % (16 * NCH)) / NCH, gc = u % NCH, b = s >> 3, h = (s >> 1) & 3, dir = s & 1;
        const int row = tokrow(b, gc, lane);
        LDS_WAIT(); asm volatile("" ::: "memory");
        if (kind == 0) {
            const float logi = W.gates()[(size_t)row * 16 + dir * 8 + h], logf = W.gates()[(size_t)row * 16 + dir * 8 + 4 + h];
            const float bc = scan_incl(logf, lane, dir), bend = sh_idx(bc, dir ? 0 : 63), g = bend - bc + logi, gmax = wave_max(g, lane), wj = __expf(g - gmax);
#pragma unroll
            for (int i = 0; i < 8; ++i) { const int p = i * 8 + (lane >> 3), c8 = lane & 7; const int rp = tokrow(b, gc, p);
                float fv[8], fk[8]; unpack8(*(const u32x4*)(proj + (size_t)rp * DINP + C_MV + h * 64 + c8 * 8), fv); unpack8(*(const u32x4*)(W.mqk() + (size_t)rp * 512 + 256 + h * 64 + c8 * 8), fk);
                const float wp = sh_idx(wj, p);
#pragma unroll
                for (int e = 0; e < 8; ++e) { As[(c8 * 8 + e) * 72 + p] = (bf16_t)f2bf(fv[e]); Bs[(c8 * 8 + e) * 72 + p] = (bf16_t)f2bf(fk[e] * wp); } }
            LDS_WAIT(); asm volatile("" ::: "memory");
            float* ut = W.mu() + (size_t)(s * NCH + gc) * 4096;
#pragma unroll
            for (int mt = 0; mt < 2; ++mt)
#pragma unroll
                for (int nt = 0; nt < 2; ++nt) { f32x16 acc = {}; wmma32<4>(acc, As + mt * 32 * 72, 72, Bs + nt * 32 * 72, 72, r32, hi);
#pragma unroll
                    for (int r = 0; r < 16; ++r) ut[(32 * mt + crow(r, hi)) * 64 + 32 * nt + r32] = acc[r]; }
            float nsum = 0.f;
#pragma unroll 8
            for (int j = 0; j < 64; ++j) nsum += bf2f(Bs[lane * 72 + j]);
            W.mn()[(size_t)(s * NCH + gc) * 64 + lane] = nsum;
            if (lane == 0) { W.ms()[(size_t)(s * NCH + gc) * 4 + 0] = gmax; W.ms()[(size_t)(s * NCH + gc) * 4 + 1] = bend; }
        } else {
            float bc[32];
            { const float* lp = W.loga() + ((size_t)dir * MA + row) * 128 + h * 32;
#pragma unroll
              for (int q4 = 0; q4 < 8; ++q4) { const f32x4 v = *(const f32x4*)(lp + 4 * q4); bc[4 * q4] = v[0]; bc[4 * q4 + 1] = v[1]; bc[4 * q4 + 2] = v[2]; bc[4 * q4 + 3] = v[3]; } }
#pragma unroll
            for (int d = 0; d < 32; ++d) bc[d] = scan_incl(bc[d], lane, dir);
            float kk[32];
#pragma unroll
            for (int q8 = 0; q8 < 4; ++q8) { float f[8]; unpack8(*(const u32x4*)(proj + (size_t)row * DINP + C_GK + h * 32 + q8 * 8), f);
#pragma unroll
                for (int e = 0; e < 8; ++e) kk[q8 * 8 + e] = f[e]; }
            float* gdp = W.gd() + (size_t)(s * NCH + gc) * 32;
#pragma unroll
            for (int d = 0; d < 32; ++d) { const float bend = sh_idx(bc[d], dir ? 0 : 63); Bs[d * 72 + lane] = (bf16_t)f2bf(kk[d] * __expf(bend - bc[d])); if (lane == d) gdp[d] = __expf(bend); }
#pragma unroll
            for (int i = 0; i < 8; ++i) { const int p = i * 8 + (lane >> 3), c8 = lane & 7; const int rp = tokrow(b, gc, p);
                float fv[8]; unpack8(*(const u32x4*)(proj + (size_t)rp * DINP + C_GV + h * 64 + c8 * 8), fv);
#pragma unroll
                for (int e = 0; e < 8; ++e) As[(c8 * 8 + e) * 72 + p] = (bf16_t)f2bf(fv[e]); }
            LDS_WAIT(); asm volatile("" ::: "memory");
            float* ut = W.gu() + (size_t)(s * NCH + gc) * 2048;
#pragma unroll
            for (int mt = 0; mt < 2; ++mt) { f32x16 acc = {}; wmma32<4>(acc, As + mt * 32 * 72, 72, Bs, 72, r32, hi);
#pragma unroll
                for (int r = 0; r < 16; ++r) ut[(32 * mt + crow(r, hi)) * 32 + r32] = acc[r]; }
        }
    }
}

DI int scan_gc(int dir, int sc) { return dir ? (NCH - 1 - sc) : (sc < 4 ? 128 + sc : sc - 4); }
DI void phase_scan(const WS& W, LAS unsigned char* lds) {
    int tid_ = threadIdx.x; asm volatile("" : "+v"(tid_)); const int tid = tid_;
    LAS float* gm = (LAS float*)lds; LAS float* be = gm + NCH; LAS float* dec = be + NCH; LAS float* ff = dec + NCH; LAS float* mi = ff + NCH;
    for (int u = blockIdx.x; u < 192; u += gridDim.x) {
        __syncthreads();
        if (u < 128) {
            const int s = u >> 3, slice = u & 7, dir = s & 1;
            if (tid < NCH) { const int gc = scan_gc(dir, tid); gm[tid] = W.ms()[(size_t)(s * NCH + gc) * 4 + 0]; be[tid] = W.ms()[(size_t)(s * NCH + gc) * 4 + 1]; }
            __syncthreads();
            if (tid == 0) { float m = 0.f; for (int sc = 0; sc < NCH; ++sc) { mi[sc] = m; const float mn = fmaxf(be[sc] + m, gm[sc]); dec[sc] = __expf(be[sc] + m - mn); ff[sc] = __expf(gm[sc] - mn); m = mn; } }
            __syncthreads();
            const int e = slice * 512 + tid; float C = 0.f, nn = 0.f;
            const bool do_n = (slice == 0 && tid < 64);
            for (int sc = 0; sc < NCH; ++sc) { const int gc = scan_gc(dir, sc);
                float* p = W.mu() + (size_t)(s * NCH + gc) * 4096 + e; const float uu = *p; *p = C; C = dec[sc] * C + ff[sc] * uu;
                if (do_n) { float* q = W.mn() + (size_t)(s * NCH + gc) * 64 + tid; const float un = *q; *q = nn; nn = dec[sc] * nn + ff[sc] * un; }
                if (slice == 0 && tid == 64) W.ms()[(size_t)(s * NCH + gc) * 4 + 2] = mi[sc]; }
        } else {
            const int s = (u - 128) >> 2, slice = (u - 128) & 3, dir = s & 1; const int e = slice * 512 + tid, d = e & 31; float S = 0.f;
            for (int sc = 0; sc < NCH; ++sc) { const int gc = scan_gc(dir, sc);
                const float dcy = W.gd()[(size_t)(s * NCH + gc) * 32 + d]; float* p = W.gu() + (size_t)(s * NCH + gc) * 2048 + e; const float uu = *p; *p = S; S = dcy * S + uu; }
        }
    }
    __syncthreads();
}

constexpr int AT_SLOT = 20480, AT_WS = 3 * AT_SLOT, AT_OST = AT_WS + 2048;
DI void glds16(const void* gsrc, unsigned lds_dst) { unsigned keep;
    asm volatile("s_mov_b32 %0, m0\n\ts_mov_b32 m0, %2\n\ts_nop 0\n\tglobal_load_lds_dwordx4 %1, off\n\ts_mov_b32 m0, %0" : "=&s"(keep) : "v"(gsrc), "s"(lds_dst) : "memory"); }
DI s16x4 vtr(const LAS char* p) { typedef short v4i16_t __attribute__((ext_vector_type(4))); return __builtin_bit_cast(s16x4, __builtin_amdgcn_ds_read_tr16_b64_v4i16((LAS v4i16_t*)p)); }
DI void attn_unit(const WS& W, LAS unsigned char* lds, int b, int h, int tq0, int tile0, int nt, int orow0) {
    int tid_ = threadIdx.x; asm volatile("" : "+v"(tid_)); const int tid = tid_, lane = tid & 63, r32 = lane & 31, hi = lane >> 5; const int wid = __builtin_amdgcn_readfirstlane(tid >> 6);
    const unsigned lds0 = (unsigned)(uintptr_t)lds;
    const bf16_t* Qw = W.q() + ((size_t)(b * NH + h) * NKEY + tq0 + wid * 32 + r32) * QK;
    const char* Kt = (const char*)(W.k() + ((size_t)(b * NH + h) * NTILE + tile0) * 6144);
    const char* Vt = (const char*)(W.v() + ((size_t)(b * NH + h) * NTILE + tile0) * 4096);
    const int np = wid < 4 ? 3 : 2;
#define AT_ISSUE(t, slot) do { const char* kt_ = Kt + (size_t)(t) * 12288; const char* vt_ = Vt + (size_t)(t) * 8192; const unsigned d_ = lds0 + (slot) * AT_SLOT; \
        glds16(kt_ + wid * 1024 + lane * 16, (unsigned)__builtin_amdgcn_readfirstlane(d_ + wid * 1024)); \
        if (wid < 4) { glds16(kt_ + (wid + 8) * 1024 + lane * 16, (unsigned)__builtin_amdgcn_readfirstlane(d_ + (wid + 8) * 1024)); glds16(vt_ + (wid + 4) * 1024 + lane * 16, (unsigned)__builtin_amdgcn_readfirstlane(d_ + (wid + 16) * 1024)); } \
        else { glds16(vt_ + (wid - 4) * 1024 + lane * 16, (unsigned)__builtin_amdgcn_readfirstlane(d_ + (wid + 8) * 1024)); } } while (0)
    bf16x8 qr[6];
#pragma unroll
    for (int d0 = 0; d0 < 6; ++d0) qr[d0] = *(const bf16x8*)(Qw + d0 * 16 + hi * 8);
    VM_WAIT();
    AT_ISSUE(0, 0);
    if (nt > 1) AT_ISSUE(1, 1);
    f32x16 o[2]; o[0] = f32x16{}; o[1] = f32x16{}; float l_reg = 0.f;
    const int vb = ((lane >> 4) & 1) * 32 + (lane & 3) * 8 + (4 * hi + ((lane & 15) >> 2)) * 64;
    int slot = 0;
    for (int t = 0; t < nt; ++t) {
        if (t + 1 < nt) { if (np == 3) asm volatile("s_waitcnt vmcnt(3)\n\ts_waitcnt lgkmcnt(0)\n\ts_barrier" ::: "memory"); else asm volatile("s_waitcnt vmcnt(2)\n\ts_waitcnt lgkmcnt(0)\n\ts_barrier" ::: "memory"); }
        else asm volatile("s_waitcnt vmcnt(0)\n\ts_waitcnt lgkmcnt(0)\n\ts_barrier" ::: "memory");
        if (t + 2 < nt) { const int s2 = slot >= 1 ? slot - 1 : 2; AT_ISSUE(t + 2, s2); }
        const LAS char* Ks = (const LAS char*)lds + slot * AT_SLOT; const LAS char* Vs = Ks + 12288;
        f32x16 p0 = f32x16{}, p1 = f32x16{};
#pragma unroll
        for (int d0 = 0; d0 < 6; ++d0) {
            const bf16x8 k0 = *(const LAS bf16x8*)(Ks + (2 * d0 + hi) * 1024 + r32 * 16);
            const bf16x8 k1 = *(const LAS bf16x8*)(Ks + (2 * d0 + hi) * 1024 + (32 + r32) * 16);
            p0 = __builtin_amdgcn_mfma_f32_32x32x16_bf16(k0, qr[d0], p0, 0, 0, 0);
            p1 = __builtin_amdgcn_mfma_f32_32x32x16_bf16(k1, qr[d0], p1, 0, 0, 0);
        }
        float sacc = 0.f;
#pragma unroll
        for (int r = 0; r < 16; ++r) { p0[r] = __builtin_amdgcn_exp2f(p0[r]); p1[r] = __builtin_amdgcn_exp2f(p1[r]); sacc += p0[r] + p1[r]; }
        l_reg += sacc;
        u32x4 pw[4];
#pragma unroll
        for (int j = 0; j < 4; ++j) { pw[0][j] = cvtpk(p0[2 * j], p0[2 * j + 1]); pw[1][j] = cvtpk(p0[8 + 2 * j], p0[8 + 2 * j + 1]);
            pw[2][j] = cvtpk(p1[2 * j], p1[2 * j + 1]); pw[3][j] = cvtpk(p1[8 + 2 * j], p1[8 + 2 * j + 1]); }
#pragma unroll
        for (int d0 = 0; d0 < 2; ++d0)
#pragma unroll
            for (int ks = 0; ks < 4; ++ks) {
                const s16x4 lo = vtr(Vs + vb + d0 * 4096 + ks * 1024), hh = vtr(Vs + vb + d0 * 4096 + ks * 1024 + 512);
                const bf16x8 vf = (bf16x8){lo[0], lo[1], lo[2], lo[3], hh[0], hh[1], hh[2], hh[3]};
                o[d0] = __builtin_amdgcn_mfma_f32_32x32x16_bf16(__builtin_bit_cast(bf16x8, pw[ks]), vf, o[d0], 0, 0, 0);
            }
        slot = slot == 2 ? 0 : slot + 1;
    }
#undef AT_ISSUE
    { auto rr = __builtin_amdgcn_permlane32_swap(__float_as_uint(l_reg), __float_as_uint(l_reg), false, false); l_reg = __uint_as_float(rr[0]) + __uint_as_float(rr[1]); }
    LAS float* wsf = (LAS float*)(lds + AT_WS) + wid * 64;
    if (hi == 0) wsf[r32] = l_reg;
    LDS_WAIT();
    float rli[16];
#pragma unroll
    for (int r = 0; r < 16; ++r) rli[r] = 1.f / wsf[crow(r, hi)];
    LAS bf16_t* stg = (LAS bf16_t*)(lds + AT_OST) + wid * 2048;
#pragma unroll
    for (int r = 0; r < 16; ++r) { const int orow = crow(r, hi);
#pragma unroll
        for (int d0 = 0; d0 < 2; ++d0) stg[orow * 64 + d0 * 32 + r32] = (bf16_t)f2bf(o[d0][r] * rli[r]); }
    LDS_WAIT();
    bf16_t* Ow = W.mix() + (size_t)(orow0 + wid * 32) * D + h * 64;
#pragma unroll
    for (int i = 0; i < 4; ++i) { const int row = i * 8 + (lane >> 3), ch = lane & 7; u32x4 v = *(const LAS u32x4*)(stg + row * 64 + ch * 8);
#ifdef PROBE_NOATT
        v = (u32x4){0u, 0u, 0u, 0u};
#endif
        *(u32x4*)(Ow + (size_t)row * D + ch * 8) = v; }
    asm volatile("s_waitcnt lgkmcnt(0)\n\ts_barrier" ::: "memory");
}
DI void phase_attn(const WS& W, LAS unsigned char* lds, bool need_ctx) {
    const int G = gridDim.x, bx = blockIdx.x; const int vcu = (G % 8 == 0) ? (bx % 8) * (G / 8) + bx / 8 : bx;
    for (int L = vcu; L < 512; L += G) {
        int bh, qb; if (G == 256) { const int i = L >> 8, v = L & 255; bh = (v >> 5) * 2 + i; qb = v & 31; } else { bh = L >> 5; qb = L & 31; }
        attn_unit(W, lds, bh >> 3, bh & 7, qb * 256, 0, NTILE, (bh >> 3) * SEQ + qb * 256);
    }
    if (need_ctx) for (int L = vcu; L < 16; L += G) attn_unit(W, lds, L >> 3, L & 7, SEQ, 128, 4, ML + (L >> 3) * CTX);
}

DI void mlstm_out_unit(KArgs a, const WS& W, int l, int b, int h, int gc, LAS unsigned char* lds) {
    int tid_ = threadIdx.x; asm volatile("" : "+v"(tid_)); const int tid = tid_, lane = tid & 63, r32 = lane & 31, hi = lane >> 5; const int wid = __builtin_amdgcn_readfirstlane(tid >> 6);
    LAS bf16_t* qs = (LAS bf16_t*)lds; LAS bf16_t* ks = qs + 4608; LAS bf16_t* vT = ks + 4608; LAS bf16_t* CT = vT + 4608  ; LAS bf16_t* P = CT + 2 * 4608  ;
    LAS float* Hs = (LAS float*)(lds + 64512)  ; LAS float* sm = (LAS float*)(lds + 97280);
    const bf16_t* proj = W.proj();
    { const int p = tid >> 3, c8 = tid & 7; const int rp = tokrow(b, gc, p);
      *(LAS u32x4*)(qs + p * 72 + c8 * 8) = *(const u32x4*)(W.mqk() + (size_t)rp * 512 + h * 64 + c8 * 8);
      *(LAS u32x4*)(ks + p * 72 + c8 * 8) = *(const u32x4*)(W.mqk() + (size_t)rp * 512 + 256 + h * 64 + c8 * 8);
      float fv[8]; unpack8(*(const u32x4*)(proj + (size_t)rp * DINP + C_MV + h * 64 + c8 * 8), fv);
#pragma unroll
      for (int e = 0; e < 8; ++e) vT[(c8 * 8 + e) * 72 + p] = (bf16_t)f2bf(fv[e]);
#pragma unroll
      for (int dir = 0; dir < 2; ++dir) { const int s = (b * 4 + h) * 2 + dir; const float* cp = W.mu() + (size_t)(s * NCH + gc) * 4096 + p * 64 + c8 * 8;
          const f32x4 c0 = *(const f32x4*)cp, c1 = *(const f32x4*)(cp + 4); float f[8] = {c0[0], c0[1], c0[2], c0[3], c1[0], c1[1], c1[2], c1[3]};
          *(LAS u32x4*)(CT + dir * 4608 + p * 72 + c8 * 8) = pack8(f); }
      if (tid < 128) { const int dir = tid >> 6, d = tid & 63; const int s = (b * 4 + h) * 2 + dir; sm[dir * 384 + 4 * 64 + d] = W.mn()[(size_t)(s * NCH + gc) * 64 + d]; } }
    if ((wid & 3) == 0) { const int dir = wid >> 2; const int s = (b * 4 + h) * 2 + dir; const int row = tokrow(b, gc, lane);
        const float logi = W.gates()[(size_t)row * 16 + dir * 8 + h], logf = W.gates()[(size_t)row * 16 + dir * 8 + 4 + h];
        const float mst = W.ms()[(size_t)(s * NCH + gc) * 4 + 2];
        const float bc = scan_incl(logf, lane, dir), av = logi - bc, amax = scan_max(av, lane, dir), mt = bc + fmaxf(mst, amax);
        LAS float* sd = sm + dir * 384; sd[lane] = bc - mt; sd[64 + lane] = av; sd[128 + lane] = __expf(bc + mst - mt); sd[192 + lane] = __expf(-mt); }
    __syncthreads();
    const int dir = wid >> 2, mt_ = (wid >> 1) & 1, nt_ = wid & 1; LAS float* sd = sm + dir * 384; LAS bf16_t* Pd = P + dir * 4608;
    { f32x16 acc = {}; wmma32<4>(acc, qs + mt_ * 32 * 72, 72, ks + nt_ * 32 * 72, 72, r32, hi);
      const int j = 32 * nt_ + r32; const float bj = sd[64 + j];
#pragma unroll
      for (int r = 0; r < 16; ++r) { const int t = 32 * mt_ + crow(r, hi); const bool ok = dir ? (j >= t) : (j <= t); const float w = ok ? __expf(sd[t] + bj) : 0.f; Pd[t * 72 + j] = (bf16_t)f2bf(acc[r] * w); } }
    __syncthreads();
    f32x16 acc = {};
    wmma32<4>(acc, qs + mt_ * 32 * 72, 72, CT + dir * 4608 + nt_ * 32 * 72, 72, r32, hi);
#pragma unroll
    for (int r = 0; r < 16; ++r) acc[r] *= sd[128 + 32 * mt_ + crow(r, hi)];
    wmma32<4>(acc, Pd + mt_ * 32 * 72, 72, vT + nt_ * 32 * 72, 72, r32, hi);
    if (nt_ == 0 && lane < 32) { const int t = 32 * mt_ + lane; float rs = 0.f, qn = 0.f;
#pragma unroll 8
        for (int j = 0; j < 64; ++j) { rs += bf2f(Pd[t * 72 + j]); qn += bf2f(qs[t * 72 + j]) * sd[256 + j]; }
        const float den = rs + sd[128 + t] * qn; sd[320 + t] = 1.f / fmaxf(fabsf(den), sd[192 + t]); }
    __syncthreads();
#pragma unroll
    for (int r = 0; r < 16; ++r) { const int t = 32 * mt_ + crow(r, hi); Hs[dir * 4096 + t * 64 + 32 * nt_ + r32] = acc[r] * sd[320 + t]; }
    __syncthreads();
    { const int t = tid >> 3, v0 = (tid & 7) * 8; const int row = tokrow(b, gc, t); float hv[8]; float ss = 0.f;
#pragma unroll
      for (int e = 0; e < 8; ++e) { hv[e] = Hs[t * 64 + v0 + e] + Hs[4096 + t * 64 + v0 + e]; ss += hv[e] * hv[e]; }
      ss += sh_xor(ss, 1, lane); ss += sh_xor(ss, 2, lane); ss += sh_xor(ss, 4, lane);
      const float r = rsqrtf(ss * (1.f / 64.f) + EPS);
      float xcv[8], ov[8]; unpack8(*(const u32x4*)(W.xconv() + (size_t)row * 256 + h * 64 + v0), xcv); unpack8(*(const u32x4*)(proj + (size_t)row * DINP + C_MO + h * 64 + v0), ov);
      const float* nw = a->in[I_MNW] + l * 256 + h * 64 + v0; const float* sk = a->in[I_MSK] + l * 256 + h * 64 + v0; float o[8];
#pragma unroll
      for (int e = 0; e < 8; ++e) o[e] = sigmoidf_(ov[e]) * (hv[e] * r * nw[e] + sk[e] * xcv[e]);
      *(u32x4*)(W.mix() + (size_t)row * D + 512 + h * 64 + v0) = pack8(o); }
    __syncthreads();
}
DI void gla_out_unit(KArgs a, const WS& W, int l, int b, int h, int gc, LAS unsigned char* lds) {
    int tid_ = threadIdx.x; asm volatile("" : "+v"(tid_)); const int tid = tid_, lane = tid & 63, r32 = lane & 31, hi = lane >> 5; const int wid = __builtin_amdgcn_readfirstlane(tid >> 6);
    LAS bf16_t* qs = (LAS bf16_t*)lds  ; LAS bf16_t* ks = qs + 2 * 2560; LAS bf16_t* vT = ks + 2 * 2560  ; LAS bf16_t* ST = vT + 4608  ; LAS bf16_t* P = ST + 2 * 2560  ;
    LAS float* Hs = (LAS float*)(lds + 58368);
    const bf16_t* proj = W.proj();
    { const int p = tid >> 3, c8 = tid & 7; const int rp = tokrow(b, gc, p);
      float fv[8]; unpack8(*(const u32x4*)(proj + (size_t)rp * DINP + C_GV + h * 64 + c8 * 8), fv);
#pragma unroll
      for (int e = 0; e < 8; ++e) vT[(c8 * 8 + e) * 72 + p] = (bf16_t)f2bf(fv[e]);
      const int dir = tid >> 8, idx = tid & 255, v = idx >> 2, d0 = (idx & 3) * 8; const int s = (b * 4 + h) * 2 + dir;
      const float* sp = W.gu() + (size_t)(s * NCH + gc) * 2048 + v * 32 + d0; const f32x4 c0 = *(const f32x4*)sp, c1 = *(const f32x4*)(sp + 4);
      float f[8] = {c0[0], c0[1], c0[2], c0[3], c1[0], c1[1], c1[2], c1[3]}; *(LAS u32x4*)(ST + dir * 2560 + v * 40 + d0) = pack8(f); }
    if ((wid & 3) == 0) { const int dir = wid >> 2; const int row = tokrow(b, gc, lane);
        float bc[32];
        { const float* lp = W.loga() + ((size_t)dir * MA + row) * 128 + h * 32;
#pragma unroll
          for (int q4 = 0; q4 < 8; ++q4) { const f32x4 v = *(const f32x4*)(lp + 4 * q4); bc[4 * q4] = v[0]; bc[4 * q4 + 1] = v[1]; bc[4 * q4 + 2] = v[2]; bc[4 * q4 + 3] = v[3]; } }
#pragma unroll
        for (int d = 0; d < 32; ++d) bc[d] = scan_incl(bc[d], lane, dir);
#pragma unroll
        for (int q8 = 0; q8 < 4; ++q8) { float fq[8], fk[8]; unpack8(*(const u32x4*)(proj + (size_t)row * DINP + C_GQ + h * 32 + q8 * 8), fq); unpack8(*(const u32x4*)(proj + (size_t)row * DINP + C_GK + h * 32 + q8 * 8), fk);
#pragma unroll
            for (int e = 0; e < 8; ++e) { fq[e] = fq[e] * 0.17677669529663687f * __expf(bc[q8 * 8 + e]); fk[e] = fk[e] * __expf(-bc[q8 * 8 + e]); }
            *(LAS u32x4*)(qs + dir * 2560 + lane * 40 + q8 * 8) = pack8(fq); *(LAS u32x4*)(ks + dir * 2560 + lane * 40 + q8 * 8) = pack8(fk); } }
    __syncthreads();
    const int dir = wid >> 2, mt_ = (wid >> 1) & 1, nt_ = wid & 1; LAS bf16_t* Pd = P + dir * 4608;
    { f32x16 acc = {}; wmma32<2>(acc, qs + dir * 2560 + mt_ * 32 * 40, 40, ks + dir * 2560 + nt_ * 32 * 40, 40, r32, hi);
      const int j = 32 * nt_ + r32;
#pragma unroll
      for (int r = 0; r < 16; ++r) { const int t = 32 * mt_ + crow(r, hi); const bool ok = dir ? (j >= t) : (j <= t); Pd[t * 72 + j] = (bf16_t)f2bf(ok ? acc[r] : 0.f); } }
    __syncthreads();
    f32x16 acc = {};
    wmma32<2>(acc, qs + dir * 2560 + mt_ * 32 * 40, 40, ST + dir * 2560 + nt_ * 32 * 40, 40, r32, hi);
    wmma32<4>(acc, Pd + mt_ * 32 * 72, 72, vT + nt_ * 32 * 72, 72, r32, hi);
#pragma unroll
    for (int r = 0; r < 16; ++r) { const int t = 32 * mt_ + crow(r, hi); Hs[dir * 4096 + t * 64 + 32 * nt_ + r32] = acc[r]; }
    __syncthreads();
    { const int t = tid >> 3, v0 = (tid & 7) * 8; const int row = tokrow(b, gc, t); float hv[8]; float ss = 0.f;
#pragma unroll
      for (int e = 0; e < 8; ++e) { hv[e] = Hs[t * 64 + v0 + e] + Hs[4096 + t * 64 + v0 + e]; ss += hv[e] * hv[e]; }
      ss += sh_xor(ss, 1, lane); ss += sh_xor(ss, 2, lane); ss += sh_xor(ss, 4, lane);
      const float r = rsqrtf(ss * (1.f / 64.f) + EPS);
      float rv[8]; unpack8(*(const u32x4*)(proj + (size_t)row * DINP + C_GR + h * 64 + v0), rv);
      const float* nw = a->in[I_GNW] + l * 256 + h * 64 + v0; float o[8];
#pragma unroll
      for (int e = 0; e < 8; ++e) o[e] = hv[e] * r * nw[e] * siluf(rv[e]);
      *(u32x4*)(W.mix() + (size_t)row * D + 768 + h * 64 + v0) = pack8(o); }
    __syncthreads();
}
DI void phase_chunkout(KArgs a, const WS& W, int l, LAS unsigned char* lds) {
    const int nch = (l < DEPTH - 1) ? NCH : 128;
    for (int u = blockIdx.x; u < 2 * 8 * nch; u += gridDim.x) {
        const int kind = u / (8 * nch), rem = u % (8 * nch), bh = rem / nch, gc = rem % nch;
        if (kind == 0) mlstm_out_unit(a, W, l, bh >> 2, bh & 3, gc, lds); else gla_out_unit(a, W, l, bh >> 2, bh & 3, gc, lds);
    }
}

DI void phase_router(KArgs a, const WS& W, int l, int nrows, LAS unsigned char* lds) {
    int tid_ = threadIdx.x; asm volatile("" : "+v"(tid_)); const int tid = tid_, lane = tid & 63, wid = __builtin_amdgcn_readfirstlane(tid >> 6);
    const int gw = blockIdx.x * 8 + wid, NGW = gridDim.x * 8;
    LAS float* WT = (LAS float*)lds;
    __syncthreads();
    for (int i = tid; i < 36 * 1024; i += 512) { const int e = i >> 10, k = i & 1023; WT[i] = e < 4 ? a->in[I_WGRP][(size_t)l * D * 4 + k * 4 + e] : a->in[I_WER][(size_t)l * D * 32 + k * 32 + (e - 4)]; }
    __syncthreads();
    unsigned* cnt = W.ctl() + CW_CNT + l * NEXP;
    for (int row = gw; row < nrows; row += NGW) {
        const float* xr = row < ML ? a->out + (size_t)row * D : W.xc() + (size_t)(row - ML) * D;
        const int vec = row < SEQ ? 0 : (row < ML ? 1 : 2);
        f32x4 v[4]; float ss = 0.f;
#pragma unroll
        for (int j = 0; j < 4; ++j) { v[j] = *(const f32x4*)(xr + 4 * lane + 256 * j); ss += (v[j][0] * v[j][0] + v[j][1] * v[j][1]) + (v[j][2] * v[j][2] + v[j][3] * v[j][3]); }
        const float r = rsqrtf(wave_sum(ss, lane) * (1.f / D) + EPS);
        const float* md = W.mods() + (size_t)(l * 3 + vec) * 6144; const float* nw = a->in[I_N2W] + l * D; bf16_t* hr = W.h() + (size_t)row * D;
#pragma unroll
        for (int j = 0; j < 4; ++j) { const int c = 4 * lane + 256 * j; const f32x4 w = *(const f32x4*)(nw + c), sh = *(const f32x4*)(md + 3072 + c), sc = *(const f32x4*)(md + 4096 + c);
#pragma unroll
            for (int i = 0; i < 4; ++i) v[j][i] = v[j][i] * r * w[i] * (1.f + sc[i]) + sh[i];
            u32x2 p; p.x = pk2(v[j][0], v[j][1]); p.y = pk2(v[j][2], v[j][3]); *(u32x2*)(hr + c) = p; }
        LAS float* lg = (LAS float*)(lds + 147456) + wid * 64;
#pragma unroll 2
        for (int e = 0; e < 36; ++e) { float s = 0.f;
#pragma unroll
            for (int j = 0; j < 4; ++j) { const f32x4 w = *(const LAS f32x4*)(WT + e * 1024 + 4 * lane + 256 * j); s += (v[j][0] * w[0] + v[j][1] * w[1]) + (v[j][2] * w[2] + v[j][3] * w[3]); }
            s = wave_sum(s, lane); if (lane == 0) lg[e] = s; }
        LDS_WAIT(); asm volatile("" ::: "memory");
        int g = 0; float gmx = lg[0] + a->in[I_BGRP][l * 4];
        float gl[4];
#pragma unroll
        for (int i = 0; i < 4; ++i) gl[i] = lg[i] + a->in[I_BGRP][l * 4 + i];
#pragma unroll
        for (int i = 1; i < 4; ++i) if (gl[i] > gmx) { gmx = gl[i]; g = i; }
        float gz = 0.f;
#pragma unroll
        for (int i = 0; i < 4; ++i) gz += __expf(gl[i] - gmx);
        const float gwt = 1.f / gz;
        float el[8];
#pragma unroll
        for (int i = 0; i < 8; ++i) el[i] = lg[4 + g * 8 + i] + a->in[I_BER][l * 32 + g * 8 + i];
        int i1 = 0; float m1 = el[0];
#pragma unroll
        for (int i = 1; i < 8; ++i) if (el[i] > m1) { m1 = el[i]; i1 = i; }
        int i2 = -1; float m2 = -3.0e38f;
#pragma unroll
        for (int i = 0; i < 8; ++i) if (i != i1 && el[i] > m2) { m2 = el[i]; i2 = i; }
        const float ex = __expf(m2 - m1), w1 = gwt / (1.f + ex), w2 = gwt * ex / (1.f + ex);
        if (lane == 0) {
#ifdef FIXED_ROUTE
            const int e1 = (row * 7) & 31, e2 = (e1 + 13) & 31;
#else
            const int e1 = g * 8 + i1, e2 = g * 8 + i2;
#endif
            const unsigned s1 = atomicAdd(cnt + e1, 1u), s2 = atomicAdd(cnt + e2, 1u);
            W.pair()[(size_t)e1 * PAIRCAP + s1] = row * 2; W.pw()[(size_t)e1 * PAIRCAP + s1] = w1;
            W.pair()[(size_t)e2 * PAIRCAP + s2] = row * 2 + 1; W.pw()[(size_t)e2 * PAIRCAP + s2] = w2;
        }
    }
}
DI void moe_tables(const WS& W, int l, LAS unsigned char* lds) {
    volatile LAS int* toff = (volatile LAS int*)(lds + MISC_OFF + 64); volatile LAS int* cn = (volatile LAS int*)(lds + MISC_OFF + 256);
    __syncthreads();
    if (threadIdx.x == 0) { int acc = 0; for (int e = 0; e < NEXP; ++e) { const int c = (int)__hip_atomic_load(W.ctl() + CW_CNT + l * NEXP + e, __ATOMIC_RELAXED, __HIP_MEMORY_SCOPE_AGENT); cn[e] = c; toff[e] = acc; acc += (c + 255) >> 8; } toff[NEXP] = acc; }
    __syncthreads();
}

__global__ void __launch_bounds__(512, 2) fwd_kernel(Args a) {
    extern __shared__ __attribute__((aligned(16))) unsigned char lds_raw[];
    LAS unsigned char* lds = (LAS unsigned char*)lds_raw;
    const KArgs ka = (KArgs)__builtin_amdgcn_kernarg_segment_ptr();
#define AL() ({ KArgs al_ = ka; asm volatile("" : "+s"(al_)); al_; })
#define WL() (WS{AL()->ws})
#define LL() ({ int l_ = l; asm volatile("" : "+s"(l_)); l_; })
    const WS W{a.ws};
    const int tid = threadIdx.x, G = gridDim.x;
    volatile LAS unsigned* misc = (volatile LAS unsigned*)(lds + MISC_OFF);
    if (tid < 4) misc[tid] = 0u;
    __syncthreads();
    const bool fused = (a.ph_hi - a.ph_lo) > 1;
    XcdBarrier bar; bar.bar = W.ctl() + CW_BAR; bar.x = 0; bar.st = misc;
    if (fused) bar = xcd_barrier_post(W.ctl() + CW_BAR, misc);
    const int lo = a.ph_lo, hi = a.ph_hi;
#ifndef PHMASK
#define PHMASK 0xFFFFFFFFu
#endif
#ifndef NO_MOE
#define NO_MOE 0
#endif
#define RUN(k) (lo <= (k) && (k) < hi)
#define EN(j) ((PHMASK >> (j)) & 1u)
#define SEAM(k) do { if (lo <= (k) && (k) + 1 < hi) xcd_barrier(bar); } while (0)
    if (EN(11) && RUN(0)) { phase_prologue(AL(), WL(), lds); }
    SEAM(0);
    for (int l = 0; l < DEPTH; ++l) {
        const int p0 = 1 + l * NPL; const bool need_ctx = l < DEPTH - 1; const int mrows = need_ctx ? MA : ML;
        if (lo >= p0 + NPL || hi <= p0) continue;
        if (EN(0) && RUN(p0 + 0)) { phase_norm1(AL(), WL(), LL(), l - 1, (l > 0) && !NO_MOE, true, MA); }
        SEAM(p0 + 0);
        if (EN(1) && RUN(p0 + 1)) { const WS W = WL(); pg8::DenseSched S; S.init(W.h(), W.wl(LL(), WL_IN), D, D, MA, DINP, G, (int)blockIdx.x); pg8::EpiBf16 E{W.proj(), DINP}; pg8::gemm_phase(lds, S, E, D, D); }
        SEAM(p0 + 1);
        if (EN(2) && RUN(p0 + 2)) { phase_prep(AL(), WL(), LL(), lds); }
        SEAM(p0 + 2);
        if (EN(3) && RUN(p0 + 3)) { const WS W = WL();
            { pg8::DenseSched S; S.init(W.cqn(), W.wl(LL(), WL_UP), 384, 384, MA, 1792, G, (int)blockIdx.x); pg8::EpiBf16 E{W.qkvraw(), 1792}; pg8::gemm_phase(lds, S, E, 384, 384); }
            { pg8::DenseSched S; S.init(W.xconv(), W.wl(LL(), WL_MQK), 256, 256, MA, 512, G, (int)blockIdx.x); pg8::EpiBf16 E{W.mqk(), 512}; pg8::gemm_phase(lds, S, E, 256, 256); }
        }
        SEAM(p0 + 3);
        if (EN(4) && RUN(p0 + 4)) { phase_post(AL(), WL(), LL(), lds); }
        SEAM(p0 + 4);
        if (EN(5) && RUN(p0 + 5)) { { const WS W2 = WL(); phase_scan(W2, lds); phase_attn(W2, lds, need_ctx); } }
        SEAM(p0 + 5);
        if (EN(6) && RUN(p0 + 6)) { phase_chunkout(AL(), WL(), LL(), lds); }
        SEAM(p0 + 6);
        if (EN(7) && RUN(p0 + 7)) { const WS W = WL(); float* outp = AL()->out; pg8::DenseSched S; S.init(W.mix(), W.wl(LL(), WL_OUT), D, D, mrows, D, G, (int)blockIdx.x); pg8::EpiResid E{outp, W.xc(), W.mods() + (size_t)LL() * 3 * 6144 + 2048}; pg8::gemm_phase(lds, S, E, D, D); }
        SEAM(p0 + 7);
        if (!NO_MOE && EN(8) && RUN(p0 + 8)) { phase_router(AL(), WL(), LL(), mrows, lds); }
        SEAM(p0 + 8);
        if (!NO_MOE && EN(9) && RUN(p0 + 9)) { const WS W = WL(); moe_tables(W, LL(), lds);
            pg8::MoeSched<true> S{W.h(), W.wgu(), D, D, (size_t)512 * D, W.pair(), (const volatile LAS int*)(lds + MISC_OFF + 64), (const volatile LAS int*)(lds + MISC_OFF + 256), 2, G, (int)blockIdx.x};
            pg8::EpiMoeUp E{W.act(), W.pw(), (const volatile LAS int*)(lds + MISC_OFF + 256)}; pg8::gemm_phase(lds, S, E, D, D); }
        SEAM(p0 + 9);
        if (!NO_MOE && EN(10) && RUN(p0 + 10)) { const WS W = WL(); moe_tables(W, LL(), lds);
            pg8::MoeSched<false> S{W.act(), W.wdn(), DE, DE, (size_t)D * DE, W.pair(), (const volatile LAS int*)(lds + MISC_OFF + 64), (const volatile LAS int*)(lds + MISC_OFF + 256), 4, G, (int)blockIdx.x};
            pg8::EpiMoeDown E{W.y(), W.pair(), (const volatile LAS int*)(lds + MISC_OFF + 256)}; pg8::gemm_phase(lds, S, E, DE, DE); }
        SEAM(p0 + 10);
    }
    if (NO_MOE && RUN(NPHASE - 1)) { KArgs aa = AL(); for (int i = blockIdx.x * 512 + tid; i < ML * D; i += G * 512) { const float xi = aa->in[I_X][i]; aa->out[i] = xi + 64.f * (aa->out[i] - xi); } }
    if (!NO_MOE && EN(12) && RUN(NPHASE - 1)) { phase_norm1(AL(), WL(), 0, DEPTH - 1, true, false, ML); }
#undef RUN
#undef SEAM
}

extern "C" void kernel_launch(void* const* d_in, const int* in_sizes, int n_in, void* d_out, int out_size, void* d_ws, size_t ws_size, hipStream_t stream) {
    static int grid = 0;
    if (grid == 0) {
        if (n_in != 33 || out_size != ML * D || ws_size < WS_END) { fprintf(stderr, "kernel_launch: unexpected shapes (n_in %d out %d ws %zu need %zu)\n", n_in, out_size, ws_size, (size_t)WS_END); grid = -1; return; }
        int dev = 0, cus = 0, per_cu = 0;
        if (hipGetDevice(&dev) != hipSuccess || hipDeviceGetAttribute(&cus, hipDeviceAttributeMultiprocessorCount, dev) != hipSuccess) { grid = -1; return; }
        if (hipFuncSetAttribute((const void*)fwd_kernel, hipFuncAttributeMaxDynamicSharedMemorySize, LDS_BYTES) != hipSuccess) { fprintf(stderr, "kernel_launch: hipFuncSetAttribute failed\n"); grid = -1; return; }
        if (hipOccupancyMaxActiveBlocksPerMultiprocessor(&per_cu, (const void*)fwd_kernel, 512, LDS_BYTES) != hipSuccess || per_cu < 1) fprintf(stderr, "kernel_launch: occupancy query says %d\n", per_cu);
        (void)hipGetLastError();
        grid = cus < 256 ? cus : 256;
    }
    if (grid < 0) return;
    (void)hipMemsetAsync((char*)d_ws + WS_CTL, 0, CTL_BYTES, stream);
    Args a{};
    for (int i = 0; i < 33; ++i) a.in[i] = (const float*)d_in[i];
    a.out = (float*)d_out; a.ws = (unsigned char*)d_ws;
#if N_LAUNCH_MODE == 1
    a.ph_lo = 0; a.ph_hi = NPHASE;
    hipLaunchKernelGGL(fwd_kernel, dim3(grid), dim3(512), LDS_BYTES, stream, a);
#else
    for (int p = 0; p < NPHASE; ++p) { a.ph_lo = p; a.ph_hi = p + 1; hipLaunchKernelGGL(fwd_kernel, dim3(grid), dim3(512), LDS_BYTES, stream, a); }
#endif
}
```

```cpp
#include <hip/hip_runtime.h>
#include <cstdio>
#include <cstdint>

#ifndef N_LAUNCH_MODE
#define N_LAUNCH_MODE 1
#endif

#define LAS __attribute__((address_space(3)))
#define GAS __attribute__((address_space(1)))
typedef unsigned short bf16_t;
typedef short bf16x8 __attribute__((ext_vector_type(8)));
typedef short s16x4 __attribute__((ext_vector_type(4)));
typedef float f32x2 __attribute__((ext_vector_type(2)));
typedef float f32x4 __attribute__((ext_vector_type(4)));
typedef float f32x16 __attribute__((ext_vector_type(16)));
typedef unsigned u32x2 __attribute__((ext_vector_type(2)));
typedef unsigned u32x4 __attribute__((ext_vector_type(4)));
#define DI __device__ __forceinline__

constexpr int D = 1024, NB = 2, SEQ = 8192, DEPTH = 4, CTX = 256;
constexpr int ML = NB * SEQ, MC = NB * CTX, MA = ML + MC;
constexpr int DINP = 2048;
constexpr int C_CQ = 0, C_CKV = 256, C_KR = 384, C_MX = 416, C_MV = 672, C_MO = 928, C_MG = 1184, C_GQ = 1200, C_GK = 1328, C_GV = 1456, C_GR = 1712, C_GA = 1968;
constexpr int NH = 8, QK = 96, NKEY = SEQ + CTX, NTILE = NKEY / 64;
constexpr int NCH = 132;
constexpr int NEXP = 32, DE = 256, PAIRCAP = MA;
constexpr float EPS = 1e-6f;
constexpr float QSCALE = 0.10206207261596577f * 1.4426950408889634f;
constexpr int NPL = 11;
constexpr int NPHASE = 1 + DEPTH * NPL + 1;

constexpr size_t MiB = 1u << 20;
constexpr size_t WS_CTL = 0, CTL_BYTES = 1 * MiB;
constexpr size_t WS_MODS = 1 * MiB;
constexpr size_t WS_ROPE = WS_MODS + MiB / 2;
constexpr size_t WS_XC = WS_ROPE + 1 * MiB + MiB / 2;
constexpr size_t WS_WL = 5 * MiB;
constexpr size_t WL_STRIDE = 8 * MiB, WL_IN = 0, WL_UP = 4 * MiB, WL_MQK = 4 * MiB + 1536 * 1024, WL_OUT = 6 * MiB;
constexpr size_t WS_WGU = 37 * MiB;
constexpr size_t WS_WDN = 69 * MiB;
constexpr size_t WS_A = 85 * MiB;
constexpr size_t WS_B = 151 * MiB;
constexpr size_t WS_ACT = WS_B + 34 * MiB;
constexpr size_t WS_H = 209 * MiB;
constexpr size_t WS_CQ = 242 * MiB;
constexpr size_t WS_XCONV = 255 * MiB;
constexpr size_t WS_MQK = 264 * MiB;
constexpr size_t WS_Q = 281 * MiB;
constexpr size_t WS_K = 306 * MiB;
constexpr size_t WS_V = 331 * MiB;
constexpr size_t WS_GATES = 348 * MiB;
constexpr size_t WS_LOGA = 350 * MiB;
constexpr size_t WS_MU = 367 * MiB;
constexpr size_t WS_MN = 400 * MiB;
constexpr size_t WS_MS = 401 * MiB;
constexpr size_t WS_GU = 402 * MiB;
constexpr size_t WS_GD = 419 * MiB;
constexpr size_t WS_PAIR = 420 * MiB;
constexpr size_t WS_PW = 423 * MiB;
constexpr size_t WS_RTW = 426 * MiB;
constexpr size_t WS_END = 427 * MiB;
static_assert(WS_A + (size_t)MA * DINP * 2 <= WS_B && WS_B + (size_t)MA * 1792 * 2 <= WS_H && WS_ACT + (size_t)42240 * 256 * 2 <= WS_H && WS_B + (size_t)MA * 1024 * 2 <= WS_ACT, "ws map");
static_assert(WS_H + (size_t)MA * D * 2 <= WS_CQ && WS_CQ + (size_t)MA * 384 * 2 <= WS_XCONV && WS_XCONV + (size_t)MA * 256 * 2 <= WS_MQK && WS_MQK + (size_t)MA * 512 * 2 <= WS_Q, "ws map 2");
static_assert(WS_Q + (size_t)16 * 8448 * 96 * 2 <= WS_K && WS_K + (size_t)16 * 132 * 12288 <= WS_V && WS_V + (size_t)16 * 132 * 8192 <= WS_GATES && WS_GATES + (size_t)MA * 64 <= WS_LOGA, "ws map 3");
static_assert(WS_LOGA + (size_t)2 * MA * 512 <= WS_MU && WS_MU + (size_t)16 * 132 * 16384 <= WS_MN && WS_MN + (size_t)16 * 132 * 256 <= WS_MS && WS_GU + (size_t)16 * 132 * 8192 <= WS_GD && WS_GD + (size_t)16 * 132 * 128 <= WS_PAIR, "ws map 4");
static_assert(WS_PAIR + (size_t)32 * PAIRCAP * 4 <= WS_PW && WS_PW + (size_t)32 * PAIRCAP * 4 <= WS_END, "ws map 5");
constexpr int CW_BAR = 4096;
constexpr int CW_CNT = 16384;

constexpr int LDS_BYTES = 163840 - 1024;
constexpr int MISC_OFF = LDS_BYTES - 1024;
constexpr int WSCR = 19200;

struct Args { const float* in[33]; float* out; unsigned char* ws; int ph_lo, ph_hi; };
typedef const __attribute__((address_space(4))) Args* KArgs;

DI float bf2f(unsigned v) { return __uint_as_float(v << 16); }
DI unsigned f2bf(float f) { unsigned u = __float_as_uint(f); return (u + 0x7fffu + ((u >> 16) & 1u)) >> 16; }
DI unsigned pk2(float lo, float hi) { return f2bf(lo) | (f2bf(hi) << 16); }
typedef __bf16 bf16x2_t __attribute__((ext_vector_type(2)));
DI unsigned cvtpk(float lo, float hi) { f32x2 v = {lo, hi}; bf16x2_t b = __builtin_convertvector(v, bf16x2_t); return __builtin_bit_cast(unsigned, b); }
DI float sh_idx(float v, int src) { return __int_as_float(__builtin_amdgcn_ds_bpermute(src << 2, __float_as_int(v))); }
DI float sh_xor(float v, int m, int lane) { return sh_idx(v, lane ^ m); }
DI float wave_sum(float v, int lane) {
#pragma unroll
    for (int o = 1; o < 64; o <<= 1) v += sh_xor(v, o, lane);
    return v;
}
DI float wave_max(float v, int lane) {
#pragma unroll
    for (int o = 1; o < 64; o <<= 1) v = fmaxf(v, sh_xor(v, o, lane));
    return v;
}
DI float dpp_sum63(float v) {
#define DPP_ADD(ctrl, rmask) v += __int_as_float(__builtin_amdgcn_update_dpp(0, __float_as_int(v), ctrl, rmask, 0xF, false))
    DPP_ADD(0xB1, 0xF);
    DPP_ADD(0x4E, 0xF);
    DPP_ADD(0x141, 0xF);
    DPP_ADD(0x140, 0xF);
    DPP_ADD(0x142, 0xA);
    DPP_ADD(0x143, 0xC);
#undef DPP_ADD
    return v;
}
DI float siluf(float x) { return x / (1.f + __expf(-x)); }
DI float sigmoidf_(float x) { return 1.f / (1.f + __expf(-x)); }
DI float logsigmoidf_(float x) { return fminf(x, 0.f) - log1pf(__expf(-fabsf(x))); }
DI int crow(int r, int hi) { return (r & 3) + 8 * (r >> 2) + 4 * hi; }
#define LDS_WAIT() asm volatile("s_waitcnt lgkmcnt(0)" ::: "memory")
#define VM_WAIT() asm volatile("s_waitcnt vmcnt(0)" ::: "memory")
DI int tokrow(int b, int gc, int t) { return gc < 128 ? b * SEQ + gc * 64 + t : ML + b * CTX + (gc - 128) * 64 + t; }

#define XB_TMO      128
#define XB_XCNT(j)  (256  + 64 * (j))
#define XB_XSUB(j)  (1280 + 64 * (j))
#define XB_XGEN(j)  (2304 + 64 * (j))
#define XB_TOP      3328
#define XB_TOPGEN   3392
#define XCD_BAR_WORDS 3456
#define XB_SPIN_CAP (1u << 22)
DI unsigned xb_ld(unsigned* p)              { return __hip_atomic_load(p, __ATOMIC_RELAXED, __HIP_MEMORY_SCOPE_AGENT); }
DI unsigned xb_add(unsigned* p, unsigned v) { return __hip_atomic_fetch_add(p, v, __ATOMIC_RELAXED, __HIP_MEMORY_SCOPE_AGENT); }
DI unsigned xb_xcc_id() { return (unsigned)__builtin_amdgcn_s_getreg((3 << 11) | 20) & 0xFu; }
#define XB_SPIN(cond, bar) do { unsigned _sp = 0; while (cond) { __builtin_amdgcn_s_sleep(1); \
    if ((++_sp & 255u) == 0u) { if (xb_ld(&(bar)[XB_TMO])) break; if (_sp > XB_SPIN_CAP) { atomicAdd(&(bar)[XB_TMO], 1u); break; } } } } while (0)
struct XcdBarrier { unsigned* bar; unsigned x; volatile LAS unsigned* st; };
DI XcdBarrier xcd_barrier_post(unsigned* bar, volatile LAS unsigned* st) {
    XcdBarrier b; b.bar = bar; b.x = xb_xcc_id(); b.st = st;
    if (threadIdx.x == 0) (void)xb_add(&bar[XB_XCNT(b.x)], 1u);
    return b;
}
DI void xcd_barrier_complete(unsigned* bar, unsigned x, unsigned& nloc, unsigned& nx) {
    const unsigned G = gridDim.x * gridDim.y * gridDim.z;
    unsigned sum, cnt, mine, sp = 0u;
    for (;;) {
        sum = 0u; cnt = 0u; mine = 0u;
#pragma unroll
        for (unsigned j = 0; j < 16; ++j) { const unsigned c = xb_ld(&bar[XB_XCNT(j)]); sum += c; cnt += (c > 0u) ? 1u : 0u; mine = (j == x) ? c : mine; }
        if (sum == G) break;
        __builtin_amdgcn_s_sleep(1);
        if ((++sp & 255u) == 0u) { if (xb_ld(&bar[XB_TMO])) break; if (sp > XB_SPIN_CAP) { atomicAdd(&bar[XB_TMO], 1u); break; } }
    }
    nloc = mine > 0u ? mine : 1u; nx = cnt > 0u ? cnt : 1u;
}
DI void xcd_barrier(const XcdBarrier& b) {
    asm volatile("s_waitcnt vmcnt(0)" ::: "memory");
    __syncthreads();
    if (threadIdx.x == 0) {
        unsigned* bar = b.bar;
        __builtin_amdgcn_s_waitcnt(0);
        unsigned nloc = b.st[0], nx = b.st[1];
        if (nloc == 0u) { xcd_barrier_complete(bar, b.x, nloc, nx); b.st[0] = nloc; b.st[1] = nx; }
        const unsigned old = xb_add(&bar[XB_XSUB(b.x)], 1u);
        const unsigned gen = old / nloc;
        if (old + 1u == (gen + 1u) * nloc) {
            __builtin_amdgcn_fence(__ATOMIC_RELEASE, "agent");
            asm volatile("s_waitcnt vmcnt(0)" ::: "memory");
            const unsigned og = xb_add(&bar[XB_TOP], 1u);
            const unsigned tg = og / nx;
            if (og + 1u == (tg + 1u) * nx) xb_add(&bar[XB_TOPGEN], 1u);
            else XB_SPIN(xb_ld(&bar[XB_TOPGEN]) == tg, bar);
            __builtin_amdgcn_fence(__ATOMIC_ACQUIRE, "agent");
            xb_add(&bar[XB_XGEN(b.x)], 1u);
            asm volatile("s_waitcnt vmcnt(0)" ::: "memory");
        } else {
            XB_SPIN(xb_ld(&bar[XB_XGEN(b.x)]) == gen, bar);
            __builtin_amdgcn_fence(__ATOMIC_ACQUIRE, "agent");
            asm volatile("s_waitcnt vmcnt(0)" ::: "memory");
        }
    }
    __syncthreads();
}

namespace pg8 {
constexpr int BM = 256, BK = 64, HALF = 128, HTB = HALF * BK * 2, NXCD = 8, WGM = 8;
DI int lds_byte(int r, int c) { const int st = (r >> 4) * 2 + (c >> 5), rr = r & 15, cc = c & 31, ob = rr * 64 + cc * 2; return st * 1024 + (ob ^ (((ob >> 9) & 1) << 5)); }
DI void stage_rc(int b, int& R, int& C) { const int st = b / 1024, sb = b % 1024, swz = sb ^ (((sb >> 9) & 1) << 5); R = (st >> 1) * 16 + swz / 64; C = (st & 1) * 32 + (swz % 64) / 2; }
DI int perm32(int rho) { const int n = rho >> 4, i = rho & 15; return 8 * (i >> 2) + 4 * n + (i & 3); }
struct Unit { int pm, pn, e, t; };
DI unsigned cvt_pk_bf16(float lo, float hi) { unsigned r; asm volatile("v_cvt_pk_bf16_f32 %0, %1, %2" : "=v"(r) : "v"(lo), "v"(hi)); return r; }

struct DenseSched {
    static constexpr bool PER_UNIT_A = false;
    const bf16_t* A; const bf16_t* Bt; int lda, ldb; int nM, nN, nwg, G, c;
    DI void init(const bf16_t* A_, const bf16_t* Bt_, int lda_, int ldb_, int M, int N, int G_, int c_) { A = A_; Bt = Bt_; lda = lda_; ldb = ldb_; nM = M / BM; nN = N / BM; nwg = nM * nN; G = G_; c = c_; }
    DI bool next(int i, Unit& u) const {
        const long L = (long)i * G + c; if (L >= nwg) return false;
        int wgid = (int)L; { const int q = nwg / NXCD, r = nwg % NXCD, xcd = wgid % NXCD, off = wgid / NXCD; wgid = (xcd < r ? xcd * (q + 1) : r * (q + 1) + (xcd - r) * q) + off; }
        const int nig = WGM * nN, gid = wgid / nig, fm = gid * WGM, gsz = (nM - fm) < WGM ? (nM - fm) : WGM;
        u.pm = fm + ((wgid % nig) % gsz); u.pn = (wgid % nig) / gsz; u.e = 0; u.t = 0; return true;
    }
    DI const char* abase(const Unit& u) const { return (const char*)A + (size_t)u.pm * BM * lda * 2; }
    DI const char* bbase(const Unit& u) const { return (const char*)Bt + (size_t)u.pn * BM * ldb * 2; }
    DI void avoff(const Unit&, const int (&R)[2], const int (&C)[2], unsigned (&va)[2][2]) const {
#pragma unroll
        for (int h = 0; h < 2; ++h)
#pragma unroll
            for (int i = 0; i < 2; ++i) va[h][i] = (unsigned)((h * HALF + R[i]) * lda + C[i]) * 2u;
    }
};
template <bool GATHER> struct MoeSched {
    static constexpr bool PER_UNIT_A = GATHER;
    const bf16_t* A; const bf16_t* Bt; int lda, ldb; size_t bexp;
    const int* pair; const volatile LAS int* toff; const volatile LAS int* cnt; int NPN, G, c;
    DI bool next(int i, Unit& u) const {
        const int T = __builtin_amdgcn_readfirstlane(toff[NEXP]); const int L = i * G + c; if (L >= T * NPN) return false;
        const int ti = L / NPN; u.pn = L % NPN; int e = 0;
#pragma unroll 1
        for (int j = 1; j < NEXP; ++j) e = (__builtin_amdgcn_readfirstlane(toff[j]) <= ti) ? j : e;
        u.pm = ti; u.e = e; u.t = ti - __builtin_amdgcn_readfirstlane(toff[e]); return true;
    }
    DI const char* abase(const Unit& u) const { return GATHER ? (const char*)A : (const char*)A + (size_t)u.pm * BM * lda * 2; }
    DI const char* bbase(const Unit& u) const { return (const char*)Bt + ((size_t)u.e * bexp + (size_t)u.pn * BM * ldb) * 2; }
    DI void avoff(const Unit& u, const int (&R)[2], const int (&C)[2], unsigned (&va)[2][2]) const {
        const int n = __builtin_amdgcn_readfirstlane(cnt[u.e]);
#pragma unroll
        for (int h = 0; h < 2; ++h)
#pragma unroll
            for (int i = 0; i < 2; ++i) {
                if (GATHER) { const int slot = u.t * BM + h * HALF + R[i]; const int tok = (slot < n) ? (pair[(size_t)u.e * PAIRCAP + slot] >> 1) : 0; va[h][i] = (unsigned)(tok * lda + C[i]) * 2u; }
                else va[h][i] = (unsigned)((h * HALF + R[i]) * lda + C[i]) * 2u;
            }
    }
};

template <class Epi, class Sched>
DI void gemm_phase(LAS unsigned char* lds, const Sched& S, const Epi& E, const int K, const int ldb) {
    int tid_ = threadIdx.x; asm volatile("" : "+v"(tid_));
    const int tid = tid_, wid = __builtin_amdgcn_readfirstlane(tid >> 6), lane = tid & 63, wr = wid >> 2, wc = wid & 3, fr = lane & 15, fq = lane >> 4;
    int nt = K / BK; asm volatile("" : "+s"(nt));
    int Rr[2], Cc[2]; unsigned vb[2];
#pragma unroll
    for (int i = 0; i < 2; ++i) { stage_rc(tid * 16 + i * 8192, Rr[i], Cc[i]); const int Rb = (Rr[i] & ~31) + perm32(Rr[i] & 31); vb[i] = (unsigned)(Rb * ldb + Cc[i]) * 2u; }
    const size_t kstep = (size_t)(BK * 2);
    const size_t hstepB = (size_t)HALF * ldb * 2;
    const unsigned ldsw = (unsigned)wid * 1024u;
    const int aoff = lds_byte(wr * 64 + fr, fq * 8), boff = lds_byte(wc * 32 + fr, fq * 8);
#define PG8_SA(b, h) (((b) * 2 + (h)) * HTB)
#define PG8_SB(b, h) ((4 + (b) * 2 + (h)) * HTB)
#define PG8_STAGE_A(b, h, gbase, VA) do { _Pragma("unroll") for (int _i = 0; _i < 2; ++_i) \
        __builtin_amdgcn_global_load_lds((const unsigned*)((const char*)(gbase) + (VA)[h][_i]), (LAS unsigned*)(lds + PG8_SA(b, h) + ldsw + _i * 8192), 16, 0, 0); } while (0)
#define PG8_STAGE_B(b, h, gbase) do { _Pragma("unroll") for (int _i = 0; _i < 2; ++_i) \
        __builtin_amdgcn_global_load_lds((const unsigned*)((const char*)(gbase) + (h) * hstepB + vb[_i]), (LAS unsigned*)(lds + PG8_SB(b, h) + ldsw + _i * 8192), 16, 0, 0); } while (0)
#define PG8_LDA(dst, b, h) do { _Pragma("unroll") for (int m = 0; m < 4; ++m) _Pragma("unroll") for (int k = 0; k < 2; ++k) dst[m][k] = *(const LAS bf16x8*)(lds + PG8_SA(b, h) + aoff + m * 2048 + k * 1024); } while (0)
#define PG8_LDB(dst, b, h) do { _Pragma("unroll") for (int n = 0; n < 2; ++n) _Pragma("unroll") for (int k = 0; k < 2; ++k) dst[n][k] = *(const LAS bf16x8*)(lds + PG8_SB(b, h) + boff + n * 2048 + k * 1024); } while (0)
#define PG8_MMA(ai, bj, At, Bt) do { __builtin_amdgcn_s_setprio(1); _Pragma("unroll") for (int m = 0; m < 4; ++m) _Pragma("unroll") for (int n = 0; n < 2; ++n) _Pragma("unroll") for (int k = 0; k < 2; ++k) \
        acc[ai][bj][m][n] = __builtin_amdgcn_mfma_f32_16x16x32_bf16(Bt[n][k], At[m][k], acc[ai][bj][m][n], 0, 0, 0); __builtin_amdgcn_s_setprio(0); } while (0)
#define PG8_WAIT_V(n) asm volatile("s_waitcnt vmcnt(" #n ")" ::: "memory")
#define PG8_WAIT_L(n) asm volatile("s_waitcnt lgkmcnt(" #n ")" ::: "memory")
#define PG8_BAR __builtin_amdgcn_s_barrier()
#define PG8_SCHED __builtin_amdgcn_sched_barrier(0)
    Unit cur, nxt; int ui = 0;
    if (!S.next(0, cur)) return;
    f32x4 acc[2][2][4][2];
#pragma unroll
    for (int a = 0; a < 2; ++a)
#pragma unroll
        for (int b = 0; b < 2; ++b)
#pragma unroll
            for (int m = 0; m < 4; ++m)
#pragma unroll
                for (int n = 0; n < 2; ++n) acc[a][b][m][n] = (f32x4){0.f, 0.f, 0.f, 0.f};
    bf16x8 At[4][2], B0[2][2], B1[2][2];
    unsigned va[2][2];
    const char* cA = S.abase(cur); const char* cB = S.bbase(cur);
    S.avoff(cur, Rr, Cc, va);
    PG8_STAGE_B(0, 0, cB); PG8_STAGE_B(0, 1, cB); PG8_STAGE_A(0, 0, cA, va); PG8_STAGE_A(0, 1, cA, va);
    if (wr == 1) PG8_BAR;
    PG8_WAIT_V(2); PG8_BAR;
    PG8_STAGE_B(1, 0, cB + kstep); PG8_STAGE_A(1, 0, cA + kstep, va); PG8_STAGE_B(1, 1, cB + kstep);
    PG8_WAIT_V(6); PG8_BAR;
    for (;;) {
        const bool has_next = S.next(ui + 1, nxt);
        const char* nA = cA; const char* nB = cB;
        if (has_next) { nA = S.abase(nxt); nB = S.bbase(nxt); }
        for (int t = 0; t < nt; t += 2) {
            const bool last = (t == nt - 2);
            const char* a1 = cA + (size_t)(t + 1) * kstep;
            const char* a2 = last ? nA : cA + (size_t)(t + 2) * kstep; const char* b2 = last ? nB : cB + (size_t)(t + 2) * kstep;
            const char* a3 = a2 + kstep; const char* b3 = b2 + kstep;
            PG8_LDB(B0, 0, 0); PG8_LDB(B1, 0, 1); PG8_SCHED; PG8_LDA(At, 0, 0); PG8_STAGE_A(1, 1, a1, va);
            if (Sched::PER_UNIT_A && last && has_next) S.avoff(nxt, Rr, Cc, va);
            PG8_WAIT_V(8); PG8_WAIT_L(0); PG8_BAR; PG8_MMA(0, 0, At, B0); PG8_MMA(0, 1, At, B1); PG8_BAR; PG8_SCHED;
            PG8_LDA(At, 0, 1); PG8_STAGE_B(0, 0, b2); PG8_STAGE_B(0, 1, b2); PG8_STAGE_A(0, 0, a2, va);
            PG8_WAIT_V(8); PG8_WAIT_L(0); PG8_BAR; PG8_MMA(1, 0, At, B0); PG8_MMA(1, 1, At, B1); PG8_BAR; PG8_SCHED;
            PG8_LDB(B0, 1, 0); PG8_LDB(B1, 1, 1); PG8_SCHED; PG8_LDA(At, 1, 0); PG8_STAGE_A(0, 1, a2, va);
            PG8_WAIT_V(8); PG8_WAIT_L(0); PG8_BAR; PG8_MMA(0, 0, At, B0); PG8_MMA(0, 1, At, B1); PG8_BAR; PG8_SCHED;
            PG8_LDA(At, 1, 1); PG8_STAGE_B(1, 0, b3); PG8_STAGE_B(1, 1, b3); PG8_STAGE_A(1, 0, a3, va);
            PG8_WAIT_V(8); PG8_WAIT_L(0); PG8_BAR; PG8_MMA(1, 0, At, B0); PG8_MMA(1, 1, At, B1); PG8_BAR; PG8_SCHED;
        }
        E(acc, cur, wr, wc, fr, fq);
        if (!has_next) break;
#pragma unroll
        for (int a = 0; a < 2; ++a)
#pragma unroll
            for (int b = 0; b < 2; ++b)
#pragma unroll
                for (int m = 0; m < 4; ++m)
#pragma unroll
                    for (int n = 0; n < 2; ++n) acc[a][b][m][n] = (f32x4){0.f, 0.f, 0.f, 0.f};
        cur = nxt; cA = nA; cB = nB; ++ui;
    }
    PG8_WAIT_V(0);
    if (wr == 0) PG8_BAR;
    PG8_BAR;
#undef PG8_SA
#undef PG8_SB
#undef PG8_STAGE_A
#undef PG8_STAGE_B
#undef PG8_LDA
#undef PG8_LDB
#undef PG8_MMA
#undef PG8_WAIT_V
#undef PG8_WAIT_L
#undef PG8_BAR
#undef PG8_SCHED
}

struct EpiBf16 {
    bf16_t* O; int ldc;
    DI void operator()(const f32x4 (&acc)[2][2][4][2], const Unit& u, int wr, int wc, int fr, int fq) const {
        asm volatile("" : "+v"(fr), "+v"(fq));
        const int row0 = u.pm * BM + wr * 64 + fr, col0 = u.pn * BM + wc * 32 + 8 * fq;
#pragma unroll
        for (int ai = 0; ai < 2; ++ai)
#pragma unroll
            for (int m = 0; m < 4; ++m) { bf16_t* rowp = O + (size_t)(row0 + ai * HALF + m * 16) * ldc + col0;
#pragma unroll
                for (int bj = 0; bj < 2; ++bj) { const f32x4 v0 = acc[ai][bj][m][0], v1 = acc[ai][bj][m][1];
                    u32x4 w; w.x = cvt_pk_bf16(v0[0], v0[1]); w.y = cvt_pk_bf16(v0[2], v0[3]); w.z = cvt_pk_bf16(v1[0], v1[1]); w.w = cvt_pk_bf16(v1[2], v1[3]);
                    *(u32x4*)(rowp + bj * HALF) = w; } }
    }
};
struct EpiResid {
    float* xl; float* xc; const float* gate; float gs = 1.f;
    DI void operator()(const f32x4 (&acc)[2][2][4][2], const Unit& u, int wr, int wc, int fr, int fq) const {
        asm volatile("" : "+v"(fr), "+v"(fq));
        const int rt = u.pm * BM; const int vec = rt < SEQ ? 0 : (rt < ML ? 1 : 2);
        float* xb = rt < ML ? xl + (size_t)rt * D : xc + (size_t)(rt - ML) * D;
        const int row0 = wr * 64 + fr, col0 = u.pn * BM + wc * 32 + 8 * fq;
        const float* g = gate + vec * 6144 + col0;
        f32x4 gv[2][2];
#pragma unroll
        for (int bj = 0; bj < 2; ++bj)
#pragma unroll
            for (int n = 0; n < 2; ++n) gv[bj][n] = *(const f32x4*)(g + bj * HALF + 4 * n);
#pragma unroll
        for (int ai = 0; ai < 2; ++ai)
#pragma unroll
            for (int m = 0; m < 4; ++m) { float* rowp = xb + (size_t)(row0 + ai * HALF + m * 16) * D + col0;
#pragma unroll
                for (int bj = 0; bj < 2; ++bj)
#pragma unroll
                    for (int n = 0; n < 2; ++n) { f32x4* p = (f32x4*)(rowp + bj * HALF + 4 * n); f32x4 xv = *p; xv = xv + gv[bj][n] * acc[ai][bj][m][n] * gs; *p = xv; } }
    }
};
struct EpiMoeUp {
    bf16_t* ACT; const float* pw; const volatile LAS int* cnt;
    DI void operator()(const f32x4 (&acc)[2][2][4][2], const Unit& u, int wr, int wc, int fr, int fq) const {
        asm volatile("" : "+v"(fr), "+v"(fq));
        const int n_e = __builtin_amdgcn_readfirstlane(cnt[u.e]); const int col0 = u.pn * 128 + wc * 32 + 8 * fq;
#pragma unroll
        for (int ai = 0; ai < 2; ++ai)
#pragma unroll
            for (int m = 0; m < 4; ++m) { const int rt = wr * 64 + fr + ai * HALF + m * 16; const int slot = u.t * BM + rt;
                const float w = slot < n_e ? pw[(size_t)u.e * PAIRCAP + slot] : 0.f;
                float a[8];
#pragma unroll
                for (int n = 0; n < 2; ++n)
#pragma unroll
                    for (int j = 0; j < 4; ++j) { const float g = acc[ai][0][m][n][j], up = acc[ai][1][m][n][j]; a[n * 4 + j] = siluf(g) * up * w; }
                u32x4 o; o.x = cvt_pk_bf16(a[0], a[1]); o.y = cvt_pk_bf16(a[2], a[3]); o.z = cvt_pk_bf16(a[4], a[5]); o.w = cvt_pk_bf16(a[6], a[7]);
                *(u32x4*)(ACT + ((size_t)u.pm * BM + rt) * DE + col0) = o; }
    }
};
struct EpiMoeDown {
    bf16_t* Y; const int* pair; const volatile LAS int* cnt;
    DI void operator()(const f32x4 (&acc)[2][2][4][2], const Unit& u, int wr, int wc, int fr, int fq) const {
        asm volatile("" : "+v"(fr), "+v"(fq));
        const int n_e = __builtin_amdgcn_readfirstlane(cnt[u.e]); const int col0 = u.pn * BM + wc * 32 + 8 * fq;
#pragma unroll
        for (int ai = 0; ai < 2; ++ai)
#pragma unroll
            for (int m = 0; m < 4; ++m) { const int rt = wr * 64 + fr + ai * HALF + m * 16; const int slot = u.t * BM + rt;
                if (slot < n_e) { const int pr = pair[(size_t)u.e * PAIRCAP + slot]; bf16_t* rowp = Y + (size_t)pr * D + col0;
#pragma unroll
                    for (int bj = 0; bj < 2; ++bj) { const f32x4 v0 = acc[ai][bj][m][0], v1 = acc[ai][bj][m][1];
                        u32x4 w; w.x = cvt_pk_bf16(v0[0], v0[1]); w.y = cvt_pk_bf16(v0[2], v0[3]); w.z = cvt_pk_bf16(v1[0], v1[1]); w.w = cvt_pk_bf16(v1[2], v1[3]);
                        *(u32x4*)(rowp + bj * HALF) = w; } } }
    }
};
}

template <int KS> DI void wmma32(f32x16& acc, const LAS bf16_t* As, int lda, const LAS bf16_t* Bs, int ldb, int r32, int hi) {
#pragma unroll
    for (int ks = 0; ks < KS; ++ks) {
        const bf16x8 a = *(const LAS bf16x8*)(As + r32 * lda + ks * 16 + hi * 8);
        const bf16x8 b = *(const LAS bf16x8*)(Bs + r32 * ldb + ks * 16 + hi * 8);
        acc = __builtin_amdgcn_mfma_f32_32x32x16_bf16(a, b, acc, 0, 0, 0);
    }
}
DI float scan_incl(float x, int lane, bool suffix) {
#pragma unroll
    for (int off = 1; off < 64; off <<= 1) { const float v = sh_idx(x, suffix ? ((lane + off) & 63) : ((lane - off) & 63)); const bool ok = suffix ? (lane + off < 64) : (lane >= off); x += ok ? v : 0.f; }
    return x;
}
DI float scan_max(float x, int lane, bool suffix) {
#pragma unroll
    for (int off = 1; off < 64; off <<= 1) { const float v = sh_idx(x, suffix ? ((lane + off) & 63) : ((lane - off) & 63)); const bool ok = suffix ? (lane + off < 64) : (lane >= off); x = ok ? fmaxf(x, v) : x; }
    return x;
}
DI void unpack8(const u32x4 v, float (&f)[8]) {
    f[0] = bf2f(v.x & 0xffffu); f[1] = bf2f(v.x >> 16); f[2] = bf2f(v.y & 0xffffu); f[3] = bf2f(v.y >> 16);
    f[4] = bf2f(v.z & 0xffffu); f[5] = bf2f(v.z >> 16); f[6] = bf2f(v.w & 0xffffu); f[7] = bf2f(v.w >> 16);
}
DI u32x4 pack8(const float (&f)[8]) { u32x4 o; o.x = pk2(f[0], f[1]); o.y = pk2(f[2], f[3]); o.z = pk2(f[4], f[5]); o.w = pk2(f[6], f[7]); return o; }

struct WS {
    unsigned char* ws;
    DI unsigned* ctl() const { return (unsigned*)(ws + WS_CTL); }
    DI float* mods() const { return (float*)(ws + WS_MODS); }
    DI float* rope() const { return (float*)(ws + WS_ROPE); }
    DI float* xc() const { return (float*)(ws + WS_XC); }
    DI bf16_t* wl(int l, size_t off) const { return (bf16_t*)(ws + WS_WL + (size_t)l * WL_STRIDE + off); }
    DI bf16_t* wgu() const { return (bf16_t*)(ws + WS_WGU); }
    DI bf16_t* wdn() const { return (bf16_t*)(ws + WS_WDN); }
    DI bf16_t* proj() const { return (bf16_t*)(ws + WS_A); }
    DI bf16_t* y() const { return (bf16_t*)(ws + WS_A); }
    DI bf16_t* qkvraw() const { return (bf16_t*)(ws + WS_B); }
    DI bf16_t* mix() const { return (bf16_t*)(ws + WS_B); }
    DI bf16_t* act() const { return (bf16_t*)(ws + WS_ACT); }
    DI bf16_t* h() const { return (bf16_t*)(ws + WS_H); }
    DI bf16_t* cqn() const { return (bf16_t*)(ws + WS_CQ); }
    DI bf16_t* xconv() const { return (bf16_t*)(ws + WS_XCONV); }
    DI bf16_t* mqk() const { return (bf16_t*)(ws + WS_MQK); }
    DI bf16_t* q() const { return (bf16_t*)(ws + WS_Q); }
    DI bf16_t* k() const { return (bf16_t*)(ws + WS_K); }
    DI bf16_t* v() const { return (bf16_t*)(ws + WS_V); }
    DI float* gates() const { return (float*)(ws + WS_GATES); }
    DI float* loga() const { return (float*)(ws + WS_LOGA); }
    DI float* mu() const { return (float*)(ws + WS_MU); }
    DI float* mn() const { return (float*)(ws + WS_MN); }
    DI float* ms() const { return (float*)(ws + WS_MS); }
    DI float* gu() const { return (float*)(ws + WS_GU); }
    DI float* gd() const { return (float*)(ws + WS_GD); }
    DI int* pair() const { return (int*)(ws + WS_PAIR); }
    DI float* pw() const { return (float*)(ws + WS_PW); }
    DI float* rtw() const { return (float*)(ws + WS_RTW); }
};
enum { I_X = 0, I_C, I_CTX, I_CCTX, I_WMOD, I_BMOD, I_N1W, I_WIN, I_QAN, I_WUQ, I_KVAN, I_WUKV, I_QNW, I_KNW, I_MCW, I_MCB, I_MWQ, I_MWK, I_MGB, I_MNW, I_MSK,
       I_GWA, I_GBA, I_GNW, I_WOUT, I_N2W, I_WGRP, I_BGRP, I_WER, I_BER, I_WG, I_WU, I_WD };

DI void tr_item(const float* W, int N, int nvalid, bf16_t* WT, int ldd, int k0, int n0, int drow0, int dcol0, LAS float* scr, int lane) {
#pragma unroll 8
    for (int i = 0; i < 32; ++i) { const int kk = 2 * i + (lane >> 5); const int n = n0 + (lane & 31); scr[kk * 33 + (lane & 31)] = (n < nvalid) ? W[(size_t)(k0 + kk) * N + n] : 0.f; }
    LDS_WAIT(); asm volatile("" ::: "memory");
    const int c = lane & 7;
#pragma unroll
    for (int j = 0; j < 4; ++j) { const int n = (lane >> 3) + 8 * j; const LAS float* s = scr + (8 * c) * 33 + n;
        u32x4 o; o.x = pk2(s[0 * 33], s[1 * 33]); o.y = pk2(s[2 * 33], s[3 * 33]); o.z = pk2(s[4 * 33], s[5 * 33]); o.w = pk2(s[6 * 33], s[7 * 33]);
        *(u32x4*)(WT + (size_t)(drow0 + n) * ldd + dcol0 + k0 + 8 * c) = o; }
    LDS_WAIT(); asm volatile("" ::: "memory");
}

DI void phase_prologue(KArgs a, const WS& W, LAS unsigned char* lds) {
    int tid_ = threadIdx.x; asm volatile("" : "+v"(tid_)); const int tid = tid_, lane = tid & 63, wid = __builtin_amdgcn_readfirstlane(tid >> 6);
    const int G = gridDim.x, gw = blockIdx.x * 8 + wid, NGW = G * 8, gt = blockIdx.x * 512 + tid, NGT = G * 512;
    LAS float* scr = (LAS float*)(lds + wid * WSCR);
    constexpr int IT_IN = 16 * 64, IT_UQ = 4 * 24, IT_UKV = 2 * 32, IT_OUT = 16 * 32, IT_L = IT_IN + IT_UQ + IT_UKV + IT_OUT;
    for (int it = gw; it < DEPTH * IT_L; it += NGW) {
        const int l = it / IT_L; int r = it % IT_L;
        if (r < IT_IN) { const int kb = r / 64, nb = r % 64; tr_item(a->in[I_WIN] + (size_t)l * D * 2000, 2000, 2000, W.wl(l, WL_IN), 1024, 64 * kb, 32 * nb, 32 * nb, 0, scr, lane); continue; } r -= IT_IN;
        if (r < IT_UQ) { const int kb = r / 24, nb = r % 24; tr_item(a->in[I_WUQ] + (size_t)l * 256 * 768, 768, 768, W.wl(l, WL_UP), 384, 64 * kb, 32 * nb, 32 * nb, 0, scr, lane); continue; } r -= IT_UQ;
        if (r < IT_UKV) { const int kb = r / 32, nb = r % 32; tr_item(a->in[I_WUKV] + (size_t)l * 128 * 1024, 1024, 1024, W.wl(l, WL_UP), 384, 64 * kb, 32 * nb, 768 + 32 * nb, 256, scr, lane); continue; } r -= IT_UKV;
        { const int kb = r / 32, nb = r % 32; tr_item(a->in[I_WOUT] + (size_t)l * D * D, 1024, 1024, W.wl(l, WL_OUT), 1024, 64 * kb, 32 * nb, 32 * nb, 0, scr, lane); }
    }
    for (int i = gt; i < DEPTH * (768 * 16 + 1024 * 32); i += NGT) {
        const int l = i / (768 * 16 + 1024 * 32); int r = i % (768 * 16 + 1024 * 32); bf16_t* wu = W.wl(l, WL_UP);
        if (r < 768 * 16) { const int row = r / 16, c = r % 16; *(u32x4*)(wu + (size_t)row * 384 + 256 + c * 8) = (u32x4){0u, 0u, 0u, 0u}; }
        else { r -= 768 * 16; const int row = 768 + r / 32, c = r % 32; *(u32x4*)(wu + (size_t)row * 384 + c * 8) = (u32x4){0u, 0u, 0u, 0u}; }
    }
    for (int i = gt; i < DEPTH * 512 * 256; i += NGT) {
        const int l = i / (512 * 256), r = i % (512 * 256), n = r / 256, kc = r % 256, hs = (n & 255) >> 6, e = n & 63;
        float v = 0.f;
        if ((kc >> 6) == hs) { const float* src = (n < 256 ? a->in[I_MWQ] : a->in[I_MWK]) + (size_t)l * 4 * 64 * 64; v = src[(hs * 64 + (kc & 63)) * 64 + e]; if (n < 256) v *= 0.125f; }
        W.wl(l, WL_MQK)[r] = (bf16_t)f2bf(v);
    }
    for (int i = gt; i < DEPTH * 36 * 1024; i += NGT) { const int l = i / (36 * 1024), r = i % (36 * 1024), e = r >> 10, k = r & 1023;
        W.rtw()[i] = e < 4 ? a->in[I_WGRP][(size_t)l * D * 4 + k * 4 + e] : a->in[I_WER][(size_t)l * D * 32 + k * 32 + (e - 4)]; }
    for (int i = gt; i < SEQ * 16; i += NGT) {
        const int t = i >> 4, p = i & 15; const float inv = powf(10000.f, -(float)(p & 7) / 8.f);
        const float ang = (float)(p < 8 ? (t >> 6) : (t & 63)) * inv;
        W.rope()[i] = cosf(ang); W.rope()[SEQ * 16 + i] = sinf(ang);
    }
    for (int i = gt; i < ML * D / 4; i += NGT) ((f32x4*)a->out)[i] = ((const f32x4*)a->in[I_X])[i];
    for (int i = gt; i < MC * D / 4; i += NGT) ((f32x4*)W.xc())[i] = ((const f32x4*)a->in[I_CTX])[i];
    {
        LAS float* sv = (LAS float*)lds;
        LAS float* red = (LAS float*)(lds + 12288);
        __syncthreads();
        for (int i = tid; i < 3 * 1024; i += 512) { const int vsel = i >> 10, k = i & 1023; const float c = vsel < 2 ? a->in[I_C][vsel * 1024 + k] : a->in[I_CCTX][k]; sv[i] = siluf(c); }
        __syncthreads();
        for (int it = blockIdx.x; it < DEPTH * 48; it += G) {
            const int l = it / 48, n0 = (it % 48) * 128, col = tid & 127, kg = tid >> 7;
            const float* wm = a->in[I_WMOD] + (size_t)l * D * 6144 + n0 + col;
            float s0 = 0.f, s1 = 0.f, s2 = 0.f;
#pragma unroll 8
            for (int k = kg * 256; k < kg * 256 + 256; ++k) { const float w = wm[(size_t)k * 6144]; s0 += sv[k] * w; s1 += sv[1024 + k] * w; s2 += sv[2048 + k] * w; }
            red[(kg * 3 + 0) * 128 + col] = s0; red[(kg * 3 + 1) * 128 + col] = s1; red[(kg * 3 + 2) * 128 + col] = s2;
            __syncthreads();
            if (tid < 384) { const int vsel = tid >> 7, c = tid & 127; const float s = red[(0 * 3 + vsel) * 128 + c] + red[(1 * 3 + vsel) * 128 + c] + red[(2 * 3 + vsel) * 128 + c] + red[(3 * 3 + vsel) * 128 + c];
                W.mods()[(size_t)(l * 3 + vsel) * 6144 + n0 + c] = s + a->in[I_BMOD][l * 6144 + n0 + c]; }
            __syncthreads();
        }
    }
}

DI void moe_weights(KArgs a, const WS& W, int l, LAS unsigned char* lds) {
    int tid_ = threadIdx.x; asm volatile("" : "+v"(tid_)); const int tid = tid_, lane = tid & 63, wid = __builtin_amdgcn_readfirstlane(tid >> 6);
    const int gw = blockIdx.x * 8 + wid, NGW = gridDim.x * 8;
    LAS float* scr = (LAS float*)(lds + wid * WSCR);
    constexpr int IT_G = 16 * 8, IT_D = 4 * 32;
    for (int it = gw; it < NEXP * (2 * IT_G + IT_D); it += NGW) {
        const int e = it / (2 * IT_G + IT_D); int r = it % (2 * IT_G + IT_D);
        if (r < 2 * IT_G) { const int up = r / IT_G; r %= IT_G; const int kb = r / 8, nb = r % 8, n0 = 32 * nb;
            const float* src = (up ? a->in[I_WU] : a->in[I_WG]) + (size_t)(l * NEXP + e) * D * DE;
            tr_item(src, DE, DE, W.wgu() + (size_t)e * 512 * D, D, 64 * kb, n0, 256 * (n0 >> 7) + (n0 & 127) + (up ? 128 : 0), 0, scr, lane); }
        else { r -= 2 * IT_G; const int kb = r / 32, nb = r % 32;
            tr_item(a->in[I_WD] + (size_t)(l * NEXP + e) * DE * D, D, D, W.wdn() + (size_t)e * D * DE, DE, 64 * kb, 32 * nb, 32 * nb, 0, scr, lane); }
    }
}

DI void phase_norm1(KArgs a, const WS& W, int l, int lc, bool combine, bool donorm, int nrows) {
    int tid_ = threadIdx.x; asm volatile("" : "+v"(tid_)); const int tid = tid_, lane = tid & 63, wid = __builtin_amdgcn_readfirstlane(tid >> 6);
    const int gw = blockIdx.x * 8 + wid, NGW = gridDim.x * 8;
    for (int row = gw; row < nrows; row += NGW) {
        float* xr = row < ML ? a->out + (size_t)row * D : W.xc() + (size_t)(row - ML) * D;
        const int vec = row < SEQ ? 0 : (row < ML ? 1 : 2);
        f32x4 v[4];
#pragma unroll
        for (int j = 0; j < 4; ++j) v[j] = *(const f32x4*)(xr + 4 * lane + 256 * j);
        if (combine) {
            const float* g2 = W.mods() + (size_t)(lc * 3 + vec) * 6144 + 5 * 1024;
            const bf16_t* y0 = W.y() + (size_t)(2 * row) * D; const bf16_t* y1 = y0 + D;
#pragma unroll
            for (int j = 0; j < 4; ++j) { const int c = 4 * lane + 256 * j; const f32x4 g = *(const f32x4*)(g2 + c); const u32x2 a0 = *(const u32x2*)(y0 + c), a1 = *(const u32x2*)(y1 + c);
                v[j][0] += g[0] * (bf2f(a0.x & 0xffffu) + bf2f(a1.x & 0xffffu)); v[j][1] += g[1] * (bf2f(a0.x >> 16) + bf2f(a1.x >> 16));
                v[j][2] += g[2] * (bf2f(a0.y & 0xffffu) + bf2f(a1.y & 0xffffu)); v[j][3] += g[3] * (bf2f(a0.y >> 16) + bf2f(a1.y >> 16));
                *(f32x4*)(xr + c) = v[j]; }
        }
        if (donorm) {
            float ss = 0.f;
#pragma unroll
            for (int j = 0; j < 4; ++j) ss += (v[j][0] * v[j][0] + v[j][1] * v[j][1]) + (v[j][2] * v[j][2] + v[j][3] * v[j][3]);
            const float r = rsqrtf(wave_sum(ss, lane) * (1.f / D) + EPS);
            const float* md = W.mods() + (size_t)(l * 3 + vec) * 6144; const float* nw = a->in[I_N1W] + l * D;
            bf16_t* hr = W.h() + (size_t)row * D;
#pragma unroll
            for (int j = 0; j < 4; ++j) { const int c = 4 * lane + 256 * j; const f32x4 w = *(const f32x4*)(nw + c), sh = *(const f32x4*)(md + c), sc = *(const f32x4*)(md + 1024 + c);
                float o[4];
#pragma unroll
                for (int i = 0; i < 4; ++i) o[i] = v[j][i] * r * w[i] * (1.f + sc[i]) + sh[i];
                u32x2 p; p.x = pk2(o[0], o[1]); p.y = pk2(o[2], o[3]); *(u32x2*)(hr + c) = p; }
        }
    }
}

DI void phase_prep(KArgs a, const WS& W, int l, LAS unsigned char* lds) {
    int tid_ = threadIdx.x; asm volatile("" : "+v"(tid_)); const int tid = tid_, lane = tid & 63, wid = __builtin_amdgcn_readfirstlane(tid >> 6);
    const int gw = blockIdx.x * 8 + wid, NGW = gridDim.x * 8;
    LAS float* wa = (LAS float*)lds;
    LAS float* cw = (LAS float*)(lds + 16384);
    __syncthreads();
    for (int i = tid; i < 4096; i += 512) wa[i] = a->in[I_GWA][l * 4096 + i];
    for (int i = tid; i < 1280; i += 512) cw[i] = a->in[I_MCW][l * 1280 + i];
    for (int i = tid; i < 256; i += 512) cw[1280 + i] = a->in[I_MCB][l * 256 + i];
    __syncthreads();
    const bf16_t* proj = W.proj();
    for (int row = gw; row < MA; row += NGW) {
        const bf16_t* pr = proj + (size_t)row * DINP;
        { const u32x2 c = *(const u32x2*)(pr + C_CQ + 4 * lane); float f[4] = {bf2f(c.x & 0xffffu), bf2f(c.x >> 16), bf2f(c.y & 0xffffu), bf2f(c.y >> 16)};
          const float r = rsqrtf(wave_sum((f[0] * f[0] + f[1] * f[1]) + (f[2] * f[2] + f[3] * f[3]), lane) * (1.f / 256.f) + EPS);
          const f32x4 g = *(const f32x4*)(a->in[I_QAN] + l * 256 + 4 * lane);
          u32x2 o; o.x = pk2(f[0] * r * g[0], f[1] * r * g[1]); o.y = pk2(f[2] * r * g[2], f[3] * r * g[3]); *(u32x2*)(W.cqn() + (size_t)row * 384 + 4 * lane) = o; }
        { const unsigned c = *(const unsigned*)(pr + C_CKV + 2 * lane); const float f0 = bf2f(c & 0xffffu), f1 = bf2f(c >> 16);
          const float r = rsqrtf(wave_sum(f0 * f0 + f1 * f1, lane) * (1.f / 128.f) + EPS);
          const f32x2 g = *(const f32x2*)(a->in[I_KVAN] + l * 128 + 2 * lane);
          *(unsigned*)(W.cqn() + (size_t)row * 384 + 256 + 2 * lane) = pk2(f0 * r * g[0], f1 * r * g[1]); }
        { const int s0 = row < ML ? (row / SEQ) * SEQ : ML + ((row - ML) / CTX) * CTX; const int Ls = row < ML ? SEQ : CTX; const int t = row - s0;
          float acc[4];
#pragma unroll
          for (int i = 0; i < 4; ++i) acc[i] = cw[1280 + 4 * lane + i];
#pragma unroll
          for (int k = 0; k < 5; ++k) { const int tt = t + k - 2;
              if (tt >= 0 && tt < Ls) { const u32x2 m = *(const u32x2*)(proj + (size_t)(s0 + tt) * DINP + C_MX + 4 * lane);
                  acc[0] += cw[k * 256 + 4 * lane + 0] * bf2f(m.x & 0xffffu); acc[1] += cw[k * 256 + 4 * lane + 1] * bf2f(m.x >> 16);
                  acc[2] += cw[k * 256 + 4 * lane + 2] * bf2f(m.y & 0xffffu); acc[3] += cw[k * 256 + 4 * lane + 3] * bf2f(m.y >> 16); } }
          u32x2 o; o.x = pk2(siluf(acc[0]), siluf(acc[1])); o.y = pk2(siluf(acc[2]), siluf(acc[3])); *(u32x2*)(W.xconv() + (size_t)row * 256 + 4 * lane) = o; }
        if (lane < 16) { const float g = bf2f(pr[C_MG + lane]) + a->in[I_MGB][l * 16 + lane]; W.gates()[(size_t)row * 16 + lane] = ((lane >> 2) & 1) ? logsigmoidf_(g) : g; }
        { const float av = lane < 32 ? bf2f(pr[C_GA + lane]) : 0.f;
#pragma unroll
          for (int u = 0; u < 2; ++u) { float s0 = a->in[I_GBA][(l * 2 + u) * 128 + lane], s1 = a->in[I_GBA][(l * 2 + u) * 128 + 64 + lane];
#pragma unroll
              for (int r = 0; r < 16; ++r) { const float ar = sh_idx(av, u * 16 + r); s0 += ar * wa[(u * 16 + r) * 128 + lane]; s1 += ar * wa[(u * 16 + r) * 128 + 64 + lane]; }
              float* lo = W.loga() + ((size_t)u * MA + row) * 128; lo[lane] = logsigmoidf_(s0) * (1.f / 16.f); lo[64 + lane] = logsigmoidf_(s1) * (1.f / 16.f); } }
    }
    __syncthreads();
    moe_weights(a, W, l, lds);
}

DI void phase_post(KArgs a, const WS& W, int l, LAS unsigned char* lds) {
    int tid_ = threadIdx.x; asm volatile("" : "+v"(tid_)); const int tid = tid_, lane = tid & 63, wid = __builtin_amdgcn_readfirstlane(tid >> 6);
    const int gw = blockIdx.x * 8 + wid, NGW = gridDim.x * 8;
    const int head = lane >> 3, sub = lane & 7, r32 = lane & 31, hi = lane >> 5;
    const bf16_t* proj = W.proj(); const bf16_t* raw = W.qkvraw();
    for (int row = gw; row < MA; row += NGW) {
        const bool lat = row < ML; const int b = lat ? row / SEQ : (row - ML) / CTX; const int t = lat ? row % SEQ : (row - ML) % CTX; const int kidx = lat ? t : SEQ + t;
        float cs[2], sn[2];
        if (lat) { cs[0] = W.rope()[t * 16 + sub * 2]; cs[1] = W.rope()[t * 16 + sub * 2 + 1]; sn[0] = W.rope()[SEQ * 16 + t * 16 + sub * 2]; sn[1] = W.rope()[SEQ * 16 + t * 16 + sub * 2 + 1]; }
        else { cs[0] = cs[1] = 1.f; sn[0] = sn[1] = 0.f; }
        { const bf16_t* qr = raw + (size_t)row * 1792 + head * 96; float f[8]; unpack8(*(const u32x4*)(qr + sub * 8), f);
          const unsigned u1 = *(const unsigned*)(qr + 64 + sub * 2), u2 = *(const unsigned*)(qr + 80 + sub * 2);
          float x1[2] = {bf2f(u1 & 0xffffu), bf2f(u1 >> 16)}, x2[2] = {bf2f(u2 & 0xffffu), bf2f(u2 >> 16)};
          float ss = x1[0] * x1[0] + x1[1] * x1[1] + x2[0] * x2[0] + x2[1] * x2[1];
#pragma unroll
          for (int i = 0; i < 8; ++i) ss += f[i] * f[i];
          ss += sh_xor(ss, 1, lane); ss += sh_xor(ss, 2, lane); ss += sh_xor(ss, 4, lane);
          const float r = rsqrtf(ss * (1.f / 96.f) + EPS) ; const float* nw = a->in[I_QNW] + l * 96;
#pragma unroll
          for (int i = 0; i < 8; ++i) f[i] = f[i] * r * nw[sub * 8 + i] * QSCALE;
          float o1[2], o2[2];
#pragma unroll
          for (int i = 0; i < 2; ++i) { const float a1 = x1[i] * r * nw[64 + sub * 2 + i], a2 = x2[i] * r * nw[80 + sub * 2 + i]; o1[i] = (a1 * cs[i] - a2 * sn[i]) * QSCALE; o2[i] = (a1 * sn[i] + a2 * cs[i]) * QSCALE; }
          bf16_t* qo = W.q() + ((size_t)(b * NH + head) * NKEY + kidx) * QK;
          *(u32x4*)(qo + sub * 8) = pack8(f); *(unsigned*)(qo + 64 + sub * 2) = pk2(o1[0], o1[1]); *(unsigned*)(qo + 80 + sub * 2) = pk2(o2[0], o2[1]); }
        { const bf16_t* kvr = raw + (size_t)row * 1792 + 768 + head * 128; float f[8]; unpack8(*(const u32x4*)(kvr + sub * 8), f);
          const bf16_t* pr = proj + (size_t)row * DINP + C_KR;
          const unsigned u1 = *(const unsigned*)(pr + sub * 2), u2 = *(const unsigned*)(pr + 16 + sub * 2);
          float x1[2] = {bf2f(u1 & 0xffffu), bf2f(u1 >> 16)}, x2[2] = {bf2f(u2 & 0xffffu), bf2f(u2 >> 16)};
          float ss = x1[0] * x1[0] + x1[1] * x1[1] + x2[0] * x2[0] + x2[1] * x2[1];
#pragma unroll
          for (int i = 0; i < 8; ++i) ss += f[i] * f[i];
          ss += sh_xor(ss, 1, lane); ss += sh_xor(ss, 2, lane); ss += sh_xor(ss, 4, lane);
          const float r = rsqrtf(ss * (1.f / 96.f) + EPS); const float* nw = a->in[I_KNW] + l * 96;
#pragma unroll
          for (int i = 0; i < 8; ++i) f[i] = f[i] * r * nw[sub * 8 + i];
          float o1[2], o2[2];
#pragma unroll
          for (int i = 0; i < 2; ++i) { const float a1 = x1[i] * r * nw[64 + sub * 2 + i], a2 = x2[i] * r * nw[80 + sub * 2 + i]; o1[i] = a1 * cs[i] - a2 * sn[i]; o2[i] = a1 * sn[i] + a2 * cs[i]; }
          const int tile = kidx >> 6, key = kidx & 63;
          bf16_t* kb = W.k() + ((size_t)(b * NH + head) * NTILE + tile) * 6144;
          *(u32x4*)(kb + (sub * 64 + key) * 8) = pack8(f);
          *(unsigned*)(kb + ((8 + (sub >> 2)) * 64 + key) * 8 + (sub & 3) * 2) = pk2(o1[0], o1[1]);
          *(unsigned*)(kb + ((10 + (sub >> 2)) * 64 + key) * 8 + (sub & 3) * 2) = pk2(o2[0], o2[1]);
          bf16_t* vb = W.v() + ((size_t)(b * NH + head) * NTILE + tile) * 4096;
          *(u32x4*)(vb + ((sub >> 2) * 4 + (key >> 4)) * 512 + (key & 15) * 32 + (sub & 3) * 8) = *(const u32x4*)(kvr + 64 + sub * 8); }
    }
    LAS bf16_t* As = (LAS bf16_t*)(lds + wid * WSCR);
    LAS bf16_t* Bs = As + 64 * 72;
    for (int u = gw; u < 2 * 16 * NCH; u += NGW) {
        const int kind = u / (16 * NCH), s = (u % (16 * NCH)) / NCH, gc = u % NCH, b = s >> 3, h = (s >> 1) & 3, dir = s & 1;
        const int row = tokrow(b, gc, lane);
        LDS_WAIT(); asm volatile("" ::: "memory");
        if (kind == 0) {
            const float logi = W.gates()[(size_t)row * 16 + dir * 8 + h], logf = W.gates()[(size_t)row * 16 + dir * 8 + 4 + h];
            const float bc = scan_incl(logf, lane, dir), bend = sh_idx(bc, dir ? 0 : 63), g = bend - bc + logi, gmax = wave_max(g, lane), wj = __expf(g - gmax);
#pragma unroll
            for (int i = 0; i < 8; ++i) { const int p = i * 8 + (lane >> 3), c8 = lane & 7; const int rp = tokrow(b, gc, p);
                float fv[8], fk[8]; unpack8(*(const u32x4*)(proj + (size_t)rp * DINP + C_MV + h * 64 + c8 * 8), fv); unpack8(*(const u32x4*)(W.mqk() + (size_t)rp * 512 + 256 + h * 64 + c8 * 8), fk);
                const float wp = sh_idx(wj, p);
#pragma unroll
                for (int e = 0; e < 8; ++e) { As[(c8 * 8 + e) * 72 + p] = (bf16_t)f2bf(fv[e]); Bs[(c8 * 8 + e) * 72 + p] = (bf16_t)f2bf(fk[e] * wp); } }
            LDS_WAIT(); asm volatile("" ::: "memory");
            float* ut = W.mu() + (size_t)(s * NCH + gc) * 4096;
#pragma unroll
            for (int mt = 0; mt < 2; ++mt)
#pragma unroll
                for (int nt = 0; nt < 2; ++nt) { f32x16 acc = {}; wmma32<4>(acc, As + mt * 32 * 72, 72, Bs + nt * 32 * 72, 72, r32, hi);
#pragma unroll
                    for (int r = 0; r < 16; ++r) ut[(32 * mt + crow(r, hi)) * 64 + 32 * nt + r32] = acc[r]; }
            float nsum = 0.f;
#pragma unroll 8
            for (int j = 0; j < 64; ++j) nsum += bf2f(Bs[lane * 72 + j]);
            W.mn()[(size_t)(s * NCH + gc) * 64 + lane] = nsum;
            if (lane == 0) { W.ms()[(size_t)(s * NCH + gc) * 4 + 0] = gmax; W.ms()[(size_t)(s * NCH + gc) * 4 + 1] = bend; }
        } else {
            float bc[32];
            { const float* lp = W.loga() + ((size_t)dir * MA + row) * 128 + h * 32;
#pragma unroll
              for (int q4 = 0; q4 < 8; ++q4) { const f32x4 v = *(const f32x4*)(lp + 4 * q4); bc[4 * q4] = v[0]; bc[4 * q4 + 1] = v[1]; bc[4 * q4 + 2] = v[2]; bc[4 * q4 + 3] = v[3]; } }
#pragma unroll
            for (int d = 0; d < 32; ++d) bc[d] = scan_incl(bc[d], lane, dir);
            float kk[32];
#pragma unroll
            for (int q8 = 0; q8 < 4; ++q8) { float f[8]; unpack8(*(const u32x4*)(proj + (size_t)row * DINP + C_GK + h * 32 + q8 * 8), f);
#pragma unroll
                for (int e = 0; e < 8; ++e) kk[q8 * 8 + e] = f[e]; }
            float* gdp = W.gd() + (size_t)(s * NCH + gc) * 32;
#pragma unroll
            for (int d = 0; d < 32; ++d) { const float bend = sh_idx(bc[d], dir ? 0 : 63); Bs[d * 72 + lane] = (bf16_t)f2bf(kk[d] * __expf(bend - bc[d])); if (lane == d) gdp[d] = __expf(bend); }
#pragma unroll
            for (int i = 0; i < 8; ++i) { const int p = i * 8 + (lane >> 3), c8 = lane & 7; const int rp = tokrow(b, gc, p);
                float fv[8]; unpack8(*(const u32x4*)(proj + (size_t)rp * DINP + C_GV + h * 64 + c8 * 8), fv);
#pragma unroll
                for (int e = 0; e < 8; ++e) As[(c8 * 8 + e) * 72 + p] = (bf16_t)f2bf(fv[e]); }
            LDS_WAIT(); asm volatile("" ::: "memory");
            float* ut = W.gu() + (size_t)(s * NCH + gc) * 2048;
#pragma unroll
            for (int mt = 0; mt < 2; ++mt) { f32x16 acc = {}; wmma32<4>(acc, As + mt * 32 * 72, 72, Bs, 72, r32, hi);
#pragma unroll
                for (int r = 0; r < 16; ++r) ut[(32 * mt + crow(r, hi)) * 32 + r32] = acc[r]; }
        }
    }
}

DI int scan_gc(int dir, int sc) { return dir ? (NCH - 1 - sc) : (sc < 4 ? 128 + sc : sc - 4); }
DI void phase_scan(const WS& W, LAS unsigned char* lds) {
    int tid_ = threadIdx.x; asm volatile("" : "+v"(tid_)); const int tid = tid_;
    LAS float* gm = (LAS float*)lds; LAS float* be = gm + NCH; LAS float* dec = be + NCH; LAS float* ff = dec + NCH; LAS float* mi = ff + NCH;
    for (int u = blockIdx.x; u < 192; u += gridDim.x) {
        __syncthreads();
        if (u < 128) {
            const int s = u >> 3, slice = u & 7, dir = s & 1;
            if (tid < NCH) { const int gc = scan_gc(dir, tid); gm[tid] = W.ms()[(size_t)(s * NCH + gc) * 4 + 0]; be[tid] = W.ms()[(size_t)(s * NCH + gc) * 4 + 1]; }
            __syncthreads();
            if (tid == 0) { float m = 0.f; for (int sc = 0; sc < NCH; ++sc) { mi[sc] = m; const float mn = fmaxf(be[sc] + m, gm[sc]); dec[sc] = __expf(be[sc] + m - mn); ff[sc] = __expf(gm[sc] - mn); m = mn; } }
            __syncthreads();
            const int e = slice * 512 + tid; float C = 0.f, nn = 0.f;
            const bool do_n = (slice == 0 && tid < 64);
            for (int sc0 = 0; sc0 < NCH; sc0 += 12) {
                float uu[12], un[12];
#pragma unroll
                for (int j = 0; j < 12; ++j) { const int gc = scan_gc(dir, sc0 + j); uu[j] = W.mu()[(size_t)(s * NCH + gc) * 4096 + e]; un[j] = do_n ? W.mn()[(size_t)(s * NCH + gc) * 64 + tid] : 0.f; }
#pragma unroll
                for (int j = 0; j < 12; ++j) { const int sc = sc0 + j, gc = scan_gc(dir, sc);
                    W.mu()[(size_t)(s * NCH + gc) * 4096 + e] = C; C = dec[sc] * C + ff[sc] * uu[j];
                    if (do_n) { W.mn()[(size_t)(s * NCH + gc) * 64 + tid] = nn; nn = dec[sc] * nn + ff[sc] * un[j]; }
                    if (slice == 0 && tid == 64) W.ms()[(size_t)(s * NCH + gc) * 4 + 2] = mi[sc]; } }
        } else {
            const int s = (u - 128) >> 2, slice = (u - 128) & 3, dir = s & 1; const int e = slice * 512 + tid, d = e & 31; float S = 0.f;
            for (int sc0 = 0; sc0 < NCH; sc0 += 12) {
                float uu[12], dc[12];
#pragma unroll
                for (int j = 0; j < 12; ++j) { const int gc = scan_gc(dir, sc0 + j); uu[j] = W.gu()[(size_t)(s * NCH + gc) * 2048 + e]; dc[j] = W.gd()[(size_t)(s * NCH + gc) * 32 + d]; }
#pragma unroll
                for (int j = 0; j < 12; ++j) { const int gc = scan_gc(dir, sc0 + j); W.gu()[(size_t)(s * NCH + gc) * 2048 + e] = S; S = dc[j] * S + uu[j]; } }
        }
    }
    __syncthreads();
}

constexpr int AT_SLOT = 20480, AT_WS = 3 * AT_SLOT, AT_OST = AT_WS + 2048;
DI void glds16(const void* gsrc, unsigned lds_dst) { unsigned keep;
    asm volatile("s_mov_b32 %0, m0\n\ts_mov_b32 m0, %2\n\ts_nop 0\n\tglobal_load_lds_dwordx4 %1, off\n\ts_mov_b32 m0, %0" : "=&s"(keep) : "v"(gsrc), "s"(lds_dst) : "memory"); }
DI s16x4 vtr(const LAS char* p) { typedef short v4i16_t __attribute__((ext_vector_type(4))); return __builtin_bit_cast(s16x4, __builtin_amdgcn_ds_read_tr16_b64_v4i16((LAS v4i16_t*)p)); }
DI void attn_unit(const WS& W, LAS unsigned char* lds, int b, int h, int tq0, int tile0, int nt, int orow0) {
    int tid_ = threadIdx.x; asm volatile("" : "+v"(tid_)); const int tid = tid_, lane = tid & 63, r32 = lane & 31, hi = lane >> 5; const int wid = __builtin_amdgcn_readfirstlane(tid >> 6);
    const unsigned lds0 = (unsigned)(uintptr_t)lds;
    const bf16_t* Qw = W.q() + ((size_t)(b * NH + h) * NKEY + tq0 + wid * 32 + r32) * QK;
    const char* Kt = (const char*)(W.k() + ((size_t)(b * NH + h) * NTILE + tile0) * 6144);
    const char* Vt = (const char*)(W.v() + ((size_t)(b * NH + h) * NTILE + tile0) * 4096);
    const int np = wid < 4 ? 3 : 2;
#define AT_ISSUE(t, slot) do { const char* kt_ = Kt + (size_t)(t) * 12288; const char* vt_ = Vt + (size_t)(t) * 8192; const unsigned d_ = lds0 + (slot) * AT_SLOT; \
        glds16(kt_ + wid * 1024 + lane * 16, (unsigned)__builtin_amdgcn_readfirstlane(d_ + wid * 1024)); \
        if (wid < 4) { glds16(kt_ + (wid + 8) * 1024 + lane * 16, (unsigned)__builtin_amdgcn_readfirstlane(d_ + (wid + 8) * 1024)); glds16(vt_ + (wid + 4) * 1024 + lane * 16, (unsigned)__builtin_amdgcn_readfirstlane(d_ + (wid + 16) * 1024)); } \
        else { glds16(vt_ + (wid - 4) * 1024 + lane * 16, (unsigned)__builtin_amdgcn_readfirstlane(d_ + (wid + 8) * 1024)); } } while (0)
    bf16x8 qr[6];
#pragma unroll
    for (int d0 = 0; d0 < 6; ++d0) qr[d0] = *(const bf16x8*)(Qw + d0 * 16 + hi * 8);
    VM_WAIT();
    AT_ISSUE(0, 0);
    if (nt > 1) AT_ISSUE(1, 1);
    f32x16 o[2]; o[0] = f32x16{}; o[1] = f32x16{}; float l_reg = 0.f;
    const int vb = ((lane >> 4) & 1) * 32 + (lane & 3) * 8 + (4 * hi + ((lane & 15) >> 2)) * 64;
    int slot = 0;
    for (int t = 0; t < nt; ++t) {
        if (t + 1 < nt) { if (np == 3) asm volatile("s_waitcnt vmcnt(3)\n\ts_waitcnt lgkmcnt(0)\n\ts_barrier" ::: "memory"); else asm volatile("s_waitcnt vmcnt(2)\n\ts_waitcnt lgkmcnt(0)\n\ts_barrier" ::: "memory"); }
        else asm volatile("s_waitcnt vmcnt(0)\n\ts_waitcnt lgkmcnt(0)\n\ts_barrier" ::: "memory");
        if (t + 2 < nt) { const int s2 = slot >= 1 ? slot - 1 : 2; AT_ISSUE(t + 2, s2); }
        const LAS char* Ks = (const LAS char*)lds + slot * AT_SLOT; const LAS char* Vs = Ks + 12288;
        f32x16 p0 = f32x16{}, p1 = f32x16{};
#pragma unroll
        for (int d0 = 0; d0 < 6; ++d0) {
            const bf16x8 k0 = *(const LAS bf16x8*)(Ks + (2 * d0 + hi) * 1024 + r32 * 16);
            const bf16x8 k1 = *(const LAS bf16x8*)(Ks + (2 * d0 + hi) * 1024 + (32 + r32) * 16);
            p0 = __builtin_amdgcn_mfma_f32_32x32x16_bf16(k0, qr[d0], p0, 0, 0, 0);
            p1 = __builtin_amdgcn_mfma_f32_32x32x16_bf16(k1, qr[d0], p1, 0, 0, 0);
        }
        float sacc = 0.f;
#pragma unroll
        for (int r = 0; r < 16; ++r) { p0[r] = __builtin_amdgcn_exp2f(p0[r]); p1[r] = __builtin_amdgcn_exp2f(p1[r]); sacc += p0[r] + p1[r]; }
        l_reg += sacc;
        u32x4 pw[4];
#pragma unroll
        for (int j = 0; j < 4; ++j) { pw[0][j] = cvtpk(p0[2 * j], p0[2 * j + 1]); pw[1][j] = cvtpk(p0[8 + 2 * j], p0[8 + 2 * j + 1]);
            pw[2][j] = cvtpk(p1[2 * j], p1[2 * j + 1]); pw[3][j] = cvtpk(p1[8 + 2 * j], p1[8 + 2 * j + 1]); }
#pragma unroll
        for (int d0 = 0; d0 < 2; ++d0)
#pragma unroll
            for (int ks = 0; ks < 4; ++ks) {
                const s16x4 lo = vtr(Vs + vb + d0 * 4096 + ks * 1024), hh = vtr(Vs + vb + d0 * 4096 + ks * 1024 + 512);
                const bf16x8 vf = (bf16x8){lo[0], lo[1], lo[2], lo[3], hh[0], hh[1], hh[2], hh[3]};
                o[d0] = __builtin_amdgcn_mfma_f32_32x32x16_bf16(__builtin_bit_cast(bf16x8, pw[ks]), vf, o[d0], 0, 0, 0);
            }
        slot = slot == 2 ? 0 : slot + 1;
    }
#undef AT_ISSUE
    { auto rr = __builtin_amdgcn_permlane32_swap(__float_as_uint(l_reg), __float_as_uint(l_reg), false, false); l_reg = __uint_as_float(rr[0]) + __uint_as_float(rr[1]); }
    LAS float* wsf = (LAS float*)(lds + AT_WS) + wid * 64;
    if (hi == 0) wsf[r32] = l_reg;
    LDS_WAIT();
    float rli[16];
#pragma unroll
    for (int r = 0; r < 16; ++r) rli[r] = 1.f / wsf[crow(r, hi)];
    LAS bf16_t* stg = (LAS bf16_t*)(lds + AT_OST) + wid * 2048;
#pragma unroll
    for (int r = 0; r < 16; ++r) { const int orow = crow(r, hi);
#pragma unroll
        for (int d0 = 0; d0 < 2; ++d0) stg[orow * 64 + d0 * 32 + r32] = (bf16_t)f2bf(o[d0][r] * rli[r]); }
    LDS_WAIT();
    bf16_t* Ow = W.mix() + (size_t)(orow0 + wid * 32) * D + h * 64;
#pragma unroll
    for (int i = 0; i < 4; ++i) { const int row = i * 8 + (lane >> 3), ch = lane & 7; u32x4 v = *(const LAS u32x4*)(stg + row * 64 + ch * 8);
#ifdef PROBE_NOATT
        v = (u32x4){0u, 0u, 0u, 0u};
#endif
        *(u32x4*)(Ow + (size_t)row * D + ch * 8) = v; }
    asm volatile("s_waitcnt lgkmcnt(0)\n\ts_barrier" ::: "memory");
}
DI void phase_attn(const WS& W, LAS unsigned char* lds, bool need_ctx) {
    const int G = gridDim.x, bx = blockIdx.x; const int vcu = (G % 8 == 0) ? (bx % 8) * (G / 8) + bx / 8 : bx;
    for (int L = vcu; L < 512; L += G) {
        int bh, qb; if (G == 256) { const int i = L >> 8, v = L & 255; bh = (v >> 5) * 2 + i; qb = v & 31; } else { bh = L >> 5; qb = L & 31; }
        attn_unit(W, lds, bh >> 3, bh & 7, qb * 256, 0, NTILE, (bh >> 3) * SEQ + qb * 256);
    }
    if (need_ctx) for (int L = vcu; L < 16; L += G) attn_unit(W, lds, L >> 3, L & 7, SEQ, 128, 4, ML + (L >> 3) * CTX);
}

DI void mlstm_out_unit(KArgs a, const WS& W, int l, int b, int h, int gc, LAS unsigned char* lds) {
    int tid_ = threadIdx.x; asm volatile("" : "+v"(tid_)); const int tid = tid_, lane = tid & 63, r32 = lane & 31, hi = lane >> 5; const int wid = __builtin_amdgcn_readfirstlane(tid >> 6);
    LAS bf16_t* qs = (LAS bf16_t*)lds; LAS bf16_t* ks = qs + 4608; LAS bf16_t* vT = ks + 4608; LAS bf16_t* CT = vT + 4608  ; LAS bf16_t* P = CT + 2 * 4608  ;
    LAS float* Hs = (LAS float*)(lds + 64512)  ; LAS float* sm = (LAS float*)(lds + 97280);
    const bf16_t* proj = W.proj();
    { const int p = tid >> 3, c8 = tid & 7; const int rp = tokrow(b, gc, p);
      *(LAS u32x4*)(qs + p * 72 + c8 * 8) = *(const u32x4*)(W.mqk() + (size_t)rp * 512 + h * 64 + c8 * 8);
      *(LAS u32x4*)(ks + p * 72 + c8 * 8) = *(const u32x4*)(W.mqk() + (size_t)rp * 512 + 256 + h * 64 + c8 * 8);
      float fv[8]; unpack8(*(const u32x4*)(proj + (size_t)rp * DINP + C_MV + h * 64 + c8 * 8), fv);
#pragma unroll
      for (int e = 0; e < 8; ++e) vT[(c8 * 8 + e) * 72 + p] = (bf16_t)f2bf(fv[e]);
#pragma unroll
      for (int dir = 0; dir < 2; ++dir) { const int s = (b * 4 + h) * 2 + dir; const float* cp = W.mu() + (size_t)(s * NCH + gc) * 4096 + p * 64 + c8 * 8;
          const f32x4 c0 = *(const f32x4*)cp, c1 = *(const f32x4*)(cp + 4); float f[8] = {c0[0], c0[1], c0[2], c0[3], c1[0], c1[1], c1[2], c1[3]};
          *(LAS u32x4*)(CT + dir * 4608 + p * 72 + c8 * 8) = pack8(f); }
      if (tid < 128) { const int dir = tid >> 6, d = tid & 63; const int s = (b * 4 + h) * 2 + dir; sm[dir * 384 + 4 * 64 + d] = W.mn()[(size_t)(s * NCH + gc) * 64 + d]; } }
    if ((wid & 3) == 0) { const int dir = wid >> 2; const int s = (b * 4 + h) * 2 + dir; const int row = tokrow(b, gc, lane);
        const float logi = W.gates()[(size_t)row * 16 + dir * 8 + h], logf = W.gates()[(size_t)row * 16 + dir * 8 + 4 + h];
        const float mst = W.ms()[(size_t)(s * NCH + gc) * 4 + 2];
        const float bc = scan_incl(logf, lane, dir), av = logi - bc, amax = scan_max(av, lane, dir), mt = bc + fmaxf(mst, amax);
        LAS float* sd = sm + dir * 384; sd[lane] = bc - mt; sd[64 + lane] = av; sd[128 + lane] = __expf(bc + mst - mt); sd[192 + lane] = __expf(-mt); }
    __syncthreads();
    const int dir = wid >> 2, mt_ = (wid >> 1) & 1, nt_ = wid & 1; LAS float* sd = sm + dir * 384; LAS bf16_t* Pd = P + dir * 4608;
    { f32x16 acc = {}; wmma32<4>(acc, qs + mt_ * 32 * 72, 72, ks + nt_ * 32 * 72, 72, r32, hi);
      const int j = 32 * nt_ + r32; const float bj = sd[64 + j];
#pragma unroll
      for (int r = 0; r < 16; ++r) { const int t = 32 * mt_ + crow(r, hi); const bool ok = dir ? (j >= t) : (j <= t); const float w = ok ? __expf(sd[t] + bj) : 0.f; Pd[t * 72 + j] = (bf16_t)f2bf(acc[r] * w); } }
    __syncthreads();
    f32x16 acc = {};
    wmma32<4>(acc, qs + mt_ * 32 * 72, 72, CT + dir * 4608 + nt_ * 32 * 72, 72, r32, hi);
#pragma unroll
    for (int r = 0; r < 16; ++r) acc[r] *= sd[128 + 32 * mt_ + crow(r, hi)];
    wmma32<4>(acc, Pd + mt_ * 32 * 72, 72, vT + nt_ * 32 * 72, 72, r32, hi);
    if (nt_ == 0 && lane < 32) { const int t = 32 * mt_ + lane; float rs = 0.f, qn = 0.f;
#pragma unroll 8
        for (int j = 0; j < 64; ++j) { rs += bf2f(Pd[t * 72 + j]); qn += bf2f(qs[t * 72 + j]) * sd[256 + j]; }
        const float den = rs + sd[128 + t] * qn; sd[320 + t] = 1.f / fmaxf(fabsf(den), sd[192 + t]); }
    __syncthreads();
#pragma unroll
    for (int r = 0; r < 16; ++r) { const int t = 32 * mt_ + crow(r, hi); Hs[dir * 4096 + t * 64 + 32 * nt_ + r32] = acc[r] * sd[320 + t]; }
    __syncthreads();
    { const int t = tid >> 3, v0 = (tid & 7) * 8; const int row = tokrow(b, gc, t); float hv[8]; float ss = 0.f;
#pragma unroll
      for (int e = 0; e < 8; ++e) { hv[e] = Hs[t * 64 + v0 + e] + Hs[4096 + t * 64 + v0 + e]; ss += hv[e] * hv[e]; }
      ss += sh_xor(ss, 1, lane); ss += sh_xor(ss, 2, lane); ss += sh_xor(ss, 4, lane);
      const float r = rsqrtf(ss * (1.f / 64.f) + EPS);
      float xcv[8], ov[8]; unpack8(*(const u32x4*)(W.xconv() + (size_t)row * 256 + h * 64 + v0), xcv); unpack8(*(const u32x4*)(proj + (size_t)row * DINP + C_MO + h * 64 + v0), ov);
      const float* nw = a->in[I_MNW] + l * 256 + h * 64 + v0; const float* sk = a->in[I_MSK] + l * 256 + h * 64 + v0; float o[8];
#pragma unroll
      for (int e = 0; e < 8; ++e) o[e] = sigmoidf_(ov[e]) * (hv[e] * r * nw[e] + sk[e] * xcv[e]);
      *(u32x4*)(W.mix() + (size_t)row * D + 512 + h * 64 + v0) = pack8(o); }
    __syncthreads();
}
DI void gla_out_unit(KArgs a, const WS& W, int l, int b, int h, int gc, LAS unsigned char* lds) {
    int tid_ = threadIdx.x; asm volatile("" : "+v"(tid_)); const int tid = tid_, lane = tid & 63, r32 = lane & 31, hi = lane >> 5; const int wid = __builtin_amdgcn_readfirstlane(tid >> 6);
    LAS bf16_t* qs = (LAS bf16_t*)lds  ; LAS bf16_t* ks = qs + 2 * 2560; LAS bf16_t* vT = ks + 2 * 2560  ; LAS bf16_t* ST = vT + 4608  ; LAS bf16_t* P = ST + 2 * 2560  ;
    LAS float* Hs = (LAS float*)(lds + 58368);
    const bf16_t* proj = W.proj();
    { const int p = tid >> 3, c8 = tid & 7; const int rp = tokrow(b, gc, p);
      float fv[8]; unpack8(*(const u32x4*)(proj + (size_t)rp * DINP + C_GV + h * 64 + c8 * 8), fv);
#pragma unroll
      for (int e = 0; e < 8; ++e) vT[(c8 * 8 + e) * 72 + p] = (bf16_t)f2bf(fv[e]);
      const int dir = tid >> 8, idx = tid & 255, v = idx >> 2, d0 = (idx & 3) * 8; const int s = (b * 4 + h) * 2 + dir;
      const float* sp = W.gu() + (size_t)(s * NCH + gc) * 2048 + v * 32 + d0; const f32x4 c0 = *(const f32x4*)sp, c1 = *(const f32x4*)(sp + 4);
      float f[8] = {c0[0], c0[1], c0[2], c0[3], c1[0], c1[1], c1[2], c1[3]}; *(LAS u32x4*)(ST + dir * 2560 + v * 40 + d0) = pack8(f); }
    if ((wid & 3) == 0) { const int dir = wid >> 2; const int row = tokrow(b, gc, lane);
        float bc[32];
        { const float* lp = W.loga() + ((size_t)dir * MA + row) * 128 + h * 32;
#pragma unroll
          for (int q4 = 0; q4 < 8; ++q4) { const f32x4 v = *(const f32x4*)(lp + 4 * q4); bc[4 * q4] = v[0]; bc[4 * q4 + 1] = v[1]; bc[4 * q4 + 2] = v[2]; bc[4 * q4 + 3] = v[3]; } }
#pragma unroll
        for (int d = 0; d < 32; ++d) bc[d] = scan_incl(bc[d], lane, dir);
#pragma unroll
        for (int q8 = 0; q8 < 4; ++q8) { float fq[8], fk[8]; unpack8(*(const u32x4*)(proj + (size_t)row * DINP + C_GQ + h * 32 + q8 * 8), fq); unpack8(*(const u32x4*)(proj + (size_t)row * DINP + C_GK + h * 32 + q8 * 8), fk);
#pragma unroll
            for (int e = 0; e < 8; ++e) { fq[e] = fq[e] * 0.17677669529663687f * __expf(bc[q8 * 8 + e]); fk[e] = fk[e] * __expf(-bc[q8 * 8 + e]); }
            *(LAS u32x4*)(qs + dir * 2560 + lane * 40 + q8 * 8) = pack8(fq); *(LAS u32x4*)(ks + dir * 2560 + lane * 40 + q8 * 8) = pack8(fk); } }
    __syncthreads();
    const int dir = wid >> 2, mt_ = (wid >> 1) & 1, nt_ = wid & 1; LAS bf16_t* Pd = P + dir * 4608;
    { f32x16 acc = {}; wmma32<2>(acc, qs + dir * 2560 + mt_ * 32 * 40, 40, ks + dir * 2560 + nt_ * 32 * 40, 40, r32, hi);
      const int j = 32 * nt_ + r32;
#pragma unroll
      for (int r = 0; r < 16; ++r) { const int t = 32 * mt_ + crow(r, hi); const bool ok = dir ? (j >= t) : (j <= t); Pd[t * 72 + j] = (bf16_t)f2bf(ok ? acc[r] : 0.f); } }
    __syncthreads();
    f32x16 acc = {};
    wmma32<2>(acc, qs + dir * 2560 + mt_ * 32 * 40, 40, ST + dir * 2560 + nt_ * 32 * 40, 40, r32, hi);
    wmma32<4>(acc, Pd + mt_ * 32 * 72, 72, vT + nt_ * 32 * 72, 72, r32, hi);
#pragma unroll
    for (int r = 0; r < 16; ++r) { const int t = 32 * mt_ + crow(r, hi); Hs[dir * 4096 + t * 64 + 32 * nt_ + r32] = acc[r]; }
    __syncthreads();
    { const int t = tid >> 3, v0 = (tid & 7) * 8; const int row = tokrow(b, gc, t); float hv[8]; float ss = 0.f;
#pragma unroll
      for (int e = 0; e < 8; ++e) { hv[e] = Hs[t * 64 + v0 + e] + Hs[4096 + t * 64 + v0 + e]; ss += hv[e] * hv[e]; }
      ss += sh_xor(ss, 1, lane); ss += sh_xor(ss, 2, lane); ss += sh_xor(ss, 4, lane);
      const float r = rsqrtf(ss * (1.f / 64.f) + EPS);
      float rv[8]; unpack8(*(const u32x4*)(proj + (size_t)row * DINP + C_GR + h * 64 + v0), rv);
      const float* nw = a->in[I_GNW] + l * 256 + h * 64 + v0; float o[8];
#pragma unroll
      for (int e = 0; e < 8; ++e) o[e] = hv[e] * r * nw[e] * siluf(rv[e]);
      *(u32x4*)(W.mix() + (size_t)row * D + 768 + h * 64 + v0) = pack8(o); }
    __syncthreads();
}
DI void phase_chunkout(KArgs a, const WS& W, int l, LAS unsigned char* lds) {
    const int nch = (l < DEPTH - 1) ? NCH : 128;
    for (int u = blockIdx.x; u < 2 * 8 * nch; u += gridDim.x) {
        const int kind = u / (8 * nch), rem = u % (8 * nch), bh = rem / nch, gc = rem % nch;
        if (kind == 0) mlstm_out_unit(a, W, l, bh >> 2, bh & 3, gc, lds); else gla_out_unit(a, W, l, bh >> 2, bh & 3, gc, lds);
    }
}

DI void phase_router(KArgs a, const WS& W, int l, int nrows, LAS unsigned char* lds, bool dry = false) {
    int tid_ = threadIdx.x; asm volatile("" : "+v"(tid_)); const int tid = tid_, lane = tid & 63, wid = __builtin_amdgcn_readfirstlane(tid >> 6);
    const int gw = blockIdx.x * 8 + wid, NGW = gridDim.x * 8;
    LAS float* WT = (LAS float*)lds;
    __syncthreads();
    for (int i = tid; i < 36 * 256; i += 512) *(LAS f32x4*)(WT + 4 * i) = *(const f32x4*)(W.rtw() + (size_t)l * 36 * 1024 + 4 * i);
    __syncthreads();
    unsigned* cnt = W.ctl() + CW_CNT + l * NEXP * 64;
    LAS float* lgw = (LAS float*)(lds + 147456) + wid * 128;
    LAS int* rt_e = (LAS int*)(lds + 151552);
    LAS int* rt_s = rt_e + 128;
    LAS float* rt_w = (LAS float*)(rt_s + 128);
    LAS int* rt_row = (LAS int*)(rt_w + 256);
    LAS int* lcnt = rt_row + 128;
    if (tid < 64) lcnt[tid] = 0;
    __syncthreads();
    int trip = 0;
    for (int row0 = gw * 2; row0 < nrows; row0 += NGW * 2, ++trip) {
        f32x4 v[2][4];
#pragma unroll
        for (int q = 0; q < 2; ++q) { const int row = row0 + q;
            const float* xr = row < ML ? a->out + (size_t)row * D : W.xc() + (size_t)(row - ML) * D;
            const int vec = row < SEQ ? 0 : (row < ML ? 1 : 2); float ss = 0.f;
#pragma unroll
            for (int j = 0; j < 4; ++j) { v[q][j] = *(const f32x4*)(xr + 4 * lane + 256 * j); ss += (v[q][j][0] * v[q][j][0] + v[q][j][1] * v[q][j][1]) + (v[q][j][2] * v[q][j][2] + v[q][j][3] * v[q][j][3]); }
            const float r = rsqrtf(wave_sum(ss, lane) * (1.f / D) + EPS);
            const float* md = W.mods() + (size_t)(l * 3 + vec) * 6144; const float* nw = a->in[I_N2W] + l * D; bf16_t* hr = W.h() + (size_t)row * D;
#pragma unroll
            for (int j = 0; j < 4; ++j) { const int c = 4 * lane + 256 * j; const f32x4 w = *(const f32x4*)(nw + c), sh = *(const f32x4*)(md + 3072 + c), sc = *(const f32x4*)(md + 4096 + c);
#pragma unroll
                for (int i = 0; i < 4; ++i) v[q][j][i] = v[q][j][i] * r * w[i] * (1.f + sc[i]) + sh[i];
                if (!dry) { u32x2 p; p.x = pk2(v[q][j][0], v[q][j][1]); p.y = pk2(v[q][j][2], v[q][j][3]); *(u32x2*)(hr + c) = p; } } }
#pragma unroll 2
        for (int e = 0; e < 36; ++e) { float s0 = 0.f, s1 = 0.f;
#pragma unroll
            for (int j = 0; j < 4; ++j) { const f32x4 w = *(const LAS f32x4*)(WT + e * 1024 + 4 * lane + 256 * j);
                s0 += (v[0][j][0] * w[0] + v[0][j][1] * w[1]) + (v[0][j][2] * w[2] + v[0][j][3] * w[3]); s1 += (v[1][j][0] * w[0] + v[1][j][1] * w[1]) + (v[1][j][2] * w[2] + v[1][j][3] * w[3]); }
            s0 = dpp_sum63(s0); s1 = dpp_sum63(s1);
            if (lane == 63) { lgw[e] = s0; lgw[64 + e] = s1; } }
        LDS_WAIT(); asm volatile("" ::: "memory");
#pragma unroll
        for (int q = 0; q < 2; ++q) { const int row = row0 + q; LAS float* lg = lgw + 64 * q;
            float gl[4];
#pragma unroll
            for (int i = 0; i < 4; ++i) gl[i] = lg[i] + a->in[I_BGRP][l * 4 + i];
            int g = 0; float gmx = gl[0];
#pragma unroll
            for (int i = 1; i < 4; ++i) if (gl[i] > gmx) { gmx = gl[i]; g = i; }
            float gz = 0.f;
#pragma unroll
            for (int i = 0; i < 4; ++i) gz += __expf(gl[i] - gmx);
            const float gwt = 1.f / gz;
            float el[8];
#pragma unroll
            for (int i = 0; i < 8; ++i) el[i] = lg[4 + g * 8 + i] + a->in[I_BER][l * 32 + g * 8 + i];
            int i1 = 0; float m1 = el[0];
#pragma unroll
            for (int i = 1; i < 8; ++i) if (el[i] > m1) { m1 = el[i]; i1 = i; }
            int i2 = -1; float m2 = -3.0e38f;
#pragma unroll
            for (int i = 0; i < 8; ++i) if (i != i1 && el[i] > m2) { m2 = el[i]; i2 = i; }
            const float ex = __expf(m2 - m1), w1 = gwt / (1.f + ex), w2 = gwt * ex / (1.f + ex);
            if (lane == 0 && !dry) {
                const int e1 = g * 8 + i1, e2 = g * 8 + i2, li = trip * 16 + wid * 2 + q;
                const int ls1 = __hip_atomic_fetch_add(lcnt + e1, 1, __ATOMIC_RELAXED, __HIP_MEMORY_SCOPE_WORKGROUP), ls2 = __hip_atomic_fetch_add(lcnt + e2, 1, __ATOMIC_RELAXED, __HIP_MEMORY_SCOPE_WORKGROUP);
                rt_e[li] = e1 | (e2 << 8); rt_s[li] = ls1 | (ls2 << 16); rt_w[2 * li] = w1; rt_w[2 * li + 1] = w2; rt_row[li] = row;
            } }
    }
    __syncthreads();
    if (!dry) {
        if (tid < NEXP) { const int n = lcnt[tid]; lcnt[32 + tid] = n > 0 ? (int)atomicAdd(cnt + tid * 64, (unsigned)n) : 0; }
        __syncthreads();
        const int nloc = ((nrows - 2 * (int)blockIdx.x * 8 + NGW * 2 - 1) / (NGW * 2));
        for (int li = tid; li < nloc * 16; li += 512) { const int tr = li >> 4, w = (li >> 1) & 7, q = li & 1; const int row = ((int)blockIdx.x * 8 + w) * 2 + tr * NGW * 2 + q;
            if (row < nrows) { const int pe = rt_e[li], ps = rt_s[li]; const int e1 = pe & 0xff, e2 = pe >> 8; const int s1 = lcnt[32 + e1] + (ps & 0xffff), s2 = lcnt[32 + e2] + (ps >> 16);
                W.pair()[(size_t)e1 * PAIRCAP + s1] = row * 2; W.pw()[(size_t)e1 * PAIRCAP + s1] = rt_w[2 * li];
                W.pair()[(size_t)e2 * PAIRCAP + s2] = row * 2 + 1; W.pw()[(size_t)e2 * PAIRCAP + s2] = rt_w[2 * li + 1]; } }
    }
    __syncthreads();
}
DI void moe_tables(const WS& W, int l, LAS unsigned char* lds) {
    volatile LAS int* toff = (volatile LAS int*)(lds + MISC_OFF + 64); volatile LAS int* cn = (volatile LAS int*)(lds + MISC_OFF + 256);
    __syncthreads();
    if (threadIdx.x == 0) { int acc = 0; for (int e = 0; e < NEXP; ++e) { const int c = (int)__hip_atomic_load(W.ctl() + CW_CNT + (l * NEXP + e) * 64, __ATOMIC_RELAXED, __HIP_MEMORY_SCOPE_AGENT); cn[e] = c; toff[e] = acc; acc += (c + 255) >> 8; } toff[NEXP] = acc; }
    __syncthreads();
}

__global__ void __launch_bounds__(512, 2) fwd_kernel(Args a) {
    extern __shared__ __attribute__((aligned(16))) unsigned char lds_raw[];
    LAS unsigned char* lds = (LAS unsigned char*)lds_raw;
    const KArgs ka = (KArgs)__builtin_amdgcn_kernarg_segment_ptr();
#define AL() ({ KArgs al_ = ka; asm volatile("" : "+s"(al_)); al_; })
#define WL() (WS{AL()->ws})
#define LL() ({ int l_ = l; asm volatile("" : "+s"(l_)); l_; })
    const WS W{a.ws};
    const int tid = threadIdx.x, G = gridDim.x;
    volatile LAS unsigned* misc = (volatile LAS unsigned*)(lds + MISC_OFF);
    if (tid < 4) misc[tid] = 0u;
    __syncthreads();
    const bool fused = (a.ph_hi - a.ph_lo) > 1;
    XcdBarrier bar; bar.bar = W.ctl() + CW_BAR; bar.x = 0; bar.st = misc;
    if (fused) bar = xcd_barrier_post(W.ctl() + CW_BAR, misc);
    const int lo = a.ph_lo, hi = a.ph_hi;
#ifndef PHMASK
#define PHMASK 0xFFFFFFFFu
#endif
#ifndef PROBE_PH
#define PROBE_PH -1
#endif
#ifndef REP_UPG
#define REP_UPG 1
#endif
#ifndef REP_PRO
#define REP_PRO 1
#endif
#ifndef REP_N1
#define REP_N1 1
#endif
#ifndef REP_OUT
#define REP_OUT 1
#endif
#ifndef REP_RT
#define REP_RT 1
#endif
#ifndef REP_ATT
#define REP_ATT 1
#endif
#ifndef REP_CHK
#define REP_CHK 1
#endif
#ifndef REP_POST
#define REP_POST 1
#endif
#ifndef REP_PREP
#define REP_PREP 1
#endif
#ifndef REP_INP
#define REP_INP 1
#endif
#ifndef REP_MOE
#define REP_MOE 1
#endif
#ifndef NO_MOE
#define NO_MOE 0
#endif
#define RUN(k) (lo <= (k) && (k) < hi)
#define EN(j) ((PHMASK >> (j)) & 1u)
#define SEAM(k) do { if (lo <= (k) && (k) + 1 < hi) xcd_barrier(bar); } while (0)
    unsigned long long pr_acc = 0, pr_t0 = 0;
#define PT0(j) do { if (PROBE_PH == (j)) pr_t0 = __builtin_amdgcn_s_memrealtime(); } while (0)
#define PT1(j) do { if (PROBE_PH == (j)) pr_acc += __builtin_amdgcn_s_memrealtime() - pr_t0; } while (0)
    PT0(11);
    if (EN(11) && RUN(0)) { for (int rep = 0; rep < REP_PRO; ++rep) phase_prologue(AL(), WL(), lds); }
    SEAM(0); PT1(11);
    for (int l = 0; l < DEPTH; ++l) {
        const int p0 = 1 + l * NPL; const bool need_ctx = l < DEPTH - 1; const int mrows = need_ctx ? MA : ML;
        if (lo >= p0 + NPL || hi <= p0) continue;
        PT0(0);
        if (EN(0) && RUN(p0 + 0)) { phase_norm1(AL(), WL(), LL(), l - 1, (l > 0) && !NO_MOE, true, MA); for (int rep = 1; rep < REP_N1; ++rep) phase_norm1(AL(), WL(), LL(), l - 1, false, true, MA); }
        SEAM(p0 + 0); PT1(0);
        PT0(1);
        if (EN(1) && RUN(p0 + 1)) { const WS W = WL(); pg8::DenseSched S; S.init(W.h(), W.wl(LL(), WL_IN), D, D, MA, DINP, G, (int)blockIdx.x); pg8::EpiBf16 E{W.proj(), DINP}; for (int rep = 0; rep < REP_INP; ++rep) pg8::gemm_phase(lds, S, E, D, D); }
        SEAM(p0 + 1); PT1(1);
        PT0(2);
        if (EN(2) && RUN(p0 + 2)) { for (int rep = 0; rep < REP_PREP; ++rep) phase_prep(AL(), WL(), LL(), lds); }
        SEAM(p0 + 2); PT1(2);
        PT0(3);
        if (EN(3) && RUN(p0 + 3)) { const WS W = WL(); for (int rep = 0; rep < REP_UPG; ++rep) {
            { pg8::DenseSched S; S.init(W.cqn(), W.wl(LL(), WL_UP), 384, 384, MA, 1792, G, (int)blockIdx.x); pg8::EpiBf16 E{W.qkvraw(), 1792}; pg8::gemm_phase(lds, S, E, 384, 384); }
            { pg8::DenseSched S; S.init(W.xconv(), W.wl(LL(), WL_MQK), 256, 256, MA, 512, G, (int)blockIdx.x); pg8::EpiBf16 E{W.mqk(), 512}; pg8::gemm_phase(lds, S, E, 256, 256); }
        } }
        SEAM(p0 + 3); PT1(3);
        PT0(4);
        if (EN(4) && RUN(p0 + 4)) { for (int rep = 0; rep < REP_POST; ++rep) phase_post(AL(), WL(), LL(), lds); }
        SEAM(p0 + 4); PT1(4);
        PT0(5);
        if (EN(5) && RUN(p0 + 5)) { { const WS W2 = WL(); phase_scan(W2, lds); for (int rep = 0; rep < REP_ATT; ++rep) phase_attn(W2, lds, need_ctx); } }
        SEAM(p0 + 5); PT1(5);
        PT0(6);
        if (EN(6) && RUN(p0 + 6)) { for (int rep = 0; rep < REP_CHK; ++rep) phase_chunkout(AL(), WL(), LL(), lds); }
        SEAM(p0 + 6); PT1(6);
        PT0(7);
        if (EN(7) && RUN(p0 + 7)) { const WS W = WL(); float* outp = AL()->out; pg8::DenseSched S; S.init(W.mix(), W.wl(LL(), WL_OUT), D, D, mrows, D, G, (int)blockIdx.x); pg8::EpiResid E{outp, W.xc(), W.mods() + (size_t)LL() * 3 * 6144 + 2048}; pg8::gemm_phase(lds, S, E, D, D);
            for (int rep = 1; rep < REP_OUT; ++rep) { pg8::EpiResid E0{outp, W.xc(), W.mods() + (size_t)LL() * 3 * 6144 + 2048, 0.f}; pg8::gemm_phase(lds, S, E0, D, D); } }
        SEAM(p0 + 7); PT1(7);
        PT0(8);
        if (!NO_MOE && EN(8) && RUN(p0 + 8)) { phase_router(AL(), WL(), LL(), mrows, lds); for (int rep = 1; rep < REP_RT; ++rep) phase_router(AL(), WL(), LL(), mrows, lds, true); }
        SEAM(p0 + 8); PT1(8);
        PT0(9);
        if (!NO_MOE && EN(9) && RUN(p0 + 9)) { const WS W = WL(); moe_tables(W, LL(), lds);
            pg8::MoeSched<true> S{W.h(), W.wgu(), D, D, (size_t)512 * D, W.pair(), (const volatile LAS int*)(lds + MISC_OFF + 64), (const volatile LAS int*)(lds + MISC_OFF + 256), 2, G, (int)blockIdx.x};
            pg8::EpiMoeUp E{W.act(), W.pw(), (const volatile LAS int*)(lds + MISC_OFF + 256)}; for (int rep = 0; rep < REP_MOE; ++rep) pg8::gemm_phase(lds, S, E, D, D); }
        SEAM(p0 + 9); PT1(9);
        PT0(10);
        if (!NO_MOE && EN(10) && RUN(p0 + 10)) { const WS W = WL(); moe_tables(W, LL(), lds);
            pg8::MoeSched<false> S{W.act(), W.wdn(), DE, DE, (size_t)D * DE, W.pair(), (const volatile LAS int*)(lds + MISC_OFF + 64), (const volatile LAS int*)(lds + MISC_OFF + 256), 4, G, (int)blockIdx.x};
            pg8::EpiMoeDown E{W.y(), W.pair(), (const volatile LAS int*)(lds + MISC_OFF + 256)}; for (int rep = 0; rep < REP_MOE; ++rep) pg8::gemm_phase(lds, S, E, DE, DE); }
        SEAM(p0 + 10); PT1(10);
    }
    if (NO_MOE && RUN(NPHASE - 1)) { KArgs aa = AL(); for (int i = blockIdx.x * 512 + tid; i < ML * D; i += G * 512) { const float xi = aa->in[I_X][i]; aa->out[i] = xi + 64.f * (aa->out[i] - xi); } }
    if (!NO_MOE && EN(12) && RUN(NPHASE - 1)) { phase_norm1(AL(), WL(), 0, DEPTH - 1, true, false, ML); }
    if (PROBE_PH >= 0 && blockIdx.x == 0) { const unsigned long long t0 = __builtin_amdgcn_s_memrealtime(); while (__builtin_amdgcn_s_memrealtime() - t0 < 4ull * pr_acc) __builtin_amdgcn_s_sleep(8); }
#undef RUN
#undef SEAM
}

extern "C" void kernel_launch(void* const* d_in, const int* in_sizes, int n_in, void* d_out, int out_size, void* d_ws, size_t ws_size, hipStream_t stream) {
    static int grid = 0;
    if (grid == 0) {
        if (n_in != 33 || out_size != ML * D || ws_size < WS_END) { fprintf(stderr, "kernel_launch: unexpected shapes (n_in %d out %d ws %zu need %zu)\n", n_in, out_size, ws_size, (size_t)WS_END); grid = -1; return; }
        int dev = 0, cus = 0, per_cu = 0;
        if (hipGetDevice(&dev) != hipSuccess || hipDeviceGetAttribute(&cus, hipDeviceAttributeMultiprocessorCount, dev) != hipSuccess) { grid = -1; return; }
        if (hipFuncSetAttribute((const void*)fwd_kernel, hipFuncAttributeMaxDynamicSharedMemorySize, LDS_BYTES) != hipSuccess) { fprintf(stderr, "kernel_launch: hipFuncSetAttribute failed\n"); grid = -1; return; }
        if (hipOccupancyMaxActiveBlocksPerMultiprocessor(&per_cu, (const void*)fwd_kernel, 512, LDS_BYTES) != hipSuccess || per_cu < 1) fprintf(stderr, "kernel_launch: occupancy query says %d\n", per_cu);
        (void)hipGetLastError();
        grid = cus < 256 ? cus : 256;
    }
    if (grid < 0) return;
    (void)hipMemsetAsync((char*)d_ws + WS_CTL, 0, CTL_BYTES, stream);
    Args a{};
    for (int i = 0; i < 33; ++i) a.in[i] = (const float*)d_in[i];
    a.out = (float*)d_out; a.ws = (unsigned char*)d_ws;
#if N_LAUNCH_MODE == 1
    a.ph_lo = 0; a.ph_hi = NPHASE;
    hipLaunchKernelGGL(fwd_kernel, dim3(grid), dim3(512), LDS_BYTES, stream, a);
#else
    for (int p = 0; p < NPHASE; ++p) { a.ph_lo = p; a.ph_hi = p + 1; hipLaunchKernelGGL(fwd_kernel, dim3(grid), dim3(512), LDS_BYTES, stream, a); }
#endif
}
```

```cpp
#include <hip/hip_runtime.h>
#include <cstdio>
#include <cstdint>

#ifndef N_LAUNCH_MODE
#define N_LAUNCH_MODE 1
#endif

#define LAS __attribute__((address_space(3)))
#define GAS __attribute__((address_space(1)))
typedef unsigned short bf16_t;
typedef short bf16x8 __attribute__((ext_vector_type(8)));
typedef short s16x4 __attribute__((ext_vector_type(4)));
typedef float f32x2 __attribute__((ext_vector_type(2)));
typedef float f32x4 __attribute__((ext_vector_type(4)));
typedef float f32x16 __attribute__((ext_vector_type(16)));
typedef unsigned u32x2 __attribute__((ext_vector_type(2)));
typedef unsigned u32x4 __attribute__((ext_vector_type(4)));
#define DI __device__ __forceinline__

constexpr int D = 1024, NB = 2, SEQ = 8192, DEPTH = 4, CTX = 256;
constexpr int ML = NB * SEQ, MC = NB * CTX, MA = ML + MC;
constexpr int DINP = 2048;
constexpr int C_CQ = 0, C_CKV = 256, C_KR = 384, C_MX = 416, C_MV = 672, C_MO = 928, C_MG = 1184, C_GQ = 1200, C_GK = 1328, C_GV = 1456, C_GR = 1712, C_GA = 1968;
constexpr int NH = 8, QK = 96, NKEY = SEQ + CTX, NTILE = NKEY / 64;
constexpr int NCH = 132;
constexpr int NEXP = 32, DE = 256, PAIRCAP = MA;
constexpr float EPS = 1e-6f;
constexpr float QSCALE = 0.10206207261596577f * 1.4426950408889634f;
constexpr int NPL = 11;
constexpr int NPHASE = 1 + DEPTH * NPL + 1;

constexpr size_t MiB = 1u << 20;
constexpr size_t WS_CTL = 0, CTL_BYTES = 1 * MiB;
constexpr size_t WS_MODS = 1 * MiB;
constexpr size_t WS_ROPE = WS_MODS + MiB / 2;
constexpr size_t WS_XC = WS_ROPE + 1 * MiB + MiB / 2;
constexpr size_t WS_WL = 5 * MiB;
constexpr size_t WL_STRIDE = 8 * MiB, WL_IN = 0, WL_UQ = 4 * MiB, WL_UKV = WL_UQ + 512 * 1024, WL_MQK = WL_UQ + 1536 * 1024, WL_OUT = 6 * MiB;
constexpr size_t WS_WGU = 37 * MiB;
constexpr size_t WS_WDN = 69 * MiB;
constexpr size_t WS_A = 85 * MiB;
constexpr size_t WS_B = 151 * MiB;
constexpr size_t WS_ACT = WS_B + 34 * MiB;
constexpr size_t WS_H = 209 * MiB;
constexpr size_t WS_CQ = 242 * MiB;
constexpr int CQ_LD = 768;
constexpr size_t WS_MQK = 267 * MiB;
constexpr size_t WS_Q = 284 * MiB;
constexpr size_t WS_K = 309 * MiB;
constexpr size_t WS_V = 334 * MiB;
constexpr size_t WS_GATES = 351 * MiB;
constexpr size_t WS_LOGA = 353 * MiB;
constexpr size_t WS_MU = 370 * MiB;
constexpr size_t WS_MN = 403 * MiB;
constexpr size_t WS_MS = 404 * MiB;
constexpr size_t WS_GU = 405 * MiB;
constexpr size_t WS_GD = 422 * MiB;
constexpr size_t WS_PAIR = 423 * MiB;
constexpr size_t WS_PW = 426 * MiB;
constexpr size_t WS_RTW = 429 * MiB;
constexpr size_t WS_XB = 430 * MiB;
constexpr size_t WS_END = 463 * MiB;
static_assert(WS_A + (size_t)MA * DINP * 2 <= WS_B && WS_B + (size_t)MA * 1792 * 2 <= WS_H && WS_ACT + (size_t)42240 * 256 * 2 <= WS_H && WS_B + (size_t)MA * 1024 * 2 <= WS_ACT, "ws map");
static_assert(WS_H + (size_t)MA * D * 2 <= WS_CQ && WS_CQ + (size_t)MA * CQ_LD * 2 <= WS_MQK && WS_MQK + (size_t)MA * 512 * 2 <= WS_Q, "ws map 2");
static_assert(WS_Q + (size_t)16 * 8448 * 96 * 2 <= WS_K && WS_K + (size_t)16 * 132 * 12288 <= WS_V && WS_V + (size_t)16 * 132 * 8192 <= WS_GATES && WS_GATES + (size_t)MA * 64 <= WS_LOGA, "ws map 3");
static_assert(WS_LOGA + (size_t)2 * MA * 512 <= WS_MU && WS_MU + (size_t)16 * 132 * 16384 <= WS_MN && WS_MN + (size_t)16 * 132 * 256 <= WS_MS && WS_GU + (size_t)16 * 132 * 8192 <= WS_GD && WS_GD + (size_t)16 * 132 * 128 <= WS_PAIR, "ws map 4");
static_assert(WS_PAIR + (size_t)32 * PAIRCAP * 4 <= WS_PW && WS_PW + (size_t)32 * PAIRCAP * 4 <= WS_RTW && WS_RTW + (size_t)4 * 36 * 1024 * 4 <= WS_END, "ws map 5");
constexpr int CW_BAR = 4096;
constexpr int CW_CNT = 16384;

constexpr int LDS_BYTES = 163840 - 1024;
constexpr int MISC_OFF = LDS_BYTES - 1024;
constexpr int WSCR = 19200;

struct Args { const float* in[33]; float* out; unsigned char* ws; int ph_lo, ph_hi; };
typedef const __attribute__((address_space(4))) Args* KArgs;

DI float bf2f(unsigned v) { return __uint_as_float(v << 16); }
DI unsigned f2bf(float f) { unsigned u = __float_as_uint(f); return (u + 0x7fffu + ((u >> 16) & 1u)) >> 16; }
DI unsigned pk2(float lo, float hi) { return f2bf(lo) | (f2bf(hi) << 16); }
typedef __bf16 bf16x2_t __attribute__((ext_vector_type(2)));
DI unsigned cvtpk(float lo, float hi) { f32x2 v = {lo, hi}; bf16x2_t b = __builtin_convertvector(v, bf16x2_t); return __builtin_bit_cast(unsigned, b); }
DI float sh_idx(float v, int src) { return __int_as_float(__builtin_amdgcn_ds_bpermute(src << 2, __float_as_int(v))); }
DI float sh_xor(float v, int m, int lane) { return sh_idx(v, lane ^ m); }
DI float wave_sum(float v, int lane) {
#pragma unroll
    for (int o = 1; o < 64; o <<= 1) v += sh_xor(v, o, lane);
    return v;
}
DI float wave_max(float v, int lane) {
#pragma unroll
    for (int o = 1; o < 64; o <<= 1) v = fmaxf(v, sh_xor(v, o, lane));
    return v;
}
DI float dpp_sum63(float v) {
#define DPP_ADD(ctrl, rmask) v += __int_as_float(__builtin_amdgcn_update_dpp(0, __float_as_int(v), ctrl, rmask, 0xF, false))
    DPP_ADD(0xB1, 0xF);
    DPP_ADD(0x4E, 0xF);
    DPP_ADD(0x141, 0xF);
    DPP_ADD(0x140, 0xF);
    DPP_ADD(0x142, 0xA);
    DPP_ADD(0x143, 0xC);
#undef DPP_ADD
    return v;
}
DI float siluf(float x) { return x / (1.f + __expf(-x)); }
DI float sigmoidf_(float x) { return 1.f / (1.f + __expf(-x)); }
DI float logsigmoidf_(float x) { return fminf(x, 0.f) - log1pf(__expf(-fabsf(x))); }
DI int crow(int r, int hi) { return (r & 3) + 8 * (r >> 2) + 4 * hi; }
#define LDS_WAIT() asm volatile("s_waitcnt lgkmcnt(0)" ::: "memory")
#define VM_WAIT() asm volatile("s_waitcnt vmcnt(0)" ::: "memory")
DI int tokrow(int b, int gc, int t) { return gc < 128 ? b * SEQ + gc * 64 + t : ML + b * CTX + (gc - 128) * 64 + t; }

#define XB_TMO      128
#define XB_XCNT(j)  (256  + 64 * (j))
#define XB_XSUB(j)  (1280 + 64 * (j))
#define XB_XGEN(j)  (2304 + 64 * (j))
#define XB_TOP      3328
#define XB_TOPGEN   3392
#define XCD_BAR_WORDS 3456
#define XB_SPIN_CAP (1u << 22)
DI unsigned xb_ld(unsigned* p)              { return __hip_atomic_load(p, __ATOMIC_RELAXED, __HIP_MEMORY_SCOPE_AGENT); }
DI unsigned xb_add(unsigned* p, unsigned v) { return __hip_atomic_fetch_add(p, v, __ATOMIC_RELAXED, __HIP_MEMORY_SCOPE_AGENT); }
DI unsigned xb_xcc_id() { return (unsigned)__builtin_amdgcn_s_getreg((3 << 11) | 20) & 0xFu; }
#define XB_SPIN(cond, bar) do { unsigned _sp = 0; while (cond) { __builtin_amdgcn_s_sleep(1); \
    if ((++_sp & 255u) == 0u) { if (xb_ld(&(bar)[XB_TMO])) break; if (_sp > XB_SPIN_CAP) { atomicAdd(&(bar)[XB_TMO], 1u); break; } } } } while (0)
struct XcdBarrier { unsigned* bar; unsigned x; volatile LAS unsigned* st; };
DI XcdBarrier xcd_barrier_post(unsigned* bar, volatile LAS unsigned* st) {
    XcdBarrier b; b.bar = bar; b.x = xb_xcc_id(); b.st = st;
    if (threadIdx.x == 0) (void)xb_add(&bar[XB_XCNT(b.x)], 1u);
    return b;
}
DI void xcd_barrier_complete(unsigned* bar, unsigned x, unsigned& nloc, unsigned& nx) {
    const unsigned G = gridDim.x * gridDim.y * gridDim.z;
    unsigned sum, cnt, mine, sp = 0u;
    for (;;) {
        sum = 0u; cnt = 0u; mine = 0u;
#pragma unroll
        for (unsigned j = 0; j < 16; ++j) { const unsigned c = xb_ld(&bar[XB_XCNT(j)]); sum += c; cnt += (c > 0u) ? 1u : 0u; mine = (j == x) ? c : mine; }
        if (sum == G) break;
        __builtin_amdgcn_s_sleep(1);
        if ((++sp & 255u) == 0u) { if (xb_ld(&bar[XB_TMO])) break; if (sp > XB_SPIN_CAP) { atomicAdd(&bar[XB_TMO], 1u); break; } }
    }
    nloc = mine > 0u ? mine : 1u; nx = cnt > 0u ? cnt : 1u;
}
DI void xcd_barrier(const XcdBarrier& b) {
    asm volatile("s_waitcnt vmcnt(0)" ::: "memory");
    __syncthreads();
    if (threadIdx.x == 0) {
        unsigned* bar = b.bar;
        __builtin_amdgcn_s_waitcnt(0);
        unsigned nloc = b.st[0], nx = b.st[1];
        if (nloc == 0u) { xcd_barrier_complete(bar, b.x, nloc, nx); b.st[0] = nloc; b.st[1] = nx; }
        const unsigned old = xb_add(&bar[XB_XSUB(b.x)], 1u);
        const unsigned gen = old / nloc;
        if (old + 1u == (gen + 1u) * nloc) {
            __builtin_amdgcn_fence(__ATOMIC_RELEASE, "agent");
            asm volatile("s_waitcnt vmcnt(0)" ::: "memory");
            const unsigned og = xb_add(&bar[XB_TOP], 1u);
            const unsigned tg = og / nx;
            if (og + 1u == (tg + 1u) * nx) xb_add(&bar[XB_TOPGEN], 1u);
            else XB_SPIN(xb_ld(&bar[XB_TOPGEN]) == tg, bar);
            __builtin_amdgcn_fence(__ATOMIC_ACQUIRE, "agent");
            xb_add(&bar[XB_XGEN(b.x)], 1u);
            asm volatile("s_waitcnt vmcnt(0)" ::: "memory");
        } else {
            XB_SPIN(xb_ld(&bar[XB_XGEN(b.x)]) == gen, bar);
            __builtin_amdgcn_fence(__ATOMIC_ACQUIRE, "agent");
            asm volatile("s_waitcnt vmcnt(0)" ::: "memory");
        }
    }
    __syncthreads();
}

DI void unpack8(const u32x4 v, float (&f)[8]) {
    f[0] = bf2f(v.x & 0xffffu); f[1] = bf2f(v.x >> 16); f[2] = bf2f(v.y & 0xffffu); f[3] = bf2f(v.y >> 16);
    f[4] = bf2f(v.z & 0xffffu); f[5] = bf2f(v.z >> 16); f[6] = bf2f(v.w & 0xffffu); f[7] = bf2f(v.w >> 16);
}
DI u32x4 pack8(const float (&f)[8]) { u32x4 o; o.x = pk2(f[0], f[1]); o.y = pk2(f[2], f[3]); o.z = pk2(f[4], f[5]); o.w = pk2(f[6], f[7]); return o; }


namespace pg8 {
constexpr int BM = 256, BK = 64, HALF = 128, HTB = HALF * BK * 2, NXCD = 8, WGM = 8;
DI int lds_byte(int r, int c) { const int st = (r >> 4) * 2 + (c >> 5), rr = r & 15, cc = c & 31, ob = rr * 64 + cc * 2; return st * 1024 + (ob ^ (((ob >> 9) & 1) << 5)); }
DI void stage_rc(int b, int& R, int& C) { const int st = b / 1024, sb = b % 1024, swz = sb ^ (((sb >> 9) & 1) << 5); R = (st >> 1) * 16 + swz / 64; C = (st & 1) * 32 + (swz % 64) / 2; }
DI int perm32(int rho) { const int n = rho >> 4, i = rho & 15; return 8 * (i >> 2) + 4 * n + (i & 3); }
struct Unit { int pm, pn, e, t; };
DI unsigned cvt_pk_bf16(float lo, float hi) { unsigned r; asm volatile("v_cvt_pk_bf16_f32 %0, %1, %2" : "=v"(r) : "v"(lo), "v"(hi)); return r; }

struct DenseSched {
    static constexpr bool PER_UNIT_A = false;
    const bf16_t* A; const bf16_t* Bt; int lda, ldb; int nM, nN, nwg, G, c;
    DI void init(const bf16_t* A_, const bf16_t* Bt_, int lda_, int ldb_, int M, int N, int G_, int c_) { A = A_; Bt = Bt_; lda = lda_; ldb = ldb_; nM = M / BM; nN = N / BM; nwg = nM * nN; G = G_; c = c_; }
    DI bool next(int i, Unit& u) const {
        const long L = (long)i * G + c; if (L >= nwg) return false;
        int wgid = (int)L; { const int q = nwg / NXCD, r = nwg % NXCD, xcd = wgid % NXCD, off = wgid / NXCD; wgid = (xcd < r ? xcd * (q + 1) : r * (q + 1) + (xcd - r) * q) + off; }
        const int nig = WGM * nN, gid = wgid / nig, fm = gid * WGM, gsz = (nM - fm) < WGM ? (nM - fm) : WGM;
        u.pm = fm + ((wgid % nig) % gsz); u.pn = (wgid % nig) / gsz; u.e = 0; u.t = 0; return true;
    }
    DI const char* abase(const Unit& u) const { return (const char*)A + (size_t)u.pm * BM * lda * 2; }
    DI const char* bbase(const Unit& u) const { return (const char*)Bt + (size_t)u.pn * BM * ldb * 2; }
    DI void avoff(const Unit&, const int (&R)[2], const int (&C)[2], unsigned (&va)[2][2]) const {
#pragma unroll
        for (int h = 0; h < 2; ++h)
#pragma unroll
            for (int i = 0; i < 2; ++i) va[h][i] = (unsigned)((h * HALF + R[i]) * lda + C[i]) * 2u;
    }
};
struct TriSched {
    static constexpr bool PER_UNIT_A = false;
    const bf16_t* A; int lda; const bf16_t* Bt0; int nM, G, c;
    DI bool next(int i, Unit& u) const {
        const int L = i * G + c, n0 = nM * 3, n1 = n0 + nM * 4, n2 = n1 + nM * 2; if (L >= n2) return false;
        const int seg = L < n0 ? 0 : (L < n1 ? 1 : 2), Ls = L - (seg == 0 ? 0 : (seg == 1 ? n0 : n1));
        u.e = seg; u.pm = Ls % nM; u.pn = Ls / nM; u.t = 0; return true;
    }
    DI const char* abase(const Unit& u) const { return (const char*)A + ((size_t)u.pm * BM * lda + (size_t)u.e * 256) * 2; }
    DI const char* bbase(const Unit& u) const { return (const char*)Bt0 + (size_t)(u.e + (u.e >> 1)) * (512 * 1024) + (size_t)u.pn * BM * 256 * 2; }
    DI void avoff(const Unit&, const int (&R)[2], const int (&C)[2], unsigned (&va)[2][2]) const {
#pragma unroll
        for (int h = 0; h < 2; ++h)
#pragma unroll
            for (int i = 0; i < 2; ++i) va[h][i] = (unsigned)((h * HALF + R[i]) * lda + C[i]) * 2u;
    }
};
template <bool GATHER> struct MoeSched {
    static constexpr bool PER_UNIT_A = GATHER;
    const bf16_t* A; const bf16_t* Bt; int lda, ldb; size_t bexp;
    const int* pair; const volatile LAS int* toff; const volatile LAS int* cnt; int NPN, G, c;
    DI bool next(int i, Unit& u) const {
        const int T = __builtin_amdgcn_readfirstlane(toff[NEXP]); const int L = i * G + c; if (L >= T * NPN) return false;
        const int ti = L / NPN; u.pn = L % NPN; int e = 0;
#pragma unroll 1
        for (int j = 1; j < NEXP; ++j) e = (__builtin_amdgcn_readfirstlane(toff[j]) <= ti) ? j : e;
        u.pm = ti; u.e = e; u.t = ti - __builtin_amdgcn_readfirstlane(toff[e]); return true;
    }
    DI const char* abase(const Unit& u) const { return GATHER ? (const char*)A : (const char*)A + (size_t)u.pm * BM * lda * 2; }
    DI const char* bbase(const Unit& u) const { return (const char*)Bt + ((size_t)u.e * bexp + (size_t)u.pn * BM * ldb) * 2; }
    DI void avoff(const Unit& u, const int (&R)[2], const int (&C)[2], unsigned (&va)[2][2]) const {
        const int n = __builtin_amdgcn_readfirstlane(cnt[u.e]);
#pragma unroll
        for (int h = 0; h < 2; ++h)
#pragma unroll
            for (int i = 0; i < 2; ++i) {
                if (GATHER) { const int slot = u.t * BM + h * HALF + R[i]; const int tok = (slot < n) ? (pair[(size_t)u.e * PAIRCAP + slot] >> 1) : 0; va[h][i] = (unsigned)(tok * lda + C[i]) * 2u; }
                else va[h][i] = (unsigned)((h * HALF + R[i]) * lda + C[i]) * 2u;
            }
    }
};

template <class Epi, class Sched>
DI void gemm_phase(LAS unsigned char* lds, const Sched& S, const Epi& E, const int K, const int ldb) {
    int tid_ = threadIdx.x; asm volatile("" : "+v"(tid_));
    const int tid = tid_, wid = __builtin_amdgcn_readfirstlane(tid >> 6), lane = tid & 63, wr = wid >> 2, wc = wid & 3, fr = lane & 15, fq = lane >> 4;
    int nt = K / BK; asm volatile("" : "+s"(nt));
    int Rr[2], Cc[2]; unsigned vb[2];
#pragma unroll
    for (int i = 0; i < 2; ++i) { stage_rc(tid * 16 + i * 8192, Rr[i], Cc[i]); const int Rb = (Rr[i] & ~31) + perm32(Rr[i] & 31); vb[i] = (unsigned)(Rb * ldb + Cc[i]) * 2u; }
    const size_t kstep = (size_t)(BK * 2);
    const size_t hstepB = (size_t)HALF * ldb * 2;
    const unsigned ldsw = (unsigned)wid * 1024u;
    const int aoff = lds_byte(wr * 64 + fr, fq * 8), boff = lds_byte(wc * 32 + fr, fq * 8);
#define PG8_SA(b, h) (((b) * 2 + (h)) * HTB)
#define PG8_SB(b, h) ((4 + (b) * 2 + (h)) * HTB)
#define PG8_STAGE_A(b, h, gbase, VA) do { _Pragma("unroll") for (int _i = 0; _i < 2; ++_i) \
        __builtin_amdgcn_global_load_lds((const unsigned*)((const char*)(gbase) + (VA)[h][_i]), (LAS unsigned*)(lds + PG8_SA(b, h) + ldsw + _i * 8192), 16, 0, 0); } while (0)
#define PG8_STAGE_B(b, h, gbase) do { _Pragma("unroll") for (int _i = 0; _i < 2; ++_i) \
        __builtin_amdgcn_global_load_lds((const unsigned*)((const char*)(gbase) + (h) * hstepB + vb[_i]), (LAS unsigned*)(lds + PG8_SB(b, h) + ldsw + _i * 8192), 16, 0, 0); } while (0)
#define PG8_LDA(dst, b, h) do { _Pragma("unroll") for (int m = 0; m < 4; ++m) _Pragma("unroll") for (int k = 0; k < 2; ++k) dst[m][k] = *(const LAS bf16x8*)(lds + PG8_SA(b, h) + aoff + m * 2048 + k * 1024); } while (0)
#define PG8_LDB(dst, b, h) do { _Pragma("unroll") for (int n = 0; n < 2; ++n) _Pragma("unroll") for (int k = 0; k < 2; ++k) dst[n][k] = *(const LAS bf16x8*)(lds + PG8_SB(b, h) + boff + n * 2048 + k * 1024); } while (0)
#define PG8_MMA(ai, bj, At, Bt) do { __builtin_amdgcn_s_setprio(1); _Pragma("unroll") for (int m = 0; m < 4; ++m) _Pragma("unroll") for (int n = 0; n < 2; ++n) _Pragma("unroll") for (int k = 0; k < 2; ++k) \
        acc[ai][bj][m][n] = __builtin_amdgcn_mfma_f32_16x16x32_bf16(Bt[n][k], At[m][k], acc[ai][bj][m][n], 0, 0, 0); __builtin_amdgcn_s_setprio(0); } while (0)
#define PG8_WAIT_V(n) asm volatile("s_waitcnt vmcnt(" #n ")" ::: "memory")
#define PG8_WAIT_L(n) asm volatile("s_waitcnt lgkmcnt(" #n ")" ::: "memory")
#define PG8_BAR __builtin_amdgcn_s_barrier()
#define PG8_SCHED __builtin_amdgcn_sched_barrier(0)
    Unit cur, nxt; int ui = 0;
    if (!S.next(0, cur)) return;
    f32x4 acc[2][2][4][2];
#pragma unroll
    for (int a = 0; a < 2; ++a)
#pragma unroll
        for (int b = 0; b < 2; ++b)
#pragma unroll
            for (int m = 0; m < 4; ++m)
#pragma unroll
                for (int n = 0; n < 2; ++n) acc[a][b][m][n] = (f32x4){0.f, 0.f, 0.f, 0.f};
    bf16x8 At[4][2], B0[2][2], B1[2][2];
    unsigned va[2][2];
    const char* cA = S.abase(cur); const char* cB = S.bbase(cur);
    S.avoff(cur, Rr, Cc, va);
    PG8_STAGE_B(0, 0, cB); PG8_STAGE_B(0, 1, cB); PG8_STAGE_A(0, 0, cA, va); PG8_STAGE_A(0, 1, cA, va);
    if (wr == 1) PG8_BAR;
    PG8_WAIT_V(2); PG8_BAR;
    PG8_STAGE_B(1, 0, cB + kstep); PG8_STAGE_A(1, 0, cA + kstep, va); PG8_STAGE_B(1, 1, cB + kstep);
    PG8_WAIT_V(6); PG8_BAR;
    for (;;) {
        const bool has_next = S.next(ui + 1, nxt);
        const char* nA = cA; const char* nB = cB;
        if (has_next) { nA = S.abase(nxt); nB = S.bbase(nxt); }
        for (int t = 0; t < nt; t += 2) {
            const bool last = (t == nt - 2);
            const char* a1 = cA + (size_t)(t + 1) * kstep;
            const char* a2 = last ? nA : cA + (size_t)(t + 2) * kstep; const char* b2 = last ? nB : cB + (size_t)(t + 2) * kstep;
            const char* a3 = a2 + kstep; const char* b3 = b2 + kstep;
            PG8_LDB(B0, 0, 0); PG8_LDB(B1, 0, 1); PG8_SCHED; PG8_LDA(At, 0, 0); PG8_STAGE_A(1, 1, a1, va);
            if (Sched::PER_UNIT_A && last && has_next) S.avoff(nxt, Rr, Cc, va);
            PG8_WAIT_V(8); PG8_WAIT_L(0); PG8_BAR; PG8_MMA(0, 0, At, B0); PG8_MMA(0, 1, At, B1); PG8_BAR; PG8_SCHED;
            PG8_LDA(At, 0, 1); PG8_STAGE_B(0, 0, b2); PG8_STAGE_B(0, 1, b2); PG8_STAGE_A(0, 0, a2, va);
            PG8_WAIT_V(8); PG8_WAIT_L(0); PG8_BAR; PG8_MMA(1, 0, At, B0); PG8_MMA(1, 1, At, B1); PG8_BAR; PG8_SCHED;
            PG8_LDB(B0, 1, 0); PG8_LDB(B1, 1, 1); PG8_SCHED; PG8_LDA(At, 1, 0); PG8_STAGE_A(0, 1, a2, va);
            PG8_WAIT_V(8); PG8_WAIT_L(0); PG8_BAR; PG8_MMA(0, 0, At, B0); PG8_MMA(0, 1, At, B1); PG8_BAR; PG8_SCHED;
            PG8_LDA(At, 1, 1); PG8_STAGE_B(1, 0, b3); PG8_STAGE_B(1, 1, b3); PG8_STAGE_A(1, 0, a3, va);
            PG8_WAIT_V(8); PG8_WAIT_L(0); PG8_BAR; PG8_MMA(1, 0, At, B0); PG8_MMA(1, 1, At, B1); PG8_BAR; PG8_SCHED;
        }
        if (wr == 0) PG8_BAR;
        E(acc, cur, wr, wc, fr, fq);
        if (!has_next) break;
#pragma unroll
        for (int a = 0; a < 2; ++a)
#pragma unroll
            for (int b = 0; b < 2; ++b)
#pragma unroll
                for (int m = 0; m < 4; ++m)
#pragma unroll
                    for (int n = 0; n < 2; ++n) acc[a][b][m][n] = (f32x4){0.f, 0.f, 0.f, 0.f};
        cur = nxt; cA = nA; cB = nB; ++ui;
        if (wr == 1) PG8_BAR;
    }
    PG8_WAIT_V(0);
    PG8_BAR;
#undef PG8_SA
#undef PG8_SB
#undef PG8_STAGE_A
#undef PG8_STAGE_B
#undef PG8_LDA
#undef PG8_LDB
#undef PG8_MMA
#undef PG8_WAIT_V
#undef PG8_WAIT_L
#undef PG8_BAR
#undef PG8_SCHED
}

struct EpiBf16 {
    bf16_t* O; int ldc;
    DI void operator()(const f32x4 (&acc)[2][2][4][2], const Unit& u, int wr, int wc, int fr, int fq) const {
        asm volatile("" : "+v"(fr), "+v"(fq));
        const int row0 = u.pm * BM + wr * 64 + fr, col0 = u.pn * BM + wc * 32 + 8 * fq;
#pragma unroll
        for (int ai = 0; ai < 2; ++ai)
#pragma unroll
            for (int m = 0; m < 4; ++m) { bf16_t* rowp = O + (size_t)(row0 + ai * HALF + m * 16) * ldc + col0;
#pragma unroll
                for (int bj = 0; bj < 2; ++bj) { const f32x4 v0 = acc[ai][bj][m][0], v1 = acc[ai][bj][m][1];
                    u32x4 w; w.x = cvt_pk_bf16(v0[0], v0[1]); w.y = cvt_pk_bf16(v0[2], v0[3]); w.z = cvt_pk_bf16(v1[0], v1[1]); w.w = cvt_pk_bf16(v1[2], v1[3]);
                    *(u32x4*)(rowp + bj * HALF) = w; } }
    }
};
struct EpiBf16Seg {
    bf16_t* O01; long o2off;
    DI void operator()(const f32x4 (&acc)[2][2][4][2], const Unit& u, int wr, int wc, int fr, int fq) const {
        asm volatile("" : "+v"(fr), "+v"(fq));
        bf16_t* O = O01 + (long)(u.e & 1) * 768 + (long)(u.e >> 1) * o2off; const int ldc = 1792 - (u.e >> 1) * 1280;
        const int row0 = u.pm * BM + wr * 64 + fr, col0 = u.pn * BM + wc * 32 + 8 * fq;
#pragma unroll
        for (int ai = 0; ai < 2; ++ai)
#pragma unroll
            for (int m = 0; m < 4; ++m) { bf16_t* rowp = O + (size_t)(row0 + ai * HALF + m * 16) * ldc + col0;
#pragma unroll
                for (int bj = 0; bj < 2; ++bj) { const f32x4 v0 = acc[ai][bj][m][0], v1 = acc[ai][bj][m][1];
                    u32x4 w; w.x = cvt_pk_bf16(v0[0], v0[1]); w.y = cvt_pk_bf16(v0[2], v0[3]); w.z = cvt_pk_bf16(v1[0], v1[1]); w.w = cvt_pk_bf16(v1[2], v1[3]);
                    *(u32x4*)(rowp + bj * HALF) = w; } }
    }
};
struct EpiResid {
    bf16_t* xb; const float* gate; float gs = 1.f;
    DI void operator()(const f32x4 (&acc)[2][2][4][2], const Unit& u, int wr, int wc, int fr, int fq) const {
        asm volatile("" : "+v"(fr), "+v"(fq));
        const int rt = u.pm * BM; const int vec = rt < SEQ ? 0 : (rt < ML ? 1 : 2);
        const int row0 = rt + wr * 64 + fr, col0 = u.pn * BM + wc * 32 + 8 * fq;
        const float* g = gate + vec * 6144 + col0;
        f32x4 gv[2][2];
#pragma unroll
        for (int bj = 0; bj < 2; ++bj)
#pragma unroll
            for (int n = 0; n < 2; ++n) gv[bj][n] = *(const f32x4*)(g + bj * HALF + 4 * n) * gs;
#pragma unroll
        for (int ai = 0; ai < 2; ++ai)
#pragma unroll
            for (int m = 0; m < 4; ++m) { bf16_t* rowp = xb + (size_t)(row0 + ai * HALF + m * 16) * D + col0;
#pragma unroll
                for (int bj = 0; bj < 2; ++bj) { u32x4* p = (u32x4*)(rowp + bj * HALF); float f[8]; unpack8(*p, f);
#pragma unroll
                    for (int n = 0; n < 2; ++n)
#pragma unroll
                        for (int j = 0; j < 4; ++j) f[4 * n + j] += gv[bj][n][j] * acc[ai][bj][m][n][j];
                    *p = pack8(f); } }
    }
};
struct EpiMoeUp {
    bf16_t* ACT; const float* pw; const volatile LAS int* cnt;
    DI void operator()(const f32x4 (&acc)[2][2][4][2], const Unit& u, int wr, int wc, int fr, int fq) const {
        asm volatile("" : "+v"(fr), "+v"(fq));
        const int n_e = __builtin_amdgcn_readfirstlane(cnt[u.e]); const int col0 = u.pn * 128 + wc * 32 + 8 * fq;
#pragma unroll
        for (int ai = 0; ai < 2; ++ai)
#pragma unroll
            for (int m = 0; m < 4; ++m) { const int rt = wr * 64 + fr + ai * HALF + m * 16; const int slot = u.t * BM + rt;
                const float w = slot < n_e ? pw[(size_t)u.e * PAIRCAP + slot] : 0.f;
                float a[8];
#pragma unroll
                for (int n = 0; n < 2; ++n)
#pragma unroll
                    for (int j = 0; j < 4; ++j) { const float g = acc[ai][0][m][n][j], up = acc[ai][1][m][n][j]; a[n * 4 + j] = siluf(g) * up * w; }
                u32x4 o; o.x = cvt_pk_bf16(a[0], a[1]); o.y = cvt_pk_bf16(a[2], a[3]); o.z = cvt_pk_bf16(a[4], a[5]); o.w = cvt_pk_bf16(a[6], a[7]);
                *(u32x4*)(ACT + ((size_t)u.pm * BM + rt) * DE + col0) = o; }
    }
};
struct EpiMoeDown {
    bf16_t* Y; const int* pair; const volatile LAS int* cnt;
    DI void operator()(const f32x4 (&acc)[2][2][4][2], const Unit& u, int wr, int wc, int fr, int fq) const {
        asm volatile("" : "+v"(fr), "+v"(fq));
        const int n_e = __builtin_amdgcn_readfirstlane(cnt[u.e]); const int col0 = u.pn * BM + wc * 32 + 8 * fq;
#pragma unroll
        for (int ai = 0; ai < 2; ++ai)
#pragma unroll
            for (int m = 0; m < 4; ++m) { const int rt = wr * 64 + fr + ai * HALF + m * 16; const int slot = u.t * BM + rt;
                if (slot < n_e) { const int pr = pair[(size_t)u.e * PAIRCAP + slot]; bf16_t* rowp = Y + (size_t)pr * D + col0;
#pragma unroll
                    for (int bj = 0; bj < 2; ++bj) { const f32x4 v0 = acc[ai][bj][m][0], v1 = acc[ai][bj][m][1];
                        u32x4 w; w.x = cvt_pk_bf16(v0[0], v0[1]); w.y = cvt_pk_bf16(v0[2], v0[3]); w.z = cvt_pk_bf16(v1[0], v1[1]); w.w = cvt_pk_bf16(v1[2], v1[3]);
                        *(u32x4*)(rowp + bj * HALF) = w; } } }
    }
};
}

template <int KS> DI void wmma32(f32x16& acc, const LAS bf16_t* As, int lda, const LAS bf16_t* Bs, int ldb, int r32, int hi) {
#pragma unroll
    for (int ks = 0; ks < KS; ++ks) {
        const bf16x8 a = *(const LAS bf16x8*)(As + r32 * lda + ks * 16 + hi * 8);
        const bf16x8 b = *(const LAS bf16x8*)(Bs + r32 * ldb + ks * 16 + hi * 8);
        acc = __builtin_amdgcn_mfma_f32_32x32x16_bf16(a, b, acc, 0, 0, 0);
    }
}
DI float scan_incl(float x, int lane, bool suffix) {
#pragma unroll
    for (int off = 1; off < 64; off <<= 1) { const float v = sh_idx(x, suffix ? ((lane + off) & 63) : ((lane - off) & 63)); const bool ok = suffix ? (lane + off < 64) : (lane >= off); x += ok ? v : 0.f; }
    return x;
}
DI float scan_max(float x, int lane, bool suffix) {
#pragma unroll
    for (int off = 1; off < 64; off <<= 1) { const float v = sh_idx(x, suffix ? ((lane + off) & 63) : ((lane - off) & 63)); const bool ok = suffix ? (lane + off < 64) : (lane >= off); x = ok ? fmaxf(x, v) : x; }
    return x;
}
struct WS {
    unsigned char* ws;
    DI unsigned* ctl() const { return (unsigned*)(ws + WS_CTL); }
    DI float* mods() const { return (float*)(ws + WS_MODS); }
    DI float* rope() const { return (float*)(ws + WS_ROPE); }
    DI float* xc() const { return (float*)(ws + WS_XC); }
    DI bf16_t* wl(int l, size_t off) const { return (bf16_t*)(ws + WS_WL + (size_t)l * WL_STRIDE + off); }
    DI bf16_t* wgu() const { return (bf16_t*)(ws + WS_WGU); }
    DI bf16_t* wdn() const { return (bf16_t*)(ws + WS_WDN); }
    DI bf16_t* proj() const { return (bf16_t*)(ws + WS_A); }
    DI bf16_t* y() const { return (bf16_t*)(ws + WS_A); }
    DI bf16_t* qkvraw() const { return (bf16_t*)(ws + WS_B); }
    DI bf16_t* mix() const { return (bf16_t*)(ws + WS_B); }
    DI bf16_t* act() const { return (bf16_t*)(ws + WS_ACT); }
    DI bf16_t* h() const { return (bf16_t*)(ws + WS_H); }
    DI bf16_t* cqn() const { return (bf16_t*)(ws + WS_CQ); }
    DI bf16_t* xconv() const { return (bf16_t*)(ws + WS_CQ) + 512; }
    DI bf16_t* mqk() const { return (bf16_t*)(ws + WS_MQK); }
    DI bf16_t* q() const { return (bf16_t*)(ws + WS_Q); }
    DI bf16_t* k() const { return (bf16_t*)(ws + WS_K); }
    DI bf16_t* v() const { return (bf16_t*)(ws + WS_V); }
    DI float* gates() const { return (float*)(ws + WS_GATES); }
    DI float* loga() const { return (float*)(ws + WS_LOGA); }
    DI float* mu() const { return (float*)(ws + WS_MU); }
    DI float* mn() const { return (float*)(ws + WS_MN); }
    DI float* ms() const { return (float*)(ws + WS_MS); }
    DI float* gu() const { return (float*)(ws + WS_GU); }
    DI float* gd() const { return (float*)(ws + WS_GD); }
    DI int* pair() const { return (int*)(ws + WS_PAIR); }
    DI float* pw() const { return (float*)(ws + WS_PW); }
    DI float* rtw() const { return (float*)(ws + WS_RTW); }
    DI bf16_t* xb() const { return (bf16_t*)(ws + WS_XB); }
};
enum { I_X = 0, I_C, I_CTX, I_CCTX, I_WMOD, I_BMOD, I_N1W, I_WIN, I_QAN, I_WUQ, I_KVAN, I_WUKV, I_QNW, I_KNW, I_MCW, I_MCB, I_MWQ, I_MWK, I_MGB, I_MNW, I_MSK,
       I_GWA, I_GBA, I_GNW, I_WOUT, I_N2W, I_WGRP, I_BGRP, I_WER, I_BER, I_WG, I_WU, I_WD };

DI void tr_item(const float* W, int N, int nvalid, bf16_t* WT, int ldd, int k0, int n0, int drow0, int dcol0, LAS float* scr, int lane) {
    f32x4 tv[8];
#pragma unroll
    for (int i = 0; i < 8; ++i) { const int kk = 8 * i + (lane >> 3), n = n0 + (lane & 7) * 4; tv[i] = (n < nvalid) ? *(const f32x4*)(W + (size_t)(k0 + kk) * N + n) : (f32x4){0.f, 0.f, 0.f, 0.f}; }
#pragma unroll
    for (int i = 0; i < 8; ++i) { const int kk = 8 * i + (lane >> 3), c = (lane & 7) * 4; scr[kk * 33 + c] = tv[i][0]; scr[kk * 33 + c + 1] = tv[i][1]; scr[kk * 33 + c + 2] = tv[i][2]; scr[kk * 33 + c + 3] = tv[i][3]; }
    LDS_WAIT(); asm volatile("" ::: "memory");
    const int c = lane & 7;
#pragma unroll
    for (int j = 0; j < 4; ++j) { const int n = (lane >> 3) + 8 * j; const LAS float* s = scr + (8 * c) * 33 + n;
        u32x4 o; o.x = pk2(s[0 * 33], s[1 * 33]); o.y = pk2(s[2 * 33], s[3 * 33]); o.z = pk2(s[4 * 33], s[5 * 33]); o.w = pk2(s[6 * 33], s[7 * 33]);
        *(u32x4*)(WT + (size_t)(drow0 + n) * ldd + dcol0 + k0 + 8 * c) = o; }
    LDS_WAIT(); asm volatile("" ::: "memory");
}

DI void phase_prologue(KArgs a, const WS& W, LAS unsigned char* lds) {
    int tid_ = threadIdx.x; asm volatile("" : "+v"(tid_)); const int tid = tid_, lane = tid & 63, wid = __builtin_amdgcn_readfirstlane(tid >> 6);
    const int G = gridDim.x, gw = blockIdx.x * 8 + wid, NGW = G * 8, gt = blockIdx.x * 512 + tid, NGT = G * 512;
    LAS float* scr = (LAS float*)(lds + wid * WSCR);
    constexpr int IT_IN = 16 * 64, IT_UQ = 4 * 24, IT_UKV = 2 * 32, IT_OUT = 16 * 32, IT_L = IT_IN + IT_UQ + IT_UKV + IT_OUT;
    for (int it = gw; it < DEPTH * IT_L; it += NGW) {
        const int l = it / IT_L; int r = it % IT_L;
        if (r < IT_IN) { const int kb = r / 64, nb = r % 64; tr_item(a->in[I_WIN] + (size_t)l * D * 2000, 2000, 2000, W.wl(l, WL_IN), 1024, 64 * kb, 32 * nb, 32 * nb, 0, scr, lane); continue; } r -= IT_IN;
        if (r < IT_UQ) { const int kb = r / 24, nb = r % 24; tr_item(a->in[I_WUQ] + (size_t)l * 256 * 768, 768, 768, W.wl(l, WL_UQ), 256, 64 * kb, 32 * nb, 32 * nb, 0, scr, lane); continue; } r -= IT_UQ;
        if (r < IT_UKV) { const int kb = r / 32, nb = r % 32; tr_item(a->in[I_WUKV] + (size_t)l * 128 * 1024, 1024, 1024, W.wl(l, WL_UKV), 256, 64 * kb, 32 * nb, 32 * nb, 0, scr, lane); continue; } r -= IT_UKV;
        { const int kb = r / 32, nb = r % 32; tr_item(a->in[I_WOUT] + (size_t)l * D * D, 1024, 1024, W.wl(l, WL_OUT), 1024, 64 * kb, 32 * nb, 32 * nb, 0, scr, lane); }
    }
    for (int i = gt; i < DEPTH * 1024 * 16; i += NGT) { const int l = i / (1024 * 16), r = i % (1024 * 16), row = r / 16, c = r % 16; *(u32x4*)(W.wl(l, WL_UKV) + (size_t)row * 256 + 128 + c * 8) = (u32x4){0u, 0u, 0u, 0u}; }
    for (int i = gt; i < DEPTH * 512 * 256; i += NGT) {
        const int l = i / (512 * 256), r = i % (512 * 256), n = r / 256, kc = r % 256, hs = (n & 255) >> 6, e = n & 63;
        float v = 0.f;
        if ((kc >> 6) == hs) { const float* src = (n < 256 ? a->in[I_MWQ] : a->in[I_MWK]) + (size_t)l * 4 * 64 * 64; v = src[(hs * 64 + (kc & 63)) * 64 + e]; if (n < 256) v *= 0.125f; }
        W.wl(l, WL_MQK)[r] = (bf16_t)f2bf(v);
    }
    for (int i = gt; i < DEPTH * 36 * 1024; i += NGT) { const int l = i / (36 * 1024), r = i % (36 * 1024), e = r >> 10, k = r & 1023;
        W.rtw()[i] = e < 4 ? a->in[I_WGRP][(size_t)l * D * 4 + k * 4 + e] : a->in[I_WER][(size_t)l * D * 32 + k * 32 + (e - 4)]; }
    for (int i = gt; i < SEQ * 16; i += NGT) {
        const int t = i >> 4, p = i & 15; const float inv = powf(10000.f, -(float)(p & 7) / 8.f);
        const float ang = (float)(p < 8 ? (t >> 6) : (t & 63)) * inv;
        W.rope()[i] = cosf(ang); W.rope()[SEQ * 16 + i] = sinf(ang);
    }
    for (int i = gt; i < MA * D / 4; i += NGT) { const f32x4 v = i < ML * D / 4 ? ((const f32x4*)a->in[I_X])[i] : ((const f32x4*)a->in[I_CTX])[i - ML * D / 4];
        u32x2 p; p.x = pk2(v[0], v[1]); p.y = pk2(v[2], v[3]); ((u32x2*)W.xb())[i] = p; }
    {
        LAS float* sv = (LAS float*)lds;
        LAS float* red = (LAS float*)(lds + 12288);
        __syncthreads();
        for (int i = tid; i < 3 * 1024; i += 512) { const int vsel = i >> 10, k = i & 1023; const float c = vsel < 2 ? a->in[I_C][vsel * 1024 + k] : a->in[I_CCTX][k]; sv[i] = siluf(c); }
        __syncthreads();
        for (int it = blockIdx.x; it < DEPTH * 48; it += G) {
            const int l = it / 48, n0 = (it % 48) * 128, col = tid & 127, kg = tid >> 7;
            const float* wm = a->in[I_WMOD] + (size_t)l * D * 6144 + n0 + col;
            float s0 = 0.f, s1 = 0.f, s2 = 0.f;
#pragma unroll 8
            for (int k = kg * 256; k < kg * 256 + 256; ++k) { const float w = wm[(size_t)k * 6144]; s0 += sv[k] * w; s1 += sv[1024 + k] * w; s2 += sv[2048 + k] * w; }
            red[(kg * 3 + 0) * 128 + col] = s0; red[(kg * 3 + 1) * 128 + col] = s1; red[(kg * 3 + 2) * 128 + col] = s2;
            __syncthreads();
            if (tid < 384) { const int vsel = tid >> 7, c = tid & 127; const float s = red[(0 * 3 + vsel) * 128 + c] + red[(1 * 3 + vsel) * 128 + c] + red[(2 * 3 + vsel) * 128 + c] + red[(3 * 3 + vsel) * 128 + c];
                W.mods()[(size_t)(l * 3 + vsel) * 6144 + n0 + c] = s + a->in[I_BMOD][l * 6144 + n0 + c]; }
            __syncthreads();
        }
    }
}

constexpr int MOE_W_ITEMS = NEXP * (2 * 16 * 8 + 4 * 32);
DI void moe_weights(KArgs a, const WS& W, int l, LAS unsigned char* lds, int it_lo, int it_hi, int first_blk) {
    int tid_ = threadIdx.x; asm volatile("" : "+v"(tid_)); const int tid = tid_, lane = tid & 63, wid = __builtin_amdgcn_readfirstlane(tid >> 6);
    if ((int)blockIdx.x < first_blk) return;
    const int gw = ((int)blockIdx.x - first_blk) * 8 + wid, NGW = ((int)gridDim.x - first_blk) * 8;
    LAS float* scr = (LAS float*)(lds + wid * WSCR);
    constexpr int IT_G = 16 * 8, IT_D = 4 * 32;
    for (int it = it_lo + gw; it < it_hi; it += NGW) {
        const int e = it / (2 * IT_G + IT_D); int r = it % (2 * IT_G + IT_D);
        if (r < 2 * IT_G) { const int up = r / IT_G; r %= IT_G; const int kb = r / 8, nb = r % 8, n0 = 32 * nb;
            const float* src = (up ? a->in[I_WU] : a->in[I_WG]) + (size_t)(l * NEXP + e) * D * DE;
            tr_item(src, DE, DE, W.wgu() + (size_t)e * 512 * D, D, 64 * kb, n0, 256 * (n0 >> 7) + (n0 & 127) + (up ? 128 : 0), 0, scr, lane); }
        else { r -= 2 * IT_G; const int kb = r / 32, nb = r % 32;
            tr_item(a->in[I_WD] + (size_t)(l * NEXP + e) * DE * D, D, D, W.wdn() + (size_t)e * D * DE, DE, 64 * kb, 32 * nb, 32 * nb, 0, scr, lane); }
    }
}

DI void phase_norm1(KArgs a, const WS& W, int l, int lc, bool combine, bool donorm, int nrows) {
    int tid_ = threadIdx.x; asm volatile("" : "+v"(tid_)); const int tid = tid_, lane = tid & 63, wid = __builtin_amdgcn_readfirstlane(tid >> 6);
    const int gw = blockIdx.x * 8 + wid, NGW = gridDim.x * 8;
    for (int rowa = gw; rowa < nrows; rowa += 2 * NGW) {
        const int rowb = rowa + NGW; const int nq = rowb < nrows ? 2 : 1;
        f32x4 v[2][4]; u32x2 xa[2][4], ya[2][4], yb[2][4]; int vec[2];
#pragma unroll
        for (int q = 0; q < 2; ++q) if (q < nq) { const int row = q ? rowb : rowa; vec[q] = row < SEQ ? 0 : (row < ML ? 1 : 2);
            const bf16_t* xr = W.xb() + (size_t)row * D;
#pragma unroll
            for (int j = 0; j < 4; ++j) xa[q][j] = *(const u32x2*)(xr + 4 * lane + 256 * j);
            if (combine) { const bf16_t* y0 = W.y() + (size_t)(2 * row) * D; const bf16_t* y1 = y0 + D;
#pragma unroll
                for (int j = 0; j < 4; ++j) { ya[q][j] = *(const u32x2*)(y0 + 4 * lane + 256 * j); yb[q][j] = *(const u32x2*)(y1 + 4 * lane + 256 * j); } } }
#pragma unroll
        for (int q = 0; q < 2; ++q) if (q < nq) { const int row = q ? rowb : rowa;
#pragma unroll
            for (int j = 0; j < 4; ++j) { v[q][j][0] = bf2f(xa[q][j].x & 0xffffu); v[q][j][1] = bf2f(xa[q][j].x >> 16); v[q][j][2] = bf2f(xa[q][j].y & 0xffffu); v[q][j][3] = bf2f(xa[q][j].y >> 16); }
            if (combine) { const float* g2 = W.mods() + (size_t)(lc * 3 + vec[q]) * 6144 + 5 * 1024;
#pragma unroll
                for (int j = 0; j < 4; ++j) { const int c = 4 * lane + 256 * j; const f32x4 g = *(const f32x4*)(g2 + c); const u32x2 a0 = ya[q][j], a1 = yb[q][j];
                    v[q][j][0] += g[0] * (bf2f(a0.x & 0xffffu) + bf2f(a1.x & 0xffffu)); v[q][j][1] += g[1] * (bf2f(a0.x >> 16) + bf2f(a1.x >> 16));
                    v[q][j][2] += g[2] * (bf2f(a0.y & 0xffffu) + bf2f(a1.y & 0xffffu)); v[q][j][3] += g[3] * (bf2f(a0.y >> 16) + bf2f(a1.y >> 16));
                    if (donorm) { u32x2 p; p.x = pk2(v[q][j][0], v[q][j][1]); p.y = pk2(v[q][j][2], v[q][j][3]); *(u32x2*)(W.xb() + (size_t)row * D + c) = p;
                        v[q][j][0] = bf2f(p.x & 0xffffu); v[q][j][1] = bf2f(p.x >> 16); v[q][j][2] = bf2f(p.y & 0xffffu); v[q][j][3] = bf2f(p.y >> 16); }
                    else *(f32x4*)(a->out + (size_t)row * D + c) = v[q][j]; } }
            if (donorm) { float ss = 0.f;
#pragma unroll
                for (int j = 0; j < 4; ++j) ss += (v[q][j][0] * v[q][j][0] + v[q][j][1] * v[q][j][1]) + (v[q][j][2] * v[q][j][2] + v[q][j][3] * v[q][j][3]);
                const float r = rsqrtf(wave_sum(ss, lane) * (1.f / D) + EPS);
                const float* md = W.mods() + (size_t)(l * 3 + vec[q]) * 6144; const float* nw = a->in[I_N1W] + l * D; bf16_t* hr = W.h() + (size_t)row * D;
#pragma unroll
                for (int j = 0; j < 4; ++j) { const int c = 4 * lane + 256 * j; const f32x4 w = *(const f32x4*)(nw + c), sh = *(const f32x4*)(md + c), sc = *(const f32x4*)(md + 1024 + c);
                    float o[4];
#pragma unroll
                    for (int i = 0; i < 4; ++i) o[i] = v[q][j][i] * r * w[i] * (1.f + sc[i]) + sh[i];
                    u32x2 p; p.x = pk2(o[0], o[1]); p.y = pk2(o[2], o[3]); *(u32x2*)(hr + c) = p; } } }
    }
}

DI void phase_prep(KArgs a, const WS& W, int l, LAS unsigned char* lds) {
    int tid_ = threadIdx.x; asm volatile("" : "+v"(tid_)); const int tid = tid_, lane = tid & 63, wid = __builtin_amdgcn_readfirstlane(tid >> 6);
    const int gw = blockIdx.x * 8 + wid, NGW = gridDim.x * 8;
    LAS float* wa = (LAS float*)lds;
    LAS float* cw = (LAS float*)(lds + 16384);
    __syncthreads();
    for (int i = tid; i < 4096; i += 512) wa[i] = a->in[I_GWA][l * 4096 + i];
    for (int i = tid; i < 1280; i += 512) cw[i] = a->in[I_MCW][l * 1280 + i];
    for (int i = tid; i < 256; i += 512) cw[1280 + i] = a->in[I_MCB][l * 256 + i];
    __syncthreads();
    const bf16_t* proj = W.proj();
    for (int rowa = gw; rowa < MA; rowa += 2 * NGW) {
        const int rowb = rowa + NGW; const int nq = rowb < MA ? 2 : 1;
        u32x2 c_cq[2], c_mx[2][5]; unsigned c_ckv[2]; float c_mg[2], c_ga[2]; int s0v[2], Lsv[2];
#pragma unroll
        for (int q = 0; q < 2; ++q) if (q < nq) { const int row = q ? rowb : rowa; const bf16_t* pr = proj + (size_t)row * DINP;
            c_cq[q] = *(const u32x2*)(pr + C_CQ + 4 * lane); c_ckv[q] = *(const unsigned*)(pr + C_CKV + 2 * lane);
            s0v[q] = row < ML ? (row / SEQ) * SEQ : ML + ((row - ML) / CTX) * CTX; Lsv[q] = row < ML ? SEQ : CTX; const int t = row - s0v[q];
#pragma unroll
            for (int k = 0; k < 5; ++k) { const int tt = t + k - 2; c_mx[q][k] = (tt >= 0 && tt < Lsv[q]) ? *(const u32x2*)(proj + (size_t)(s0v[q] + tt) * DINP + C_MX + 4 * lane) : (u32x2){0u, 0u}; }
            c_mg[q] = lane < 16 ? bf2f(pr[C_MG + lane]) : 0.f; c_ga[q] = lane < 32 ? bf2f(pr[C_GA + lane]) : 0.f; }
#pragma unroll
        for (int q = 0; q < 2; ++q) if (q < nq) { const int row = q ? rowb : rowa;
            { const u32x2 c = c_cq[q]; float f[4] = {bf2f(c.x & 0xffffu), bf2f(c.x >> 16), bf2f(c.y & 0xffffu), bf2f(c.y >> 16)};
              const float r = rsqrtf(wave_sum((f[0] * f[0] + f[1] * f[1]) + (f[2] * f[2] + f[3] * f[3]), lane) * (1.f / 256.f) + EPS);
              const f32x4 g = *(const f32x4*)(a->in[I_QAN] + l * 256 + 4 * lane);
              u32x2 o; o.x = pk2(f[0] * r * g[0], f[1] * r * g[1]); o.y = pk2(f[2] * r * g[2], f[3] * r * g[3]); *(u32x2*)(W.cqn() + (size_t)row * CQ_LD + 4 * lane) = o; }
            { const unsigned c = c_ckv[q]; const float f0 = bf2f(c & 0xffffu), f1 = bf2f(c >> 16);
              const float r = rsqrtf(wave_sum(f0 * f0 + f1 * f1, lane) * (1.f / 128.f) + EPS);
              const f32x2 g = *(const f32x2*)(a->in[I_KVAN] + l * 128 + 2 * lane);
              *(unsigned*)(W.cqn() + (size_t)row * CQ_LD + 256 + 2 * lane) = pk2(f0 * r * g[0], f1 * r * g[1]); *(unsigned*)(W.cqn() + (size_t)row * CQ_LD + 384 + 2 * lane) = 0u; }
            { float acc[4];
#pragma unroll
              for (int i = 0; i < 4; ++i) acc[i] = cw[1280 + 4 * lane + i];
#pragma unroll
              for (int k = 0; k < 5; ++k) { const u32x2 m = c_mx[q][k];
                  acc[0] += cw[k * 256 + 4 * lane + 0] * bf2f(m.x & 0xffffu); acc[1] += cw[k * 256 + 4 * lane + 1] * bf2f(m.x >> 16);
                  acc[2] += cw[k * 256 + 4 * lane + 2] * bf2f(m.y & 0xffffu); acc[3] += cw[k * 256 + 4 * lane + 3] * bf2f(m.y >> 16); }
              u32x2 o; o.x = pk2(siluf(acc[0]), siluf(acc[1])); o.y = pk2(siluf(acc[2]), siluf(acc[3])); *(u32x2*)(W.xconv() + (size_t)row * CQ_LD + 4 * lane) = o; }
            if (lane < 16) { const float g = c_mg[q] + a->in[I_MGB][l * 16 + lane]; W.gates()[(size_t)row * 16 + lane] = ((lane >> 2) & 1) ? logsigmoidf_(g) : g; }
            { const float av = c_ga[q];
#pragma unroll
              for (int u = 0; u < 2; ++u) { float s0 = a->in[I_GBA][(l * 2 + u) * 128 + lane], s1 = a->in[I_GBA][(l * 2 + u) * 128 + 64 + lane];
#pragma unroll
                  for (int r = 0; r < 16; ++r) { const float ar = sh_idx(av, u * 16 + r); s0 += ar * wa[(u * 16 + r) * 128 + lane]; s1 += ar * wa[(u * 16 + r) * 128 + 64 + lane]; }
                  float* lo = W.loga() + ((size_t)u * MA + row) * 128; lo[lane] = logsigmoidf_(s0) * (1.f / 16.f); lo[64 + lane] = logsigmoidf_(s1) * (1.f / 16.f); } } }
    }
}

DI void phase_post(KArgs a, const WS& W, int l, LAS unsigned char* lds) {
    int tid_ = threadIdx.x; asm volatile("" : "+v"(tid_)); const int tid = tid_, lane = tid & 63, wid = __builtin_amdgcn_readfirstlane(tid >> 6);
    const int gw = blockIdx.x * 8 + wid, NGW = gridDim.x * 8;
    const int head = lane >> 3, sub = lane & 7, r32 = lane & 31, hi = lane >> 5;
    const bf16_t* proj = W.proj(); const bf16_t* raw = W.qkvraw();
    for (int rowa = gw; rowa < MA; rowa += 2 * NGW) {
        const int rowb = rowa + NGW; const int nq = rowb < MA ? 2 : 1;
        u32x4 Lq[2], Lk[2], Lv[2]; unsigned Lq1[2], Lq2[2], Lk1[2], Lk2[2]; float cs[2][2], sn[2][2];
#pragma unroll
        for (int q = 0; q < 2; ++q) if (q < nq) { const int row = q ? rowb : rowa; const bool lat = row < ML; const int t = lat ? row % SEQ : 0;
            const bf16_t* qr = raw + (size_t)row * 1792 + head * 96; const bf16_t* kvr = raw + (size_t)row * 1792 + 768 + head * 128; const bf16_t* pr = proj + (size_t)row * DINP + C_KR;
            Lq[q] = *(const u32x4*)(qr + sub * 8); Lq1[q] = *(const unsigned*)(qr + 64 + sub * 2); Lq2[q] = *(const unsigned*)(qr + 80 + sub * 2);
            Lk[q] = *(const u32x4*)(kvr + sub * 8); Lv[q] = *(const u32x4*)(kvr + 64 + sub * 8); Lk1[q] = *(const unsigned*)(pr + sub * 2); Lk2[q] = *(const unsigned*)(pr + 16 + sub * 2);
            if (lat) { const f32x2 c2 = *(const f32x2*)(W.rope() + t * 16 + sub * 2), s2 = *(const f32x2*)(W.rope() + SEQ * 16 + t * 16 + sub * 2); cs[q][0] = c2[0]; cs[q][1] = c2[1]; sn[q][0] = s2[0]; sn[q][1] = s2[1]; }
            else { cs[q][0] = cs[q][1] = 1.f; sn[q][0] = sn[q][1] = 0.f; } }
#pragma unroll
        for (int q = 0; q < 2; ++q) if (q < nq) { const int row = q ? rowb : rowa;
            const bool lat = row < ML; const int b = lat ? row / SEQ : (row - ML) / CTX; const int t = lat ? row % SEQ : (row - ML) % CTX; const int kidx = lat ? t : SEQ + t;
            { float f[8]; unpack8(Lq[q], f); const unsigned u1 = Lq1[q], u2 = Lq2[q];
              float x1[2] = {bf2f(u1 & 0xffffu), bf2f(u1 >> 16)}, x2[2] = {bf2f(u2 & 0xffffu), bf2f(u2 >> 16)};
              float ss = x1[0] * x1[0] + x1[1] * x1[1] + x2[0] * x2[0] + x2[1] * x2[1];
#pragma unroll
              for (int i = 0; i < 8; ++i) ss += f[i] * f[i];
              ss += sh_xor(ss, 1, lane); ss += sh_xor(ss, 2, lane); ss += sh_xor(ss, 4, lane);
              const float r = rsqrtf(ss * (1.f / 96.f) + EPS); const float* nw = a->in[I_QNW] + l * 96;
#pragma unroll
              for (int i = 0; i < 8; ++i) f[i] = f[i] * r * nw[sub * 8 + i] * QSCALE;
              float o1[2], o2[2];
#pragma unroll
              for (int i = 0; i < 2; ++i) { const float a1 = x1[i] * r * nw[64 + sub * 2 + i], a2 = x2[i] * r * nw[80 + sub * 2 + i]; o1[i] = (a1 * cs[q][i] - a2 * sn[q][i]) * QSCALE; o2[i] = (a1 * sn[q][i] + a2 * cs[q][i]) * QSCALE; }
              bf16_t* qo = W.q() + ((size_t)(b * NH + head) * NKEY + kidx) * QK;
              *(u32x4*)(qo + sub * 8) = pack8(f); *(unsigned*)(qo + 64 + sub * 2) = pk2(o1[0], o1[1]); *(unsigned*)(qo + 80 + sub * 2) = pk2(o2[0], o2[1]); }
            { float f[8]; unpack8(Lk[q], f); const unsigned u1 = Lk1[q], u2 = Lk2[q];
              float x1[2] = {bf2f(u1 & 0xffffu), bf2f(u1 >> 16)}, x2[2] = {bf2f(u2 & 0xffffu), bf2f(u2 >> 16)};
              float ss = x1[0] * x1[0] + x1[1] * x1[1] + x2[0] * x2[0] + x2[1] * x2[1];
#pragma unroll
              for (int i = 0; i < 8; ++i) ss += f[i] * f[i];
              ss += sh_xor(ss, 1, lane); ss += sh_xor(ss, 2, lane); ss += sh_xor(ss, 4, lane);
              const float r = rsqrtf(ss * (1.f / 96.f) + EPS); const float* nw = a->in[I_KNW] + l * 96;
#pragma unroll
              for (int i = 0; i < 8; ++i) f[i] = f[i] * r * nw[sub * 8 + i];
              float o1[2], o2[2];
#pragma unroll
              for (int i = 0; i < 2; ++i) { const float a1 = x1[i] * r * nw[64 + sub * 2 + i], a2 = x2[i] * r * nw[80 + sub * 2 + i]; o1[i] = a1 * cs[q][i] - a2 * sn[q][i]; o2[i] = a1 * sn[q][i] + a2 * cs[q][i]; }
              const int tile = kidx >> 6, key = kidx & 63;
              bf16_t* kb = W.k() + ((size_t)(b * NH + head) * NTILE + tile) * 6144;
              *(u32x4*)(kb + (sub * 64 + key) * 8) = pack8(f);
              *(unsigned*)(kb + ((8 + (sub >> 2)) * 64 + key) * 8 + (sub & 3) * 2) = pk2(o1[0], o1[1]);
              *(unsigned*)(kb + ((10 + (sub >> 2)) * 64 + key) * 8 + (sub & 3) * 2) = pk2(o2[0], o2[1]);
              bf16_t* vb = W.v() + ((size_t)(b * NH + head) * NTILE + tile) * 4096;
              *(u32x4*)(vb + ((sub >> 2) * 4 + (key >> 4)) * 512 + (key & 15) * 32 + (sub & 3) * 8) = Lv[q]; } }
    }
    LAS bf16_t* As = (LAS bf16_t*)(lds + wid * WSCR);
    LAS bf16_t* Bs = As + 64 * 72;
    for (int u = gw; u < 2 * 16 * NCH; u += NGW) {
        const int kind = u / (16 * NCH), s = (u % (16 * NCH)) / NCH, gc = u % NCH, b = s >> 3, h = (s >> 1) & 3, dir = s & 1;
        const int row = tokrow(b, gc, lane);
        LDS_WAIT(); asm volatile("" ::: "memory");
        if (kind == 0) {
            const float logi = W.gates()[(size_t)row * 16 + dir * 8 + h], logf = W.gates()[(size_t)row * 16 + dir * 8 + 4 + h];
            const float bc = scan_incl(logf, lane, dir), bend = sh_idx(bc, dir ? 0 : 63), g = bend - bc + logi, gmax = wave_max(g, lane), wj = __expf(g - gmax);
#pragma unroll
            for (int i = 0; i < 8; ++i) { const int p = i * 8 + (lane >> 3), c8 = lane & 7; const int rp = tokrow(b, gc, p);
                float fv[8], fk[8]; unpack8(*(const u32x4*)(proj + (size_t)rp * DINP + C_MV + h * 64 + c8 * 8), fv); unpack8(*(const u32x4*)(W.mqk() + (size_t)rp * 512 + 256 + h * 64 + c8 * 8), fk);
                const float wp = sh_idx(wj, p);
#pragma unroll
                for (int e = 0; e < 8; ++e) { As[(c8 * 8 + e) * 72 + p] = (bf16_t)f2bf(fv[e]); Bs[(c8 * 8 + e) * 72 + p] = (bf16_t)f2bf(fk[e] * wp); } }
            LDS_WAIT(); asm volatile("" ::: "memory");
            float* ut = W.mu() + (size_t)(s * NCH + gc) * 4096;
#pragma unroll
            for (int mt = 0; mt < 2; ++mt)
#pragma unroll
                for (int nt = 0; nt < 2; ++nt) { f32x16 acc = {}; wmma32<4>(acc, As + mt * 32 * 72, 72, Bs + nt * 32 * 72, 72, r32, hi);
#pragma unroll
                    for (int r = 0; r < 16; ++r) ut[(32 * mt + crow(r, hi)) * 64 + 32 * nt + r32] = acc[r]; }
            float nsum = 0.f;
#pragma unroll 8
            for (int j = 0; j < 64; ++j) nsum += bf2f(Bs[lane * 72 + j]);
            W.mn()[(size_t)(s * NCH + gc) * 64 + lane] = nsum;
            if (lane == 0) { W.ms()[(size_t)(s * NCH + gc) * 4 + 0] = gmax; W.ms()[(size_t)(s * NCH + gc) * 4 + 1] = bend; }
        } else {
            float bc[32];
            { const float* lp = W.loga() + ((size_t)dir * MA + row) * 128 + h * 32;
#pragma unroll
              for (int q4 = 0; q4 < 8; ++q4) { const f32x4 v = *(const f32x4*)(lp + 4 * q4); bc[4 * q4] = v[0]; bc[4 * q4 + 1] = v[1]; bc[4 * q4 + 2] = v[2]; bc[4 * q4 + 3] = v[3]; } }
#pragma unroll
            for (int d = 0; d < 32; ++d) bc[d] = scan_incl(bc[d], lane, dir);
            float kk[32];
#pragma unroll
            for (int q8 = 0; q8 < 4; ++q8) { float f[8]; unpack8(*(const u32x4*)(proj + (size_t)row * DINP + C_GK + h * 32 + q8 * 8), f);
#pragma unroll
                for (int e = 0; e < 8; ++e) kk[q8 * 8 + e] = f[e]; }
            float* gdp = W.gd() + (size_t)(s * NCH + gc) * 32;
#pragma unroll
            for (int d = 0; d < 32; ++d) { const float bend = sh_idx(bc[d], dir ? 0 : 63); Bs[d * 72 + lane] = (bf16_t)f2bf(kk[d] * __expf(bend - bc[d])); if (lane == d) gdp[d] = __expf(bend); }
#pragma unroll
            for (int i = 0; i < 8; ++i) { const int p = i * 8 + (lane >> 3), c8 = lane & 7; const int rp = tokrow(b, gc, p);
                float fv[8]; unpack8(*(const u32x4*)(proj + (size_t)rp * DINP + C_GV + h * 64 + c8 * 8), fv);
#pragma unroll
                for (int e = 0; e < 8; ++e) As[(c8 * 8 + e) * 72 + p] = (bf16_t)f2bf(fv[e]); }
            LDS_WAIT(); asm volatile("" ::: "memory");
            float* ut = W.gu() + (size_t)(s * NCH + gc) * 2048;
#pragma unroll
            for (int mt = 0; mt < 2; ++mt) { f32x16 acc = {}; wmma32<4>(acc, As + mt * 32 * 72, 72, Bs, 72, r32, hi);
#pragma unroll
                for (int r = 0; r < 16; ++r) ut[(32 * mt + crow(r, hi)) * 32 + r32] = acc[r]; }
        }
    }
}

DI int scan_gc(int dir, int sc) { return dir ? (NCH - 1 - sc) : (sc < 4 ? 128 + sc : sc - 4); }
DI void phase_scan(const WS& W, LAS unsigned char* lds) {
    int tid_ = threadIdx.x; asm volatile("" : "+v"(tid_)); const int tid = tid_;
    LAS float* gm = (LAS float*)lds; LAS float* be = gm + NCH; LAS float* dec = be + NCH; LAS float* ff = dec + NCH; LAS float* mi = ff + NCH;
    for (int u = blockIdx.x; u < 192; u += gridDim.x) {
        __syncthreads();
        if (u < 128) {
            const int s = u >> 3, slice = u & 7, dir = s & 1;
            if (tid < NCH) { const int gc = scan_gc(dir, tid); gm[tid] = W.ms()[(size_t)(s * NCH + gc) * 4 + 0]; be[tid] = W.ms()[(size_t)(s * NCH + gc) * 4 + 1]; }
            __syncthreads();
            if (tid == 0) { float m = 0.f; for (int sc = 0; sc < NCH; ++sc) { mi[sc] = m; const float mn = fmaxf(be[sc] + m, gm[sc]); dec[sc] = __expf(be[sc] + m - mn); ff[sc] = __expf(gm[sc] - mn); m = mn; } }
            __syncthreads();
            const int e = slice * 512 + tid; float C = 0.f, nn = 0.f;
            const bool do_n = (slice == 0 && tid < 64);
            for (int sc0 = 0; sc0 < NCH; sc0 += 33) {
                float uu[33], un[33];
#pragma unroll
                for (int j = 0; j < 33; ++j) { const int gc = scan_gc(dir, sc0 + j); uu[j] = W.mu()[(size_t)(s * NCH + gc) * 4096 + e]; un[j] = do_n ? W.mn()[(size_t)(s * NCH + gc) * 64 + tid] : 0.f; }
#pragma unroll
                for (int j = 0; j < 33; ++j) { const int sc = sc0 + j, gc = scan_gc(dir, sc);
                    W.mu()[(size_t)(s * NCH + gc) * 4096 + e] = C; C = dec[sc] * C + ff[sc] * uu[j];
                    if (do_n) { W.mn()[(size_t)(s * NCH + gc) * 64 + tid] = nn; nn = dec[sc] * nn + ff[sc] * un[j]; }
                    if (slice == 0 && tid == 64) W.ms()[(size_t)(s * NCH + gc) * 4 + 2] = mi[sc]; } }
        } else {
            const int s = (u - 128) >> 2, slice = (u - 128) & 3, dir = s & 1; const int e = slice * 512 + tid, d = e & 31; float S = 0.f;
            for (int sc0 = 0; sc0 < NCH; sc0 += 33) {
                float uu[33], dc[33];
#pragma unroll
                for (int j = 0; j < 33; ++j) { const int gc = scan_gc(dir, sc0 + j); uu[j] = W.gu()[(size_t)(s * NCH + gc) * 2048 + e]; dc[j] = W.gd()[(size_t)(s * NCH + gc) * 32 + d]; }
#pragma unroll
                for (int j = 0; j < 33; ++j) { const int gc = scan_gc(dir, sc0 + j); W.gu()[(size_t)(s * NCH + gc) * 2048 + e] = S; S = dc[j] * S + uu[j]; } }
        }
    }
    __syncthreads();
}

constexpr int AT_SLOT = 20480, AT_WS = 4 * AT_SLOT, AT_OST = AT_WS + 2048;
DI void glds16(const void* gsrc, unsigned lds_dst) { unsigned keep;
    asm volatile("s_mov_b32 %0, m0\n\ts_mov_b32 m0, %2\n\ts_nop 0\n\tglobal_load_lds_dwordx4 %1, off\n\ts_mov_b32 m0, %0" : "=&s"(keep) : "v"(gsrc), "s"(lds_dst) : "memory"); }
DI s16x4 vtr(const LAS char* p) { typedef short v4i16_t __attribute__((ext_vector_type(4))); return __builtin_bit_cast(s16x4, __builtin_amdgcn_ds_read_tr16_b64_v4i16((LAS v4i16_t*)p)); }
DI void attn_unit(const WS& W, LAS unsigned char* lds, int b, int h, int tq0, int tile0, int nt, int orow0) {
    int tid_ = threadIdx.x; asm volatile("" : "+v"(tid_)); const int tid = tid_, lane = tid & 63, r32 = lane & 31, hi = lane >> 5; const int wid = __builtin_amdgcn_readfirstlane(tid >> 6);
    const unsigned lds0 = (unsigned)(uintptr_t)lds;
    const bf16_t* Qw = W.q() + ((size_t)(b * NH + h) * NKEY + tq0 + wid * 32 + r32) * QK;
    const char* Kt = (const char*)(W.k() + ((size_t)(b * NH + h) * NTILE + tile0) * 6144);
    const char* Vt = (const char*)(W.v() + ((size_t)(b * NH + h) * NTILE + tile0) * 4096);
    const int np = wid < 4 ? 3 : 2;
#define AT_ISSUE(t, slot) do { const char* kt_ = Kt + (size_t)(t) * 12288; const char* vt_ = Vt + (size_t)(t) * 8192; const unsigned d_ = lds0 + (slot) * AT_SLOT; \
        glds16(kt_ + wid * 1024 + lane * 16, (unsigned)__builtin_amdgcn_readfirstlane(d_ + wid * 1024)); \
        if (wid < 4) { glds16(kt_ + (wid + 8) * 1024 + lane * 16, (unsigned)__builtin_amdgcn_readfirstlane(d_ + (wid + 8) * 1024)); glds16(vt_ + (wid + 4) * 1024 + lane * 16, (unsigned)__builtin_amdgcn_readfirstlane(d_ + (wid + 16) * 1024)); } \
        else { glds16(vt_ + (wid - 4) * 1024 + lane * 16, (unsigned)__builtin_amdgcn_readfirstlane(d_ + (wid + 8) * 1024)); } } while (0)
    bf16x8 qr[6];
#pragma unroll
    for (int d0 = 0; d0 < 6; ++d0) qr[d0] = *(const bf16x8*)(Qw + d0 * 16 + hi * 8);
    VM_WAIT();
    AT_ISSUE(0, 0);
    if (nt > 1) AT_ISSUE(1, 1);
    f32x16 o[2]; o[0] = f32x16{}; o[1] = f32x16{}; float l_reg = 0.f;
    const int vb = ((lane >> 4) & 1) * 32 + (lane & 3) * 8 + (4 * hi + ((lane & 15) >> 2)) * 64;
#define AT_SYNC(t) do { if ((t) + 1 < nt) { if (np == 3) asm volatile("s_waitcnt vmcnt(3)\n\ts_waitcnt lgkmcnt(0)\n\ts_barrier" ::: "memory"); else asm volatile("s_waitcnt vmcnt(2)\n\ts_waitcnt lgkmcnt(0)\n\ts_barrier" ::: "memory"); } \
        else asm volatile("s_waitcnt vmcnt(0)\n\ts_waitcnt lgkmcnt(0)\n\ts_barrier" ::: "memory"); \
        if ((t) + 2 < nt) AT_ISSUE((t) + 2, ((t) + 2) & 3); } while (0)
#define AT_QK(sl) do { const LAS char* Ks = (const LAS char*)lds + (sl) * AT_SLOT; p0 = f32x16{}; p1 = f32x16{}; \
        _Pragma("unroll") for (int d0 = 0; d0 < 6; ++d0) { \
            const bf16x8 k0 = *(const LAS bf16x8*)(Ks + (2 * d0 + hi) * 1024 + r32 * 16); const bf16x8 k1 = *(const LAS bf16x8*)(Ks + (2 * d0 + hi) * 1024 + (32 + r32) * 16); \
            p0 = __builtin_amdgcn_mfma_f32_32x32x16_bf16(k0, qr[d0], p0, 0, 0, 0); p1 = __builtin_amdgcn_mfma_f32_32x32x16_bf16(k1, qr[d0], p1, 0, 0, 0); } } while (0)
#define AT_SMPV(sl) do { const LAS char* Vs = (const LAS char*)lds + (sl) * AT_SLOT + 12288; float sacc = 0.f; \
        _Pragma("unroll") for (int r = 0; r < 16; ++r) { p0[r] = __builtin_amdgcn_exp2f(p0[r]); p1[r] = __builtin_amdgcn_exp2f(p1[r]); sacc += p0[r] + p1[r]; } \
        l_reg += sacc; u32x4 pw[4]; \
        _Pragma("unroll") for (int j = 0; j < 4; ++j) { pw[0][j] = cvtpk(p0[2 * j], p0[2 * j + 1]); pw[1][j] = cvtpk(p0[8 + 2 * j], p0[8 + 2 * j + 1]); pw[2][j] = cvtpk(p1[2 * j], p1[2 * j + 1]); pw[3][j] = cvtpk(p1[8 + 2 * j], p1[8 + 2 * j + 1]); } \
        _Pragma("unroll") for (int d0 = 0; d0 < 2; ++d0) _Pragma("unroll") for (int ks = 0; ks < 4; ++ks) { \
            const s16x4 lo = vtr(Vs + vb + d0 * 4096 + ks * 1024), hh = vtr(Vs + vb + d0 * 4096 + ks * 1024 + 512); \
            const bf16x8 vf = (bf16x8){lo[0], lo[1], lo[2], lo[3], hh[0], hh[1], hh[2], hh[3]}; \
            o[d0] = __builtin_amdgcn_mfma_f32_32x32x16_bf16(__builtin_bit_cast(bf16x8, pw[ks]), vf, o[d0], 0, 0, 0); } } while (0)
    f32x16 p0, p1;
    if (wid < 4) {
        for (int t = 0; t < nt; ++t) { AT_SYNC(t); AT_QK(t & 3); AT_SMPV(t & 3); }
    } else {
        AT_SYNC(0); AT_QK(0);
        for (int t = 1; t < nt; ++t) { AT_SYNC(t); AT_SMPV((t - 1) & 3); AT_QK(t & 3); }
        AT_SMPV((nt - 1) & 3);
    }
#undef AT_SYNC
#undef AT_QK
#undef AT_SMPV
#undef AT_ISSUE
    { auto rr = __builtin_amdgcn_permlane32_swap(__float_as_uint(l_reg), __float_as_uint(l_reg), false, false); l_reg = __uint_as_float(rr[0]) + __uint_as_float(rr[1]); }
    LAS float* wsf = (LAS float*)(lds + AT_WS) + wid * 64;
    if (hi == 0) wsf[r32] = l_reg;
    LDS_WAIT();
    float rli[16];
#pragma unroll
    for (int r = 0; r < 16; ++r) rli[r] = 1.f / wsf[crow(r, hi)];
    LAS bf16_t* stg = (LAS bf16_t*)(lds + AT_OST) + wid * 2048;
#pragma unroll
    for (int r = 0; r < 16; ++r) { const int orow = crow(r, hi);
#pragma unroll
        for (int d0 = 0; d0 < 2; ++d0) stg[orow * 64 + d0 * 32 + r32] = (bf16_t)f2bf(o[d0][r] * rli[r]); }
    LDS_WAIT();
    bf16_t* Ow = W.mix() + (size_t)(orow0 + wid * 32) * D + h * 64;
#pragma unroll
    for (int i = 0; i < 4; ++i) { const int row = i * 8 + (lane >> 3), ch = lane & 7; u32x4 v = *(const LAS u32x4*)(stg + row * 64 + ch * 8);
#ifdef PROBE_NOATT
        v = (u32x4){0u, 0u, 0u, 0u};
#endif
        *(u32x4*)(Ow + (size_t)row * D + ch * 8) = v; }
    asm volatile("s_waitcnt lgkmcnt(0)\n\ts_barrier" ::: "memory");
}
DI void phase_attn(const WS& W, LAS unsigned char* lds, bool need_ctx) {
    const int G = gridDim.x, bx = blockIdx.x; const int vcu = (G % 8 == 0) ? (bx % 8) * (G / 8) + bx / 8 : bx;
    for (int L = vcu; L < 512; L += G) {
        int bh, qb; if (G == 256) { const int i = L >> 8, v = L & 255; bh = (v >> 5) * 2 + i; qb = v & 31; } else { bh = L >> 5; qb = L & 31; }
        attn_unit(W, lds, bh >> 3, bh & 7, qb * 256, 0, NTILE, (bh >> 3) * SEQ + qb * 256);
    }
    if (need_ctx) for (int L = vcu; L < 16; L += G) attn_unit(W, lds, L >> 3, L & 7, SEQ, 128, 4, ML + (L >> 3) * CTX);
}

DI void mlstm_out_unit(KArgs a, const WS& W, int l, int b, int h, int gc, LAS unsigned char* lds) {
    int tid_ = threadIdx.x; asm volatile("" : "+v"(tid_)); const int tid = tid_, lane = tid & 63, r32 = lane & 31, hi = lane >> 5; const int wid = __builtin_amdgcn_readfirstlane(tid >> 6);
    LAS bf16_t* qs = (LAS bf16_t*)lds; LAS bf16_t* ks = qs + 4608; LAS bf16_t* vT = ks + 4608; LAS bf16_t* CT = vT + 4608  ; LAS bf16_t* P = CT + 2 * 4608  ;
    LAS float* Hs = (LAS float*)(lds + 64512)  ; LAS float* sm = (LAS float*)(lds + 97280);
    const bf16_t* proj = W.proj();
    { const int p = tid >> 3, c8 = tid & 7; const int rp = tokrow(b, gc, p);
      *(LAS u32x4*)(qs + p * 72 + c8 * 8) = *(const u32x4*)(W.mqk() + (size_t)rp * 512 + h * 64 + c8 * 8);
      *(LAS u32x4*)(ks + p * 72 + c8 * 8) = *(const u32x4*)(W.mqk() + (size_t)rp * 512 + 256 + h * 64 + c8 * 8);
      float fv[8]; unpack8(*(const u32x4*)(proj + (size_t)rp * DINP + C_MV + h * 64 + c8 * 8), fv);
#pragma unroll
      for (int e = 0; e < 8; ++e) vT[(c8 * 8 + e) * 72 + p] = (bf16_t)f2bf(fv[e]);
#pragma unroll
      for (int dir = 0; dir < 2; ++dir) { const int s = (b * 4 + h) * 2 + dir; const float* cp = W.mu() + (size_t)(s * NCH + gc) * 4096 + p * 64 + c8 * 8;
          const f32x4 c0 = *(const f32x4*)cp, c1 = *(const f32x4*)(cp + 4); float f[8] = {c0[0], c0[1], c0[2], c0[3], c1[0], c1[1], c1[2], c1[3]};
          *(LAS u32x4*)(CT + dir * 4608 + p * 72 + c8 * 8) = pack8(f); }
      if (tid < 128) { const int dir = tid >> 6, d = tid & 63; const int s = (b * 4 + h) * 2 + dir; sm[dir * 384 + 4 * 64 + d] = W.mn()[(size_t)(s * NCH + gc) * 64 + d]; } }
    if ((wid & 3) == 0) { const int dir = wid >> 2; const int s = (b * 4 + h) * 2 + dir; const int row = tokrow(b, gc, lane);
        const float logi = W.gates()[(size_t)row * 16 + dir * 8 + h], logf = W.gates()[(size_t)row * 16 + dir * 8 + 4 + h];
        const float mst = W.ms()[(size_t)(s * NCH + gc) * 4 + 2];
        const float bc = scan_incl(logf, lane, dir), av = logi - bc, amax = scan_max(av, lane, dir), mt = bc + fmaxf(mst, amax);
        LAS float* sd = sm + dir * 384; sd[lane] = bc - mt; sd[64 + lane] = av; sd[128 + lane] = __expf(bc + mst - mt); sd[192 + lane] = __expf(-mt); }
    __syncthreads();
    const int dir = wid >> 2, mt_ = (wid >> 1) & 1, nt_ = wid & 1; LAS float* sd = sm + dir * 384; LAS bf16_t* Pd = P + dir * 4608;
    { f32x16 acc = {}; wmma32<4>(acc, qs + mt_ * 32 * 72, 72, ks + nt_ * 32 * 72, 72, r32, hi);
      const int j = 32 * nt_ + r32; const float bj = sd[64 + j];
#pragma unroll
      for (int r = 0; r < 16; ++r) { const int t = 32 * mt_ + crow(r, hi); const bool ok = dir ? (j >= t) : (j <= t); const float w = ok ? __expf(sd[t] + bj) : 0.f; Pd[t * 72 + j] = (bf16_t)f2bf(acc[r] * w); } }
    __syncthreads();
    f32x16 acc = {};
    wmma32<4>(acc, qs + mt_ * 32 * 72, 72, CT + dir * 4608 + nt_ * 32 * 72, 72, r32, hi);
#pragma unroll
    for (int r = 0; r < 16; ++r) acc[r] *= sd[128 + 32 * mt_ + crow(r, hi)];
    wmma32<4>(acc, Pd + mt_ * 32 * 72, 72, vT + nt_ * 32 * 72, 72, r32, hi);
    if (nt_ == 0 && lane < 32) { const int t = 32 * mt_ + lane; float rs = 0.f, qn = 0.f;
#pragma unroll 8
        for (int j = 0; j < 64; ++j) { rs += bf2f(Pd[t * 72 + j]); qn += bf2f(qs[t * 72 + j]) * sd[256 + j]; }
        const float den = rs + sd[128 + t] * qn; sd[320 + t] = 1.f / fmaxf(fabsf(den), sd[192 + t]); }
    __syncthreads();
#pragma unroll
    for (int r = 0; r < 16; ++r) { const int t = 32 * mt_ + crow(r, hi); Hs[dir * 4096 + t * 64 + 32 * nt_ + r32] = acc[r] * sd[320 + t]; }
    __syncthreads();
    { const int t = tid >> 3, v0 = (tid & 7) * 8; const int row = tokrow(b, gc, t); float hv[8]; float ss = 0.f;
#pragma unroll
      for (int e = 0; e < 8; ++e) { hv[e] = Hs[t * 64 + v0 + e] + Hs[4096 + t * 64 + v0 + e]; ss += hv[e] * hv[e]; }
      ss += sh_xor(ss, 1, lane); ss += sh_xor(ss, 2, lane); ss += sh_xor(ss, 4, lane);
      const float r = rsqrtf(ss * (1.f / 64.f) + EPS);
      float xcv[8], ov[8]; unpack8(*(const u32x4*)(W.xconv() + (size_t)row * CQ_LD + h * 64 + v0), xcv); unpack8(*(const u32x4*)(proj + (size_t)row * DINP + C_MO + h * 64 + v0), ov);
      const float* nw = a->in[I_MNW] + l * 256 + h * 64 + v0; const float* sk = a->in[I_MSK] + l * 256 + h * 64 + v0; float o[8];
#pragma unroll
      for (int e = 0; e < 8; ++e) o[e] = sigmoidf_(ov[e]) * (hv[e] * r * nw[e] + sk[e] * xcv[e]);
      *(u32x4*)(W.mix() + (size_t)row * D + 512 + h * 64 + v0) = pack8(o); }
    __syncthreads();
}
DI void gla_out_unit(KArgs a, const WS& W, int l, int b, int h, int gc, LAS unsigned char* lds) {
    int tid_ = threadIdx.x; asm volatile("" : "+v"(tid_)); const int tid = tid_, lane = tid & 63, r32 = lane & 31, hi = lane >> 5; const int wid = __builtin_amdgcn_readfirstlane(tid >> 6);
    LAS bf16_t* qs = (LAS bf16_t*)lds  ; LAS bf16_t* ks = qs + 2 * 2560; LAS bf16_t* vT = ks + 2 * 2560  ; LAS bf16_t* ST = vT + 4608  ; LAS bf16_t* P = ST + 2 * 2560  ;
    LAS float* Hs = (LAS float*)(lds + 58368);
    const bf16_t* proj = W.proj();
    { const int p = tid >> 3, c8 = tid & 7; const int rp = tokrow(b, gc, p);
      float fv[8]; unpack8(*(const u32x4*)(proj + (size_t)rp * DINP + C_GV + h * 64 + c8 * 8), fv);
#pragma unroll
      for (int e = 0; e < 8; ++e) vT[(c8 * 8 + e) * 72 + p] = (bf16_t)f2bf(fv[e]);
      const int dir = tid >> 8, idx = tid & 255, v = idx >> 2, d0 = (idx & 3) * 8; const int s = (b * 4 + h) * 2 + dir;
      const float* sp = W.gu() + (size_t)(s * NCH + gc) * 2048 + v * 32 + d0; const f32x4 c0 = *(const f32x4*)sp, c1 = *(const f32x4*)(sp + 4);
      float f[8] = {c0[0], c0[1], c0[2], c0[3], c1[0], c1[1], c1[2], c1[3]}; *(LAS u32x4*)(ST + dir * 2560 + v * 40 + d0) = pack8(f); }
    if ((wid & 3) == 0) { const int dir = wid >> 2; const int row = tokrow(b, gc, lane);
        float bc[32];
        { const float* lp = W.loga() + ((size_t)dir * MA + row) * 128 + h * 32;
#pragma unroll
          for (int q4 = 0; q4 < 8; ++q4) { const f32x4 v = *(const f32x4*)(lp + 4 * q4); bc[4 * q4] = v[0]; bc[4 * q4 + 1] = v[1]; bc[4 * q4 + 2] = v[2]; bc[4 * q4 + 3] = v[3]; } }
#pragma unroll
        for (int d = 0; d < 32; ++d) bc[d] = scan_incl(bc[d], lane, dir);
#pragma unroll
        for (int q8 = 0; q8 < 4; ++q8) { float fq[8], fk[8]; unpack8(*(const u32x4*)(proj + (size_t)row * DINP + C_GQ + h * 32 + q8 * 8), fq); unpack8(*(const u32x4*)(proj + (size_t)row * DINP + C_GK + h * 32 + q8 * 8), fk);
#pragma unroll
            for (int e = 0; e < 8; ++e) { fq[e] = fq[e] * 0.17677669529663687f * __expf(bc[q8 * 8 + e]); fk[e] = fk[e] * __expf(-bc[q8 * 8 + e]); }
            *(LAS u32x4*)(qs + dir * 2560 + lane * 40 + q8 * 8) = pack8(fq); *(LAS u32x4*)(ks + dir * 2560 + lane * 40 + q8 * 8) = pack8(fk); } }
    __syncthreads();
    const int dir = wid >> 2, mt_ = (wid >> 1) & 1, nt_ = wid & 1; LAS bf16_t* Pd = P + dir * 4608;
    { f32x16 acc = {}; wmma32<2>(acc, qs + dir * 2560 + mt_ * 32 * 40, 40, ks + dir * 2560 + nt_ * 32 * 40, 40, r32, hi);
      const int j = 32 * nt_ + r32;
#pragma unroll
      for (int r = 0; r < 16; ++r) { const int t = 32 * mt_ + crow(r, hi); const bool ok = dir ? (j >= t) : (j <= t); Pd[t * 72 + j] = (bf16_t)f2bf(ok ? acc[r] : 0.f); } }
    __syncthreads();
    f32x16 acc = {};
    wmma32<2>(acc, qs + dir * 2560 + mt_ * 32 * 40, 40, ST + dir * 2560 + nt_ * 32 * 40, 40, r32, hi);
    wmma32<4>(acc, Pd + mt_ * 32 * 72, 72, vT + nt_ * 32 * 72, 72, r32, hi);
#pragma unroll
    for (int r = 0; r < 16; ++r) { const int t = 32 * mt_ + crow(r, hi); Hs[dir * 4096 + t * 64 + 32 * nt_ + r32] = acc[r]; }
    __syncthreads();
    { const int t = tid >> 3, v0 = (tid & 7) * 8; const int row = tokrow(b, gc, t); float hv[8]; float ss = 0.f;
#pragma unroll
      for (int e = 0; e < 8; ++e) { hv[e] = Hs[t * 64 + v0 + e] + Hs[4096 + t * 64 + v0 + e]; ss += hv[e] * hv[e]; }
      ss += sh_xor(ss, 1, lane); ss += sh_xor(ss, 2, lane); ss += sh_xor(ss, 4, lane);
      const float r = rsqrtf(ss * (1.f / 64.f) + EPS);
      float rv[8]; unpack8(*(const u32x4*)(proj + (size_t)row * DINP + C_GR + h * 64 + v0), rv);
      const float* nw = a->in[I_GNW] + l * 256 + h * 64 + v0; float o[8];
#pragma unroll
      for (int e = 0; e < 8; ++e) o[e] = hv[e] * r * nw[e] * siluf(rv[e]);
      *(u32x4*)(W.mix() + (size_t)row * D + 768 + h * 64 + v0) = pack8(o); }
    __syncthreads();
}
DI void phase_chunkout(KArgs a, const WS& W, int l, LAS unsigned char* lds) {
    const int nch = (l < DEPTH - 1) ? NCH : 128;
    for (int u = blockIdx.x; u < 2 * 8 * nch; u += gridDim.x) {
        const int kind = u / (8 * nch), rem = u % (8 * nch), bh = rem / nch, gc = rem % nch;
        if (kind == 0) mlstm_out_unit(a, W, l, bh >> 2, bh & 3, gc, lds); else gla_out_unit(a, W, l, bh >> 2, bh & 3, gc, lds);
    }
}

DI void phase_router(KArgs a, const WS& W, int l, int nrows, LAS unsigned char* lds, bool dry = false) {
    int tid_ = threadIdx.x; asm volatile("" : "+v"(tid_)); const int tid = tid_, lane = tid & 63, wid = __builtin_amdgcn_readfirstlane(tid >> 6);
    const int gw = blockIdx.x * 8 + wid, NGW = gridDim.x * 8;
    LAS float* WT = (LAS float*)lds;
    __syncthreads();
    for (int i = tid; i < 36 * 256; i += 512) *(LAS f32x4*)(WT + 4 * i) = *(const f32x4*)(W.rtw() + (size_t)l * 36 * 1024 + 4 * i);
    __syncthreads();
    unsigned* cnt = W.ctl() + CW_CNT + l * NEXP * 64;
    LAS float* lgw = (LAS float*)(lds + 147456) + wid * 128;
    LAS int* rt_e = (LAS int*)(lds + 151552);
    LAS int* rt_s = rt_e + 128;
    LAS float* rt_w = (LAS float*)(rt_s + 128);
    LAS int* rt_row = (LAS int*)(rt_w + 256);
    LAS int* lcnt = rt_row + 128;
    if (tid < 64) lcnt[tid] = 0;
    __syncthreads();
    int trip = 0;
    for (int row0 = gw * 2; row0 < nrows; row0 += NGW * 2, ++trip) {
        f32x4 v[2][4];
#pragma unroll
        for (int q = 0; q < 2; ++q) { const int row = row0 + q;
            const bf16_t* xr = W.xb() + (size_t)row * D;
            const int vec = row < SEQ ? 0 : (row < ML ? 1 : 2); float ss = 0.f;
#pragma unroll
            for (int j = 0; j < 4; ++j) { const u32x2 xv = *(const u32x2*)(xr + 4 * lane + 256 * j); v[q][j][0] = bf2f(xv.x & 0xffffu); v[q][j][1] = bf2f(xv.x >> 16); v[q][j][2] = bf2f(xv.y & 0xffffu); v[q][j][3] = bf2f(xv.y >> 16);
                ss += (v[q][j][0] * v[q][j][0] + v[q][j][1] * v[q][j][1]) + (v[q][j][2] * v[q][j][2] + v[q][j][3] * v[q][j][3]); }
            const float r = rsqrtf(wave_sum(ss, lane) * (1.f / D) + EPS);
            const float* md = W.mods() + (size_t)(l * 3 + vec) * 6144; const float* nw = a->in[I_N2W] + l * D; bf16_t* hr = W.h() + (size_t)row * D;
#pragma unroll
            for (int j = 0; j < 4; ++j) { const int c = 4 * lane + 256 * j; const f32x4 w = *(const f32x4*)(nw + c), sh = *(const f32x4*)(md + 3072 + c), sc = *(const f32x4*)(md + 4096 + c);
#pragma unroll
                for (int i = 0; i < 4; ++i) v[q][j][i] = v[q][j][i] * r * w[i] * (1.f + sc[i]) + sh[i];
                if (!dry) { u32x2 p; p.x = pk2(v[q][j][0], v[q][j][1]); p.y = pk2(v[q][j][2], v[q][j][3]); *(u32x2*)(hr + c) = p; } } }
#pragma unroll 2
        for (int e = 0; e < 36; ++e) { float s0 = 0.f, s1 = 0.f;
#pragma unroll
            for (int j = 0; j < 4; ++j) { const f32x4 w = *(const LAS f32x4*)(WT + e * 1024 + 4 * lane + 256 * j);
                s0 += (v[0][j][0] * w[0] + v[0][j][1] * w[1]) + (v[0][j][2] * w[2] + v[0][j][3] * w[3]); s1 += (v[1][j][0] * w[0] + v[1][j][1] * w[1]) + (v[1][j][2] * w[2] + v[1][j][3] * w[3]); }
            s0 = dpp_sum63(s0); s1 = dpp_sum63(s1);
            if (lane == 63) { lgw[e] = s0; lgw[64 + e] = s1; } }
        LDS_WAIT(); asm volatile("" ::: "memory");
#pragma unroll
        for (int q = 0; q < 2; ++q) { const int row = row0 + q; LAS float* lg = lgw + 64 * q;
            float gl[4];
#pragma unroll
            for (int i = 0; i < 4; ++i) gl[i] = lg[i] + a->in[I_BGRP][l * 4 + i];
            int g = 0; float gmx = gl[0];
#pragma unroll
            for (int i = 1; i < 4; ++i) if (gl[i] > gmx) { gmx = gl[i]; g = i; }
            float gz = 0.f;
#pragma unroll
            for (int i = 0; i < 4; ++i) gz += __expf(gl[i] - gmx);
            const float gwt = 1.f / gz;
            float el[8];
#pragma unroll
            for (int i = 0; i < 8; ++i) el[i] = lg[4 + g * 8 + i] + a->in[I_BER][l * 32 + g * 8 + i];
            int i1 = 0; float m1 = el[0];
#pragma unroll
            for (int i = 1; i < 8; ++i) if (el[i] > m1) { m1 = el[i]; i1 = i; }
            int i2 = -1; float m2 = -3.0e38f;
#pragma unroll
            for (int i = 0; i < 8; ++i) if (i != i1 && el[i] > m2) { m2 = el[i]; i2 = i; }
            const float ex = __expf(m2 - m1), w1 = gwt / (1.f + ex), w2 = gwt * ex / (1.f + ex);
            if (lane == 0 && !dry) {
                const int e1 = g * 8 + i1, e2 = g * 8 + i2, li = trip * 16 + wid * 2 + q;
                const int ls1 = __hip_atomic_fetch_add(lcnt + e1, 1, __ATOMIC_RELAXED, __HIP_MEMORY_SCOPE_WORKGROUP), ls2 = __hip_atomic_fetch_add(lcnt + e2, 1, __ATOMIC_RELAXED, __HIP_MEMORY_SCOPE_WORKGROUP);
                rt_e[li] = e1 | (e2 << 8); rt_s[li] = ls1 | (ls2 << 16); rt_w[2 * li] = w1; rt_w[2 * li + 1] = w2; rt_row[li] = row;
            } }
    }
    __syncthreads();
    if (!dry) {
        if (tid < NEXP) { const int n = lcnt[tid]; lcnt[32 + tid] = n > 0 ? (int)atomicAdd(cnt + tid * 64, (unsigned)n) : 0; }
        __syncthreads();
        const int nloc = ((nrows - 2 * (int)blockIdx.x * 8 + NGW * 2 - 1) / (NGW * 2));
        for (int li = tid; li < nloc * 16; li += 512) { const int tr = li >> 4, w = (li >> 1) & 7, q = li & 1; const int row = ((int)blockIdx.x * 8 + w) * 2 + tr * NGW * 2 + q;
            if (row < nrows) { const int pe = rt_e[li], ps = rt_s[li]; const int e1 = pe & 0xff, e2 = pe >> 8; const int s1 = lcnt[32 + e1] + (ps & 0xffff), s2 = lcnt[32 + e2] + (ps >> 16);
                W.pair()[(size_t)e1 * PAIRCAP + s1] = row * 2; W.pw()[(size_t)e1 * PAIRCAP + s1] = rt_w[2 * li];
                W.pair()[(size_t)e2 * PAIRCAP + s2] = row * 2 + 1; W.pw()[(size_t)e2 * PAIRCAP + s2] = rt_w[2 * li + 1]; } }
    }
    __syncthreads();
}
DI void moe_tables(const WS& W, int l, LAS unsigned char* lds) {
    volatile LAS int* toff = (volatile LAS int*)(lds + MISC_OFF + 64); volatile LAS int* cn = (volatile LAS int*)(lds + MISC_OFF + 256);
    __syncthreads();
    if (threadIdx.x == 0) { int acc = 0; for (int e = 0; e < NEXP; ++e) { const int c = (int)__hip_atomic_load(W.ctl() + CW_CNT + (l * NEXP + e) * 64, __ATOMIC_RELAXED, __HIP_MEMORY_SCOPE_AGENT); cn[e] = c; toff[e] = acc; acc += (c + 255) >> 8; } toff[NEXP] = acc; }
    __syncthreads();
}

__global__ void __launch_bounds__(512, 2) fwd_kernel(Args a) {
    extern __shared__ __attribute__((aligned(16))) unsigned char lds_raw[];
    LAS unsigned char* lds = (LAS unsigned char*)lds_raw;
    const KArgs ka = (KArgs)__builtin_amdgcn_kernarg_segment_ptr();
#define AL() ({ KArgs al_ = ka; asm volatile("" : "+s"(al_)); al_; })
#define WL() (WS{AL()->ws})
#define LL() ({ int l_ = l; asm volatile("" : "+s"(l_)); l_; })
    const WS W{a.ws};
    const int tid = threadIdx.x, G = gridDim.x;
    volatile LAS unsigned* misc = (volatile LAS unsigned*)(lds + MISC_OFF);
    if (tid < 4) misc[tid] = 0u;
    __syncthreads();
    const bool fused = (a.ph_hi - a.ph_lo) > 1;
    XcdBarrier bar; bar.bar = W.ctl() + CW_BAR; bar.x = 0; bar.st = misc;
    if (fused) bar = xcd_barrier_post(W.ctl() + CW_BAR, misc);
    const int lo = a.ph_lo, hi = a.ph_hi;
#ifndef PHMASK
#define PHMASK 0xFFFFFFFFu
#endif
#ifndef PROBE_PH
#define PROBE_PH -1
#endif
#ifndef REP_UPG
#define REP_UPG 1
#endif
#ifndef REP_PRO
#define REP_PRO 1
#endif
#ifndef REP_N1
#define REP_N1 1
#endif
#ifndef REP_OUT
#define REP_OUT 1
#endif
#ifndef REP_RT
#define REP_RT 1
#endif
#ifndef REP_ATT
#define REP_ATT 1
#endif
#ifndef REP_CHK
#define REP_CHK 1
#endif
#ifndef REP_POST
#define REP_POST 1
#endif
#ifndef REP_PREP
#define REP_PREP 1
#endif
#ifndef REP_INP
#define REP_INP 1
#endif
#ifndef REP_MOE
#define REP_MOE 1
#endif
#ifndef NO_MOE
#define NO_MOE 0
#endif
#define RUN(k) (lo <= (k) && (k) < hi)
#define EN(j) ((PHMASK >> (j)) & 1u)
#define SEAM(k) do { if (lo <= (k) && (k) + 1 < hi) xcd_barrier(bar); } while (0)
    unsigned long long pr_acc = 0, pr_t0 = 0;
#define PT0(j) do { if (PROBE_PH == (j)) pr_t0 = __builtin_amdgcn_s_memrealtime(); } while (0)
#define PT1(j) do { if (PROBE_PH == (j)) pr_acc += __builtin_amdgcn_s_memrealtime() - pr_t0; } while (0)
    PT0(11);
    if (EN(11) && RUN(0)) { for (int rep = 0; rep < REP_PRO; ++rep) phase_prologue(AL(), WL(), lds); }
    SEAM(0); PT1(11);
    for (int l = 0; l < DEPTH; ++l) {
        const int p0 = 1 + l * NPL; const bool need_ctx = l < DEPTH - 1; const int mrows = need_ctx ? MA : ML;
        if (lo >= p0 + NPL || hi <= p0) continue;
        PT0(0);
        if (EN(0) && RUN(p0 + 0)) { phase_norm1(AL(), WL(), LL(), l - 1, (l > 0) && !NO_MOE, true, MA); for (int rep = 1; rep < REP_N1; ++rep) phase_norm1(AL(), WL(), LL(), l - 1, false, true, MA); }
        SEAM(p0 + 0); PT1(0);
        PT0(1);
        if (EN(1) && RUN(p0 + 1)) { const WS W = WL(); pg8::DenseSched S; S.init(W.h(), W.wl(LL(), WL_IN), D, D, MA, DINP, G, (int)blockIdx.x); pg8::EpiBf16 E{W.proj(), DINP}; for (int rep = 0; rep < REP_INP; ++rep) pg8::gemm_phase(lds, S, E, D, D);
            __syncthreads(); moe_weights(AL(), W, LL(), lds, 0, MOE_W_ITEMS / 2, 16); }
        SEAM(p0 + 1); PT1(1);
        PT0(2);
        if (EN(2) && RUN(p0 + 2)) { for (int rep = 0; rep < REP_PREP; ++rep) phase_prep(AL(), WL(), LL(), lds); }
        SEAM(p0 + 2); PT1(2);
        PT0(3);
        if (EN(3) && RUN(p0 + 3)) { const WS W = WL(); const int ll = LL();
            pg8::TriSched S{W.cqn(), CQ_LD, W.wl(ll, WL_UQ), MA / 256, G, (int)blockIdx.x};
            pg8::EpiBf16Seg E{W.qkvraw(), (long)((WS_MQK - WS_B) / 2)}; pg8::gemm_phase(lds, S, E, 256, 256); }
        SEAM(p0 + 3); PT1(3);
        PT0(4);
        if (EN(4) && RUN(p0 + 4)) { for (int rep = 0; rep < REP_POST; ++rep) phase_post(AL(), WL(), LL(), lds); }
        SEAM(p0 + 4); PT1(4);
        PT0(5);
        if (EN(5) && RUN(p0 + 5)) { { const WS W2 = WL(); phase_scan(W2, lds); for (int rep = 0; rep < REP_ATT; ++rep) phase_attn(W2, lds, need_ctx); } }
        SEAM(p0 + 5); PT1(5);
        PT0(6);
        if (EN(6) && RUN(p0 + 6)) { for (int rep = 0; rep < REP_CHK; ++rep) phase_chunkout(AL(), WL(), LL(), lds); }
        SEAM(p0 + 6); PT1(6);
        PT0(7);
        if (EN(7) && RUN(p0 + 7)) { const WS W = WL(); pg8::DenseSched S; S.init(W.mix(), W.wl(LL(), WL_OUT), D, D, mrows, D, G, (int)blockIdx.x); pg8::EpiResid E{W.xb(), W.mods() + (size_t)LL() * 3 * 6144 + 2048}; pg8::gemm_phase(lds, S, E, D, D);
            for (int rep = 1; rep < REP_OUT; ++rep) { pg8::EpiResid E0{W.xb(), W.mods() + (size_t)LL() * 3 * 6144 + 2048, 0.f}; pg8::gemm_phase(lds, S, E0, D, D); }
            __syncthreads(); moe_weights(AL(), W, LL(), lds, MOE_W_ITEMS / 2, MOE_W_ITEMS, need_ctx ? 8 : 0); }
        SEAM(p0 + 7); PT1(7);
        PT0(8);
        if (!NO_MOE && EN(8) && RUN(p0 + 8)) { phase_router(AL(), WL(), LL(), mrows, lds); for (int rep = 1; rep < REP_RT; ++rep) phase_router(AL(), WL(), LL(), mrows, lds, true); }
        SEAM(p0 + 8); PT1(8);
        PT0(9);
        if (!NO_MOE && EN(9) && RUN(p0 + 9)) { const WS W = WL(); moe_tables(W, LL(), lds);
            pg8::MoeSched<true> S{W.h(), W.wgu(), D, D, (size_t)512 * D, W.pair(), (const volatile LAS int*)(lds + MISC_OFF + 64), (const volatile LAS int*)(lds + MISC_OFF + 256), 2, G, (int)blockIdx.x};
            pg8::EpiMoeUp E{W.act(), W.pw(), (const volatile LAS int*)(lds + MISC_OFF + 256)}; for (int rep = 0; rep < REP_MOE; ++rep) pg8::gemm_phase(lds, S, E, D, D); }
        SEAM(p0 + 9); PT1(9);
        PT0(10);
        if (!NO_MOE && EN(10) && RUN(p0 + 10)) { const WS W = WL(); moe_tables(W, LL(), lds);
            pg8::MoeSched<false> S{W.act(), W.wdn(), DE, DE, (size_t)D * DE, W.pair(), (const volatile LAS int*)(lds + MISC_OFF + 64), (const volatile LAS int*)(lds + MISC_OFF + 256), 4, G, (int)blockIdx.x};
            pg8::EpiMoeDown E{W.y(), W.pair(), (const volatile LAS int*)(lds + MISC_OFF + 256)}; for (int rep = 0; rep < REP_MOE; ++rep) pg8::gemm_phase(lds, S, E, DE, DE); }
        SEAM(p0 + 10); PT1(10);
    }
    if (NO_MOE && RUN(NPHASE - 1)) { KArgs aa = AL(); for (int i = blockIdx.x * 512 + tid; i < ML * D; i += G * 512) { const float xi = aa->in[I_X][i]; aa->out[i] = xi + 64.f * (aa->out[i] - xi); } }
    if (!NO_MOE && EN(12) && RUN(NPHASE - 1)) { phase_norm1(AL(), WL(), 0, DEPTH - 1, true, false, ML); }
    if (PROBE_PH >= 0 && blockIdx.x == 0) { const unsigned long long t0 = __builtin_amdgcn_s_memrealtime(); while (__builtin_amdgcn_s_memrealtime() - t0 < 4ull * pr_acc) __builtin_amdgcn_s_sleep(8); }
#undef RUN
#undef SEAM
}

extern "C" void kernel_launch(void* const* d_in, const int* in_sizes, int n_in, void* d_out, int out_size, void* d_ws, size_t ws_size, hipStream_t stream) {
    static int grid = 0;
    if (grid == 0) {
        if (n_in != 33 || out_size != ML * D || ws_size < WS_END) { fprintf(stderr, "kernel_launch: unexpected shapes (n_in %d out %d ws %zu need %zu)\n", n_in, out_size, ws_size, (size_t)WS_END); grid = -1; return; }
        int dev = 0, cus = 0, per_cu = 0;
        if (hipGetDevice(&dev) != hipSuccess || hipDeviceGetAttribute(&cus, hipDeviceAttributeMultiprocessorCount, dev) != hipSuccess) { grid = -1; return; }
        if (hipFuncSetAttribute((const void*)fwd_kernel, hipFuncAttributeMaxDynamicSharedMemorySize, LDS_BYTES) != hipSuccess) { fprintf(stderr, "kernel_launch: hipFuncSetAttribute failed\n"); grid = -1; return; }
        if (hipOccupancyMaxActiveBlocksPerMultiprocessor(&per_cu, (const void*)fwd_kernel, 512, LDS_BYTES) != hipSuccess || per_cu < 1) fprintf(stderr, "kernel_launch: occupancy query says %d\n", per_cu);
        (void)hipGetLastError();
        grid = cus < 256 ? cus : 256;
    }
    if (grid < 0) return;
    (void)hipMemsetAsync((char*)d_ws + WS_CTL, 0, CTL_BYTES, stream);
    Args a{};
    for (int i = 0; i < 33; ++i) a.in[i] = (const float*)d_in[i];
    a.out = (float*)d_out; a.ws = (unsigned char*)d_ws;
#if N_LAUNCH_MODE == 1
    a.ph_lo = 0; a.ph_hi = NPHASE;
    hipLaunchKernelGGL(fwd_kernel, dim3(grid), dim3(512), LDS_BYTES, stream, a);
#else
    for (int p = 0; p < NPHASE; ++p) { a.ph_lo = p; a.ph_hi = p + 1; hipLaunchKernelGGL(fwd_kernel, dim3(grid), dim3(512), LDS_BYTES, stream, a); }
#endif
}
```
